# Optimizing an MI355X kernel written in HIP

```python
import jax, jax.numpy as jnp
from jax import lax
import numpy as np

D_MODEL = 1024
BATCH = 2
SEQ = 16384
DEPTH = 2

MIX_WIDTH = D_MODEL
POOL_WIDTH = D_MODEL // 4
POOL_WINDOWS = (2, 4, 8, 16)
POOL_GROUP = POOL_WIDTH // len(POOL_WINDOWS)
LRU_WIDTH = D_MODEL // 4
LRU_HEADS = 4
LRU_HEAD_DIM = LRU_WIDTH // LRU_HEADS
LRU_C = 8.0
CONV_WIDTH = 4
HEAD_DIM = 64
ATTN_WIDTH = MIX_WIDTH - POOL_WIDTH - LRU_WIDTH
N_HEADS = ATTN_WIDTH // HEAD_DIM
N_KV_HEADS = 2
GQA_GROUP = N_HEADS // N_KV_HEADS
KV_WIDTH = N_KV_HEADS * HEAD_DIM
N_BRANCH = 3
CMP_LEN = 32
CMP_STRIDE = 16
SEL_BLOCK = 64
SEL_TOPK = 16
WINDOW = 512
Q_BLOCK = 128
ROPE_THETA = 10000.0
D_FF = 2816
NORM_EPS = 1e-6
NEG_INF = -1e30
BIG_SCORE = 1e9
IN_SIZES = (POOL_WIDTH, LRU_WIDTH, LRU_WIDTH, ATTN_WIDTH,
            KV_WIDTH, KV_WIDTH, KV_WIDTH, KV_WIDTH, KV_WIDTH, KV_WIDTH,
            N_BRANCH * N_HEADS)
IN_COLS = sum(IN_SIZES)

kernel_name = "hymba_pool_rglru_nsa_macaron"


def rms_norm(x, g):
    x32 = x.astype(jnp.float32)
    y = x32 * lax.rsqrt(jnp.mean(x32 * x32, axis=-1, keepdims=True) + NORM_EPS)
    return (y * g.astype(jnp.float32)).astype(x.dtype)


def swiglu(x, w_gate, w_up, w_down):
    return (jax.nn.silu(x @ w_gate) * (x @ w_up)) @ w_down


def rope_tables(positions):
    inv = ROPE_THETA ** (-jnp.arange(0, HEAD_DIM, 2, dtype=jnp.float32) / HEAD_DIM)
    ang = positions.astype(jnp.float32)[..., None] * inv
    return jnp.cos(ang), jnp.sin(ang)


def apply_rope(x, cos, sin):
    x32 = x.astype(jnp.float32)
    x1, x2 = jnp.split(x32, 2, axis=-1)
    c = cos[:, :, None, :]
    s = sin[:, :, None, :]
    return jnp.concatenate([x1 * c - x2 * s, x2 * c + x1 * s], axis=-1).astype(x.dtype)


def pool_mixer(xp, pool_w, pool_scale):
    B, S, _ = xp.shape
    xg = xp.astype(jnp.float32).reshape(B, S, len(POOL_WINDOWS), POOL_GROUP)
    c = jnp.concatenate([jnp.zeros((B, 1) + xg.shape[2:], jnp.float32),
                         jnp.cumsum(xg, axis=1)], axis=1)
    t = jnp.arange(S)
    means = []
    for g, w in enumerate(POOL_WINDOWS):
        cg = c[:, :, g]
        lo = jnp.concatenate([jnp.zeros((B, w - 1, POOL_GROUP), jnp.float32),
                              cg[:, :S + 1 - w]], axis=1)
        cnt = jnp.minimum(t + 1, w).astype(jnp.float32)
        means.append((cg[:, 1:] - lo) / cnt[None, :, None])
    pooled = jnp.stack(means, axis=2)
    y = jnp.einsum('bsgi,gij->bsgj', (pooled - xg).astype(xp.dtype), pool_w)
    return y.reshape(B, S, POOL_WIDTH) * pool_scale


def rglru_mixer(xl, gate, conv_w, conv_b, w_r, b_r, w_i, b_i, lam):
    B, S, C = xl.shape
    xc = lax.conv_general_dilated(xl, conv_w[:, None, :], window_strides=(1,),
                                  padding=[(CONV_WIDTH - 1, 0)],
                                  dimension_numbers=('NWC', 'WIO', 'NWC'),
                                  feature_group_count=C) + conv_b
    xh = xc.reshape(B, S, LRU_HEADS, LRU_HEAD_DIM)
    r = jax.nn.sigmoid(jnp.einsum('bshi,hij->bshj', xh, w_r).reshape(B, S, C) + b_r)
    i = jax.nn.sigmoid(jnp.einsum('bshi,hij->bshj', xh, w_i).reshape(B, S, C) + b_i)
    log_a = -LRU_C * r.astype(jnp.float32) * jax.nn.softplus(-lam.astype(jnp.float32))
    a = jnp.exp(log_a)
    mult = jnp.sqrt(-jnp.expm1(2.0 * log_a))
    b = mult * (i * xc).astype(jnp.float32)

    def combine(left, right):
        a1, b1 = left
        a2, b2 = right
        return a1 * a2, a2 * b1 + b2

    _, h = lax.associative_scan(combine, (a, b), axis=1)
    return h.astype(xl.dtype) * jax.nn.gelu(gate)


def masked_softmax(s, mask, scale):
    s = jnp.where(mask, s.astype(jnp.float32) * scale, NEG_INF)
    p = jax.nn.softmax(s, axis=-1)
    return jnp.where(mask, p, 0.0)


def nsa_mixer(q, kc, vc, ks, vs, kw, vw, g, cos, sin, cmp_w_k, cmp_w_v, cmp_pe):
    B, S, _ = q.shape
    dt = q.dtype
    kv_heads = lambda t: t.reshape(B, S, N_KV_HEADS, HEAD_DIM)
    q = apply_rope(q.reshape(B, S, N_HEADS, HEAD_DIM), cos, sin)
    kc = apply_rope(kv_heads(kc), cos, sin)
    ks = apply_rope(kv_heads(ks), cos, sin)
    kw = apply_rope(kv_heads(kw), cos, sin)
    vc, vs, vw = kv_heads(vc), kv_heads(vs), kv_heads(vw)
    gates = jax.nn.sigmoid(g.astype(jnp.float32)).astype(dt).reshape(
        B, S, N_KV_HEADS, GQA_GROUP, N_BRANCH)
    qg = q.reshape(B, S, N_KV_HEADS, GQA_GROUP, HEAD_DIM)
    scale = HEAD_DIM ** -0.5

    n_cmp = (S - CMP_LEN) // CMP_STRIDE + 1
    cidx = jnp.arange(n_cmp)[:, None] * CMP_STRIDE + jnp.arange(CMP_LEN)[None, :]
    pe = cmp_pe[None, None, :, None, :]
    k_cmp = jnp.einsum('bnlhd,lde->bnhe', kc[:, cidx] + pe, cmp_w_k)
    v_cmp = jnp.einsum('bnlhd,lde->bnhe', vc[:, cidx] + pe, cmp_w_v)
    cmp_start = jnp.arange(n_cmp) * CMP_STRIDE
    cmp_end = cmp_start + CMP_LEN - 1

    n_sel = S // SEL_BLOCK
    n_top = min(SEL_TOPK, n_sel)
    sel_start = jnp.arange(n_sel) * SEL_BLOCK
    overlap = ((cmp_start[:, None] < sel_start[None, :] + SEL_BLOCK) &
               (cmp_start[:, None] + CMP_LEN > sel_start[None, :])).astype(jnp.float32)
    ks_blk = ks.reshape(B, n_sel, SEL_BLOCK, N_KV_HEADS, HEAD_DIM).transpose(0, 3, 1, 2, 4)
    vs_blk = vs.reshape(B, n_sel, SEL_BLOCK, N_KV_HEADS, HEAD_DIM).transpose(0, 3, 1, 2, 4)
    gather = jax.vmap(jax.vmap(lambda kb, ix: kb[ix]))

    pad = jnp.zeros((B, WINDOW, N_KV_HEADS, HEAD_DIM), dt)
    kw_pad = jnp.concatenate([pad, kw], axis=1)
    vw_pad = jnp.concatenate([pad, vw], axis=1)
    j_sel = jnp.arange(n_sel)

    def query_block(qb):
        start = qb * Q_BLOCK
        tq = start + jnp.arange(Q_BLOCK)
        qblk = lax.dynamic_slice_in_dim(qg, start, Q_BLOCK, axis=1)
        gblk = lax.dynamic_slice_in_dim(gates, start, Q_BLOCK, axis=1)

        s_c = jnp.einsum('bqhgd,bnhd->bhgqn', qblk, k_cmp)
        p_c = masked_softmax(s_c, cmp_end[None, :] <= tq[:, None], scale)
        o_c = jnp.einsum('bhgqn,bnhd->bqhgd', p_c.astype(dt), v_cmp)

        imp = jnp.einsum('bhqn,nj->bhqj', p_c.sum(axis=2), overlap)
        cur = tq // SEL_BLOCK
        valid = j_sel[None, :] <= cur[:, None]
        forced = ((j_sel[None, :] == 0) | (j_sel[None, :] == cur[:, None]) |
                  (j_sel[None, :] == cur[:, None] - 1))
        score = jnp.where(valid, jnp.where(forced, BIG_SCORE, imp), -BIG_SCORE)
        _, idx = lax.top_k(score, n_top)
        k_sel = gather(ks_blk, idx).reshape(B, N_KV_HEADS, Q_BLOCK, n_top * SEL_BLOCK, HEAD_DIM)
        v_sel = gather(vs_blk, idx).reshape(B, N_KV_HEADS, Q_BLOCK, n_top * SEL_BLOCK, HEAD_DIM)
        kpos = (idx[..., None] * SEL_BLOCK + jnp.arange(SEL_BLOCK)).reshape(
            B, N_KV_HEADS, Q_BLOCK, n_top * SEL_BLOCK)
        mask_s = (kpos <= tq[None, None, :, None])[:, :, None]
        s_s = jnp.einsum('bqhgd,bhqkd->bhgqk', qblk, k_sel)
        p_s = masked_softmax(s_s, mask_s, scale)
        o_s = jnp.einsum('bhgqk,bhqkd->bqhgd', p_s.astype(dt), v_sel)

        kwb = lax.dynamic_slice_in_dim(kw_pad, start, Q_BLOCK + WINDOW, axis=1)
        vwb = lax.dynamic_slice_in_dim(vw_pad, start, Q_BLOCK + WINDOW, axis=1)
        kp = start - WINDOW + jnp.arange(Q_BLOCK + WINDOW)
        diff = tq[:, None] - kp[None, :]
        mask_w = (diff >= 0) & (diff < WINDOW) & (kp[None, :] >= 0)
        s_w = jnp.einsum('bqhgd,bkhd->bhgqk', qblk, kwb)
        p_w = masked_softmax(s_w, mask_w, scale)
        o_w = jnp.einsum('bhgqk,bkhd->bqhgd', p_w.astype(dt), vwb)

        o = gblk[..., 0:1] * o_c + gblk[..., 1:2] * o_s + gblk[..., 2:3] * o_w
        return o.reshape(B, Q_BLOCK, ATTN_WIDTH)

    out = lax.map(query_block, jnp.arange(S // Q_BLOCK))
    return out.transpose(1, 0, 2, 3).reshape(B, S, ATTN_WIDTH)


def token_mixer(h, cos, sin, w_in, w_out, pool_w, pool_scale, conv_w, conv_b,
                lru_w_r, lru_b_r, lru_w_i, lru_b_i, lru_lambda, cmp_w_k, cmp_w_v, cmp_pe):
    proj = h @ w_in
    bounds = []
    acc = 0
    for size in IN_SIZES[:-1]:
        acc += size
        bounds.append(acc)
    xp, xl, gl, q, kc, vc, ks, vs, kw, vw, g = jnp.split(proj, bounds, axis=-1)
    y_pool = pool_mixer(xp, pool_w, pool_scale)
    y_lru = rglru_mixer(xl, gl, conv_w, conv_b, lru_w_r, lru_b_r, lru_w_i, lru_b_i, lru_lambda)
    y_attn = nsa_mixer(q, kc, vc, ks, vs, kw, vw, g, cos, sin, cmp_w_k, cmp_w_v, cmp_pe)
    return jnp.concatenate([y_pool, y_lru, y_attn], axis=-1) @ w_out


def setup_inputs(seed: int = 0) -> dict:
    key = jax.random.key(seed)
    ks = jax.random.split(key, 32)
    f32 = jnp.float32
    nrm = lambda k, shape, s: jax.random.normal(k, shape, f32) * s
    gain = lambda k: 1.0 + nrm(k, (DEPTH, D_MODEL), 0.05)
    x = jax.random.normal(ks[0], (BATCH, SEQ, D_MODEL), f32)
    offset = jax.random.randint(ks[1], (BATCH, 1), 0, 1024, dtype=jnp.int32)
    positions = (offset + jnp.arange(SEQ, dtype=jnp.int32)[None, :]).astype(jnp.int32)
    u = jax.random.uniform(ks[2], (DEPTH, LRU_WIDTH), f32, minval=0.9, maxval=0.999)
    return {
        "x": x,
        "positions": positions,
        "ffn1_pre_g": gain(ks[3]),
        "ffn1_post_g": gain(ks[4]),
        "ffn1_w_gate": nrm(ks[5], (DEPTH, D_MODEL, D_FF), D_MODEL ** -0.5),
        "ffn1_w_up": nrm(ks[6], (DEPTH, D_MODEL, D_FF), D_MODEL ** -0.5),
        "ffn1_w_down": nrm(ks[7], (DEPTH, D_FF, D_MODEL), D_FF ** -0.5),
        "mix_pre_g": gain(ks[8]),
        "mix_post_g": gain(ks[9]),
        "w_in": nrm(ks[10], (DEPTH, D_MODEL, IN_COLS), D_MODEL ** -0.5),
        "w_out": nrm(ks[11], (DEPTH, MIX_WIDTH, D_MODEL), MIX_WIDTH ** -0.5),
        "pool_w": nrm(ks[12], (DEPTH, len(POOL_WINDOWS), POOL_GROUP, POOL_GROUP), POOL_GROUP ** -0.5),
        "pool_scale": 1.0 + nrm(ks[13], (DEPTH, POOL_WIDTH), 0.1),
        "conv_w": nrm(ks[14], (DEPTH, CONV_WIDTH, LRU_WIDTH), CONV_WIDTH ** -0.5),
        "conv_b": nrm(ks[15], (DEPTH, LRU_WIDTH), 0.01),
        "lru_w_r": nrm(ks[16], (DEPTH, LRU_HEADS, LRU_HEAD_DIM, LRU_HEAD_DIM), LRU_HEAD_DIM ** -0.5),
        "lru_b_r": nrm(ks[17], (DEPTH, LRU_WIDTH), 0.01),
        "lru_w_i": nrm(ks[18], (DEPTH, LRU_HEADS, LRU_HEAD_DIM, LRU_HEAD_DIM), LRU_HEAD_DIM ** -0.5),
        "lru_b_i": nrm(ks[19], (DEPTH, LRU_WIDTH), 0.01),
        "lru_lambda": jnp.log(u) - jnp.log1p(-u),
        "cmp_w_k": nrm(ks[20], (DEPTH, CMP_LEN, HEAD_DIM, HEAD_DIM), (CMP_LEN * HEAD_DIM) ** -0.5),
        "cmp_w_v": nrm(ks[21], (DEPTH, CMP_LEN, HEAD_DIM, HEAD_DIM), (CMP_LEN * HEAD_DIM) ** -0.5),
        "cmp_pe": nrm(ks[22], (DEPTH, CMP_LEN, HEAD_DIM), 0.02),
        "ffn2_pre_g": gain(ks[23]),
        "ffn2_post_g": gain(ks[24]),
        "ffn2_w_gate": nrm(ks[25], (DEPTH, D_MODEL, D_FF), D_MODEL ** -0.5),
        "ffn2_w_up": nrm(ks[26], (DEPTH, D_MODEL, D_FF), D_MODEL ** -0.5),
        "ffn2_w_down": nrm(ks[27], (DEPTH, D_FF, D_MODEL), D_FF ** -0.5),
    }


def reference(x, positions, ffn1_pre_g, ffn1_post_g, ffn1_w_gate, ffn1_w_up, ffn1_w_down,
              mix_pre_g, mix_post_g, w_in, w_out, pool_w, pool_scale, conv_w, conv_b,
              lru_w_r, lru_b_r, lru_w_i, lru_b_i, lru_lambda, cmp_w_k, cmp_w_v, cmp_pe,
              ffn2_pre_g, ffn2_post_g, ffn2_w_gate, ffn2_w_up, ffn2_w_down):
    cos, sin = rope_tables(positions)
    h = x
    for l in range(DEPTH):
        f1 = swiglu(rms_norm(h, ffn1_pre_g[l]), ffn1_w_gate[l], ffn1_w_up[l], ffn1_w_down[l])
        h = h + 0.5 * rms_norm(f1, ffn1_post_g[l])
        m = token_mixer(rms_norm(h, mix_pre_g[l]), cos, sin, w_in[l], w_out[l],
                        pool_w[l], pool_scale[l], conv_w[l], conv_b[l],
                        lru_w_r[l], lru_b_r[l], lru_w_i[l], lru_b_i[l], lru_lambda[l],
                        cmp_w_k[l], cmp_w_v[l], cmp_pe[l])
        h = h + rms_norm(m, mix_post_g[l])
        f2 = swiglu(rms_norm(h, ffn2_pre_g[l]), ffn2_w_gate[l], ffn2_w_up[l], ffn2_w_down[l])
        h = h + 0.5 * rms_norm(f2, ffn2_post_g[l])
    return h
```

```cpp
#include <hip/hip_runtime.h>
#include <hip/hip_cooperative_groups.h>
#include <cstdio>
#include <cstdint>
namespace cg = cooperative_groups;

#define LAS __attribute__((address_space(3)))
typedef unsigned short bf16_t;
typedef short bf16x8 __attribute__((ext_vector_type(8)));
typedef float f32x4 __attribute__((ext_vector_type(4)));
typedef float f32x2 __attribute__((ext_vector_type(2)));
typedef unsigned u32x4 __attribute__((ext_vector_type(4)));
typedef unsigned u32x2 __attribute__((ext_vector_type(2)));

#ifndef N_LAUNCH_MODE
#define N_LAUNCH_MODE 1
#endif

constexpr int BATCH = 2, SEQ = 16384, DM = 1024, M = BATCH * SEQ, FF = 2816, NGU = 2 * FF, DEPTH = 2;
constexpr int INC = 2072, INP = 2304;
constexpr int C_XP = 0, C_XL = 256, C_GL = 512, C_Q = 768, C_KC = 1280, C_VC = 1408, C_KS = 1536, C_VS = 1664, C_KW = 1792, C_VW = 1920, C_G = 2048;
constexpr float EPS = 1e-6f;
constexpr float QSCALE = 0.125f * 1.4426950408889634f;
constexpr int NWAVES = 8, NTHREADS = 512;
constexpr int LRU_CHUNK = 128, LRU_NCH = SEQ / LRU_CHUNK;

constexpr size_t SZ_WGU = (size_t)NGU * DM * 2, SZ_WDN = (size_t)DM * FF * 2, SZ_WIN = (size_t)INP * DM * 2, SZ_WOUT = (size_t)DM * DM * 2;
constexpr size_t WS_WGU = 0;
constexpr size_t WS_WDN = WS_WGU + 4 * SZ_WGU;
constexpr size_t WS_WIN = WS_WDN + 4 * SZ_WDN;
constexpr size_t WS_WOUT = WS_WIN + 2 * SZ_WIN;
constexpr size_t WS_WPOOL = WS_WOUT + 2 * SZ_WOUT;
constexpr size_t WS_WLRU = WS_WPOOL + 2 * 4 * 4096 * 2;
constexpr size_t WS_WCMP = WS_WLRU + 2 * 2 * 4 * 4096 * 2;
constexpr size_t WS_COS = WS_WCMP + 2 * 2 * 64 * 2048 * 2;
constexpr size_t WS_SIN = WS_COS + (size_t)M * 32 * 4;
constexpr size_t WS_A = WS_SIN + (size_t)M * 32 * 4;
constexpr size_t WS_HID = WS_A + (size_t)M * DM * 2;
constexpr size_t WS_QR = WS_HID + (size_t)M * INP * 2;
constexpr size_t WS_F = WS_HID + (size_t)M * FF * 2;
constexpr size_t WS_KS = WS_F + (size_t)M * DM * 2;
constexpr size_t WS_KW = WS_KS + (size_t)4 * SEQ * 64 * 2;
constexpr size_t WS_VST = WS_KW + (size_t)4 * SEQ * 64 * 2;
constexpr size_t WS_VWT = WS_VST + (size_t)4 * SEQ * 64 * 2;
constexpr size_t WS_KCMP = WS_VWT + (size_t)4 * SEQ * 64 * 2;
constexpr size_t WS_VCMPT = WS_KCMP + (size_t)4 * 1024 * 64 * 2;
constexpr size_t WS_CARA = WS_VCMPT + (size_t)4 * 1024 * 64 * 2;
constexpr size_t WS_CARH = WS_CARA + (size_t)BATCH * LRU_NCH * 256 * 4;
constexpr size_t WS_END = WS_CARH + (size_t)BATCH * LRU_NCH * 256 * 4;
static_assert(WS_QR + (size_t)M * 512 * 2 == WS_F, "Qr fills the tail of the hidden buffer");
static_assert(WS_END <= (size_t)512 * 1024 * 1024, "workspace map");

constexpr int LDS_BYTES = 147456;
constexpr int WAVE_LDS = 17408;

__device__ __forceinline__ unsigned cvt_pk_bf16(float lo, float hi) { unsigned r; asm volatile("v_cvt_pk_bf16_f32 %0, %1, %2" : "=v"(r) : "v"(lo), "v"(hi)); return r; }
__device__ __forceinline__ float bflo(unsigned w) { return __uint_as_float(w << 16); }
__device__ __forceinline__ float bfhi(unsigned w) { return __uint_as_float(w & 0xffff0000u); }
__device__ __forceinline__ float bf1(unsigned short u) { return __uint_as_float((unsigned)u << 16); }
__device__ __forceinline__ float fexp2(float x) { return __builtin_amdgcn_exp2f(x); }
__device__ __forceinline__ float sigmoidf_(float x) { return 1.0f / (1.0f + __expf(-x)); }
__device__ __forceinline__ float wave_sum(float v) {
#pragma unroll
    for (int o = 1; o < 64; o <<= 1) v += __shfl_xor(v, o);
    return v;
}
#define LDS_WAIT() asm volatile("s_waitcnt lgkmcnt(0)" ::: "memory")
#define CFENCE() asm volatile("" ::: "memory")

namespace pg8 {
constexpr int BM = 256, BK = 64, HALF = 128, HTB = HALF * BK * 2, STAGE_BYTES = 8 * HTB, NXCD = 8, WGM = 8;
__host__ __device__ __forceinline__ int lds_byte(int r, int c) { const int st = (r >> 4) * 2 + (c >> 5), rr = r & 15, cc = c & 31, ob = rr * 64 + cc * 2; return st * 1024 + (ob ^ (((ob >> 9) & 1) << 5)); }
__host__ __device__ __forceinline__ void stage_rc(int b, int& R, int& C) { const int st = b / 1024, sb = b % 1024, swz = sb ^ (((sb >> 9) & 1) << 5); R = (st >> 1) * 16 + swz / 64; C = (st & 1) * 32 + (swz % 64) / 2; }
__host__ __device__ __forceinline__ int perm32(int rho) { const int n = rho >> 4, i = rho & 15; return 8 * (i >> 2) + 4 * n + (i & 3); }
struct Unit { int pm, pn; };
struct Gemm { const bf16_t* A; const bf16_t* Bt; int M, N, K; };
struct StaticOrder {
    int nM, nN, nwg, G, c;
    __device__ void init(int M_, int N_, int G_, int c_) { nM = M_ / BM; nN = N_ / BM; nwg = nM * nN; G = G_; c = c_; }
    __device__ bool next(int i, Unit& u) const {
        const long L = (long)i * G + c; if (L >= nwg) return false;
        int wgid = (int)L; { const int q = nwg / NXCD, r = nwg % NXCD, xcd = wgid % NXCD, off = wgid / NXCD; wgid = (xcd < r ? xcd * (q + 1) : r * (q + 1) + (xcd - r) * q) + off; }
        const int nig = WGM * nN, gid = wgid / nig, fm = gid * WGM, gsz = (nM - fm) < WGM ? (nM - fm) : WGM;
        u.pm = fm + ((wgid % nig) % gsz); u.pn = (wgid % nig) / gsz; return true;
    }
    __device__ __forceinline__ void a_ready(const Unit&) const {}
    __device__ __forceinline__ void done(const Unit&) const {}
};
struct EpiStore {
    static constexpr bool PERM = true, AFTER_DRAIN = false;
    bf16_t* O; int ldc;
    __device__ __forceinline__ void operator()(const f32x4 (&acc)[2][2][4][2], const Unit& u, int wr, int wc, int fr, int fq) const {
        const int row0 = u.pm * BM + wr * 64 + fr, col0 = u.pn * BM + wc * 32 + 8 * fq;
#pragma unroll
        for (int ai = 0; ai < 2; ++ai)
#pragma unroll
            for (int m = 0; m < 4; ++m) { bf16_t* rowp = O + (size_t)(row0 + ai * HALF + m * 16) * ldc + col0;
#pragma unroll
                for (int bj = 0; bj < 2; ++bj) { const f32x4 v0 = acc[ai][bj][m][0], v1 = acc[ai][bj][m][1];
                    u32x4 w; w.x = cvt_pk_bf16(v0[0], v0[1]); w.y = cvt_pk_bf16(v0[2], v0[3]); w.z = cvt_pk_bf16(v1[0], v1[1]); w.w = cvt_pk_bf16(v1[2], v1[3]);
                    *(u32x4*)(rowp + bj * HALF) = w; } }
    }
};
struct EpiSwiGLU {
    static constexpr bool PERM = true, AFTER_DRAIN = false;
    bf16_t* O;
    __device__ __forceinline__ void operator()(const f32x4 (&acc)[2][2][4][2], const Unit& u, int wr, int wc, int fr, int fq) const {
        const int row0 = u.pm * BM + wr * 64 + fr, col0 = u.pn * HALF + wc * 32 + 8 * fq;
#pragma unroll
        for (int ai = 0; ai < 2; ++ai)
#pragma unroll
            for (int m = 0; m < 4; ++m) { bf16_t* rowp = O + (size_t)(row0 + ai * HALF + m * 16) * FF + col0;
                float r[8];
#pragma unroll
                for (int n = 0; n < 2; ++n)
#pragma unroll
                    for (int j = 0; j < 4; ++j) { const float g = acc[ai][0][m][n][j], up = acc[ai][1][m][n][j];
                        r[n * 4 + j] = g * __builtin_amdgcn_rcpf(1.0f + fexp2(-1.4426950408889634f * g)) * up; }
                u32x4 w; w.x = cvt_pk_bf16(r[0], r[1]); w.y = cvt_pk_bf16(r[2], r[3]); w.z = cvt_pk_bf16(r[4], r[5]); w.w = cvt_pk_bf16(r[6], r[7]);
                *(u32x4*)rowp = w; }
    }
};

template <class Epi, class Sched, bool ALIGN_EPI = false, bool SP2 = false>
__device__ __forceinline__ void gemm_phase(LAS unsigned char* lds, const Gemm g, const Sched& S, const Epi& E, const int tid) {
    const int wid = __builtin_amdgcn_readfirstlane(tid >> 6), lane = tid & 63, wr = wid >> 2, wc = wid & 3, fr = lane & 15, fq = lane >> 4;
    const int K = g.K, nt = K / BK;
    unsigned voffA[2], voffB[2];
#pragma unroll
    for (int i = 0; i < 2; ++i) { int R, C; stage_rc(tid * 16 + i * 8192, R, C); const int Rb = Epi::PERM ? ((R & ~31) + perm32(R & 31)) : R;
        voffA[i] = (unsigned)(R * K + C) * 2u; voffB[i] = (unsigned)(Rb * K + C) * 2u; }
    const size_t kstep = (size_t)(BK * 2);
    const size_t hstep = (size_t)HALF * K * 2;
    const size_t tstep = 2 * hstep;
    const unsigned ldsw = (unsigned)wid * 1024u;
    const int aoff = lds_byte(wr * 64 + fr, fq * 8), boff = lds_byte(wc * 32 + fr, fq * 8);
#define PG8_SA(b, h) (((b) * 2 + (h)) * HTB)
#define PG8_SB(b, h) ((4 + (b) * 2 + (h)) * HTB)
#define PG8_STAGE(bufoff, gbase, voff) do { _Pragma("unroll") for (int _i = 0; _i < 2; ++_i) \
        __builtin_amdgcn_global_load_lds((const unsigned*)((const char*)(gbase) + (voff)[_i]), (LAS unsigned*)(lds + (bufoff) + ldsw + _i * 8192), 16, 0, 0); } while (0)
#define PG8_LDA(dst, b, h) do { _Pragma("unroll") for (int m = 0; m < 4; ++m) _Pragma("unroll") for (int k = 0; k < 2; ++k) dst[m][k] = *(const LAS bf16x8*)(lds + PG8_SA(b, h) + aoff + m * 2048 + k * 1024); } while (0)
#define PG8_LDB(dst, b, h) do { _Pragma("unroll") for (int n = 0; n < 2; ++n) _Pragma("unroll") for (int k = 0; k < 2; ++k) dst[n][k] = *(const LAS bf16x8*)(lds + PG8_SB(b, h) + boff + n * 2048 + k * 1024); } while (0)
#define PG8_MMA(ai, bj, At, Bt) do { __builtin_amdgcn_s_setprio(1); _Pragma("unroll") for (int m = 0; m < 4; ++m) _Pragma("unroll") for (int n = 0; n < 2; ++n) _Pragma("unroll") for (int k = 0; k < 2; ++k) \
        acc[ai][bj][m][n] = __builtin_amdgcn_mfma_f32_16x16x32_bf16(Bt[n][k], At[m][k], acc[ai][bj][m][n], 0, 0, 0); __builtin_amdgcn_s_setprio(0); } while (0)
#define PG8_WAIT_V(n) asm volatile("s_waitcnt vmcnt(" #n ")" ::: "memory")
#define PG8_WAIT_L(n) asm volatile("s_waitcnt lgkmcnt(" #n ")" ::: "memory")
#define PG8_BAR __builtin_amdgcn_s_barrier()
#define PG8_SCHED __builtin_amdgcn_sched_barrier(0)
    Unit cur, nxt; int ui = 0;
    if (!S.next(0, cur)) return;
    f32x4 acc[2][2][4][2];
#pragma unroll
    for (int a = 0; a < 2; ++a)
#pragma unroll
        for (int b = 0; b < 2; ++b)
#pragma unroll
            for (int m = 0; m < 4; ++m)
#pragma unroll
                for (int n = 0; n < 2; ++n) acc[a][b][m][n] = (f32x4){0.f, 0.f, 0.f, 0.f};
    bf16x8 At[4][2], B0[2][2], B1[2][2];
    const char* cA = (const char*)g.A + (size_t)cur.pm * tstep; const char* cB = (const char*)g.Bt + (size_t)cur.pn * tstep;
    S.a_ready(cur);
    if constexpr (SP2) {
        PG8_STAGE(PG8_SB(0, 0), cB, voffB); PG8_STAGE(PG8_SB(0, 1), cB + hstep, voffB); PG8_STAGE(PG8_SA(0, 0), cA, voffA); PG8_STAGE(PG8_SA(0, 1), cA + hstep, voffA);
        if (wr == 1) PG8_BAR;
        PG8_WAIT_V(2); PG8_BAR;
        PG8_STAGE(PG8_SB(1, 0), cB + kstep, voffB); PG8_STAGE(PG8_SA(1, 0), cA + kstep, voffA); PG8_STAGE(PG8_SB(1, 1), cB + hstep + kstep, voffB);
        PG8_WAIT_V(6); PG8_BAR;
    } else {
        PG8_STAGE(PG8_SB(0, 0), cB, voffB); PG8_STAGE(PG8_SA(0, 0), cA, voffA); PG8_STAGE(PG8_SB(0, 1), cB + hstep, voffB); PG8_STAGE(PG8_SA(0, 1), cA + hstep, voffA);
        if (wr == 1) PG8_BAR;
        PG8_WAIT_V(4); PG8_BAR;
        PG8_STAGE(PG8_SB(1, 0), cB + kstep, voffB); PG8_STAGE(PG8_SA(1, 0), cA + kstep, voffA); PG8_STAGE(PG8_SB(1, 1), cB + hstep + kstep, voffB);
        PG8_WAIT_V(6); PG8_BAR;
    }
    for (;;) {
        const bool has_next = S.next(ui + 1, nxt);
        const char* nA = has_next ? (const char*)g.A + (size_t)nxt.pm * tstep : cA; const char* nB = has_next ? (const char*)g.Bt + (size_t)nxt.pn * tstep : cB;
        for (int t = 0; t < nt; t += 2) {
            const bool last = (t == nt - 2);
            const char* a1 = cA + (size_t)(t + 1) * kstep;
            const char* a2 = last ? nA : cA + (size_t)(t + 2) * kstep; const char* b2 = last ? nB : cB + (size_t)(t + 2) * kstep;
            const char* a3 = a2 + kstep; const char* b3 = b2 + kstep;
            if (last && has_next) S.a_ready(nxt);
            if constexpr (SP2) {
            PG8_LDB(B0, 0, 0); PG8_LDB(B1, 0, 1); PG8_SCHED; PG8_LDA(At, 0, 0); PG8_STAGE(PG8_SA(1, 1), a1 + hstep, voffA);
            PG8_WAIT_V(8); PG8_WAIT_L(0); PG8_BAR; PG8_MMA(0, 0, At, B0); PG8_MMA(0, 1, At, B1); PG8_BAR; PG8_SCHED;
            PG8_LDA(At, 0, 1); PG8_STAGE(PG8_SB(0, 0), b2, voffB); PG8_STAGE(PG8_SB(0, 1), b2 + hstep, voffB); PG8_STAGE(PG8_SA(0, 0), a2, voffA);
            PG8_WAIT_V(8); PG8_WAIT_L(0); PG8_BAR; PG8_MMA(1, 0, At, B0); PG8_MMA(1, 1, At, B1); PG8_BAR; PG8_SCHED;
            PG8_LDB(B0, 1, 0); PG8_LDB(B1, 1, 1); PG8_SCHED; PG8_LDA(At, 1, 0); PG8_STAGE(PG8_SA(0, 1), a2 + hstep, voffA);
            PG8_WAIT_V(8); PG8_WAIT_L(0); PG8_BAR; PG8_MMA(0, 0, At, B0); PG8_MMA(0, 1, At, B1); PG8_BAR; PG8_SCHED;
            PG8_LDA(At, 1, 1); PG8_STAGE(PG8_SB(1, 0), b3, voffB); PG8_STAGE(PG8_SB(1, 1), b3 + hstep, voffB); PG8_STAGE(PG8_SA(1, 0), a3, voffA);
            PG8_WAIT_V(8); PG8_WAIT_L(0); PG8_BAR; PG8_MMA(1, 0, At, B0); PG8_MMA(1, 1, At, B1); PG8_BAR; PG8_SCHED;
            } else {
            PG8_LDB(B0, 0, 0); PG8_SCHED; PG8_LDA(At, 0, 0); PG8_STAGE(PG8_SA(1, 1), a1 + hstep, voffA);
            PG8_WAIT_L(8); PG8_BAR; PG8_WAIT_L(0); PG8_MMA(0, 0, At, B0); PG8_BAR; PG8_SCHED;
            PG8_LDB(B1, 0, 1); PG8_STAGE(PG8_SB(0, 0), b2, voffB);
            PG8_BAR; PG8_WAIT_L(0); PG8_MMA(0, 1, At, B1); PG8_BAR;
            PG8_LDA(At, 0, 1); PG8_STAGE(PG8_SA(0, 0), a2, voffA);
            PG8_BAR; PG8_WAIT_L(0); PG8_MMA(1, 0, At, B0); PG8_BAR; PG8_SCHED;
            PG8_STAGE(PG8_SB(0, 1), b2 + hstep, voffB);
            PG8_WAIT_V(6); PG8_BAR; PG8_MMA(1, 1, At, B1); PG8_BAR;
            PG8_LDB(B0, 1, 0); PG8_SCHED; PG8_LDA(At, 1, 0); PG8_STAGE(PG8_SA(0, 1), a2 + hstep, voffA);
            PG8_WAIT_L(8); PG8_BAR; PG8_WAIT_L(0); PG8_MMA(0, 0, At, B0); PG8_BAR; PG8_SCHED;
            PG8_LDB(B1, 1, 1); PG8_STAGE(PG8_SB(1, 0), b3, voffB);
            PG8_BAR; PG8_WAIT_L(0); PG8_MMA(0, 1, At, B1); PG8_BAR;
            PG8_LDA(At, 1, 1); PG8_STAGE(PG8_SA(1, 0), a3, voffA);
            PG8_BAR; PG8_WAIT_L(0); PG8_MMA(1, 0, At, B0); PG8_BAR; PG8_SCHED;
            PG8_STAGE(PG8_SB(1, 1), b3 + hstep, voffB);
            PG8_WAIT_V(6); PG8_BAR; PG8_MMA(1, 1, At, B1); PG8_BAR;
            }
        }
        if constexpr (ALIGN_EPI) { if (wr == 0) PG8_BAR; }
        if constexpr (!Epi::AFTER_DRAIN) { E(acc, cur, wr, wc, fr, fq); S.done(cur); }
        if (!has_next) break;
#pragma unroll
        for (int a = 0; a < 2; ++a)
#pragma unroll
            for (int b = 0; b < 2; ++b)
#pragma unroll
                for (int m = 0; m < 4; ++m)
#pragma unroll
                    for (int n = 0; n < 2; ++n) acc[a][b][m][n] = (f32x4){0.f, 0.f, 0.f, 0.f};
        cur = nxt; cA = nA; cB = nB; ++ui;
        if constexpr (ALIGN_EPI) { if (wr == 1) PG8_BAR; }
    }
    PG8_WAIT_V(0);
    if constexpr (!ALIGN_EPI) { if (wr == 0) PG8_BAR; }
    PG8_BAR;
#undef PG8_SA
#undef PG8_SB
#undef PG8_STAGE
#undef PG8_LDA
#undef PG8_LDB
#undef PG8_MMA
#undef PG8_WAIT_V
#undef PG8_WAIT_L
#undef PG8_BAR
#undef PG8_SCHED
}
}

struct Args { const void* in[28]; float* out; unsigned char* ws; int ph_lo, ph_hi; };

struct Ctx {
    LAS unsigned char* lds; LAS unsigned char* wlds;
    int tid, lane, wave, gw, ngw, G;
    unsigned char* ws;
};
constexpr int PTAB_OFF = 147456 - 256;
__device__ __forceinline__ const void* ldptr(LAS unsigned char* lds, int i) {
    volatile LAS unsigned* t = (volatile LAS unsigned*)(lds + PTAB_OFF) + 2 * i;
    const unsigned lo = __builtin_amdgcn_readfirstlane(t[0]), hi = __builtin_amdgcn_readfirstlane(t[1]);
    return (const void*)(((unsigned long long)hi << 32) | lo);
}
#define INP_F(i) ((const float*)ldptr(c.lds, (i)))

#define MFMA16(a, b, c) __builtin_amdgcn_mfma_f32_16x16x32_bf16((a), (b), (c), 0, 0, 0)

__device__ __forceinline__ void tr_item(const float* W, int K, int N, int nblk, bf16_t* WT, int mode, LAS float* scr, int item, int lane) {
    const int kb = item / nblk, nb = item % nblk, k0 = 64 * kb, n0 = 32 * nb;
    const int nn = n0 + (lane & 31);
#pragma unroll 8
    for (int i = 0; i < 32; ++i) { const int kk = 2 * i + (lane >> 5); scr[kk * 33 + (lane & 31)] = (nn < N) ? W[(size_t)(k0 + kk) * N + nn] : 0.f; }
    LDS_WAIT();
    const int row_off = mode == 0 ? 0 : ((n0 >> 7) * 128 + (mode == 2 ? 128 : 0));
    const int c = lane & 7;
#pragma unroll
    for (int j = 0; j < 4; ++j) { const int n = (lane >> 3) + 8 * j; const LAS float* s = scr + (8 * c) * 33 + n;
        u32x4 o; o.x = cvt_pk_bf16(s[0 * 33], s[1 * 33]); o.y = cvt_pk_bf16(s[2 * 33], s[3 * 33]); o.z = cvt_pk_bf16(s[4 * 33], s[5 * 33]); o.w = cvt_pk_bf16(s[6 * 33], s[7 * 33]);
        *(u32x4*)(WT + (size_t)(row_off + n0 + n) * K + k0 + 8 * c) = o; }
    LDS_WAIT();
}

__device__ __forceinline__ void norm_row_to_bf16(const float* xrow, const float* g, bf16_t* orow, int lane) {
    const f32x4* xr = (const f32x4*)xrow + lane; const f32x4* gr = (const f32x4*)g + lane;
    f32x4 v[4]; float s = 0.f;
#pragma unroll
    for (int j = 0; j < 4; ++j) { v[j] = xr[64 * j]; s += (v[j].x * v[j].x + v[j].y * v[j].y) + (v[j].z * v[j].z + v[j].w * v[j].w); }
    const float rs = 1.0f / sqrtf(wave_sum(s) * (1.f / DM) + EPS);
    u32x2* o8 = (u32x2*)orow + lane;
#pragma unroll
    for (int j = 0; j < 4; ++j) { const f32x4 gg = gr[64 * j]; u32x2 w; w.x = cvt_pk_bf16(v[j].x * rs * gg.x, v[j].y * rs * gg.y); w.y = cvt_pk_bf16(v[j].z * rs * gg.z, v[j].w * rs * gg.w); o8[64 * j] = w; }
}

constexpr int TR_BIG = 1408, TR_PER_LAYER = 6 * 1408 + 1152 + 512 + 8 + 16 + 128, TR_TOTAL = DEPTH * TR_PER_LAYER;

__device__ __forceinline__ void p0_prologue(const Ctx& c) {
    LAS float* scr = (LAS float*)c.wlds;
    unsigned char* ws = c.ws;
    for (int it = c.gw; it < TR_TOTAL; it += c.ngw) {
        const int l = it / TR_PER_LAYER; int r = it % TR_PER_LAYER;
        const float* src; bf16_t* dst; int K, N, nblk, mode = 0;
        if (r < 4 * TR_BIG) { const int q = r / TR_BIG; r -= q * TR_BIG; const int which = q >> 1, isup = q & 1;
            src = INP_F(which ? (isup ? 26 : 25) : (isup ? 5 : 4)) + (size_t)l * DM * FF; dst = (bf16_t*)(ws + WS_WGU + (size_t)(l * 2 + which) * SZ_WGU); K = DM; N = FF; nblk = FF / 32; mode = 1 + isup; }
        else if (r < 6 * TR_BIG) { r -= 4 * TR_BIG; const int which = r / TR_BIG; r -= which * TR_BIG;
            src = INP_F(which ? 27 : 6) + (size_t)l * DM * FF; dst = (bf16_t*)(ws + WS_WDN + (size_t)(l * 2 + which) * SZ_WDN); K = FF; N = DM; nblk = DM / 32; }
        else if (r < 6 * TR_BIG + 1152) { r -= 6 * TR_BIG; src = INP_F(9) + (size_t)l * DM * INC; dst = (bf16_t*)(ws + WS_WIN + (size_t)l * SZ_WIN); K = DM; N = INC; nblk = INP / 32; }
        else if (r < 6 * TR_BIG + 1152 + 512) { r -= 6 * TR_BIG + 1152; src = INP_F(10) + (size_t)l * DM * DM; dst = (bf16_t*)(ws + WS_WOUT + (size_t)l * SZ_WOUT); K = DM; N = DM; nblk = DM / 32; }
        else if (r < 6 * TR_BIG + 1152 + 512 + 8) { r -= 6 * TR_BIG + 1152 + 512; const int g = r >> 1; r &= 1;
            src = INP_F(11) + (size_t)(l * 4 + g) * 4096; dst = (bf16_t*)(ws + WS_WPOOL) + (size_t)(l * 4 + g) * 4096; K = 64; N = 64; nblk = 2; }
        else if (r < 6 * TR_BIG + 1152 + 512 + 8 + 16) { r -= 6 * TR_BIG + 1152 + 512 + 8; const int q = r >> 1; r &= 1; const int ri = q >> 2, h = q & 3;
            src = INP_F(ri ? 17 : 15) + (size_t)(l * 4 + h) * 4096; dst = (bf16_t*)(ws + WS_WLRU) + (size_t)((l * 2 + ri) * 4 + h) * 4096; K = 64; N = 64; nblk = 2; }
        else { r -= 6 * TR_BIG + 1152 + 512 + 8 + 16; const int kv = r >> 6; r &= 63;
            src = INP_F(kv ? 21 : 20) + (size_t)l * 2048 * 64; dst = (bf16_t*)(ws + WS_WCMP) + (size_t)(l * 2 + kv) * 64 * 2048; K = 2048; N = 64; nblk = 2; }
        tr_item(src, K, N, nblk, dst, mode, scr, r, c.lane);
    }
    {
        const int* pos = (const int*)ldptr(c.lds, 1); float* ct = (float*)(ws + WS_COS); float* st = (float*)(ws + WS_SIN);
        for (int e = c.gw * 64 + c.lane; e < M * 32; e += c.ngw * 64) {
            const int m = e >> 5, i = e & 31;
            const float inv = powf(10000.0f, -(float)(2 * i) / 64.0f);
            const float ang = (float)pos[m] * inv;
            const double ad = (double)ang; const double k = rint(ad * 0.15915494309189535); const float rr = (float)(ad - k * 6.283185307179586);
            ct[e] = cosf(rr); st[e] = sinf(rr);
        }
    }
    const float* x0 = INP_F(0); const float* g0 = INP_F(2);
    for (int m = c.gw; m < M; m += c.ngw) norm_row_to_bf16(x0 + (size_t)m * DM, g0, (bf16_t*)(ws + WS_A) + (size_t)m * DM, c.lane);
}

__device__ __forceinline__ void rowpass(const Ctx& c, const float* hin, float* hout, const bf16_t* f, const float* gpost, float coef, const float* gnext, bf16_t* aout) {
    const int lane = c.lane;
    for (int m = c.gw; m < M; m += c.ngw) {
        const u32x2* fr = (const u32x2*)(f + (size_t)m * DM) + lane;
        const f32x4* hr = (const f32x4*)(hin + (size_t)m * DM) + lane;
        f32x4 fv[4], hv[4]; float s = 0.f;
#pragma unroll
        for (int j = 0; j < 4; ++j) { const u32x2 w = fr[64 * j]; fv[j] = (f32x4){bflo(w.x), bfhi(w.x), bflo(w.y), bfhi(w.y)}; hv[j] = hr[64 * j];
            s += (fv[j].x * fv[j].x + fv[j].y * fv[j].y) + (fv[j].z * fv[j].z + fv[j].w * fv[j].w); }
        const float rs = coef / sqrtf(wave_sum(s) * (1.f / DM) + EPS);
        float s2 = 0.f;
#pragma unroll
        for (int j = 0; j < 4; ++j) { const f32x4 gg = ((const f32x4*)gpost + lane)[64 * j]; hv[j] = hv[j] + fv[j] * rs * gg;
            s2 += (hv[j].x * hv[j].x + hv[j].y * hv[j].y) + (hv[j].z * hv[j].z + hv[j].w * hv[j].w); }
        f32x4* ho = (f32x4*)(hout + (size_t)m * DM) + lane;
#pragma unroll
        for (int j = 0; j < 4; ++j) ho[64 * j] = hv[j];
        if (gnext) {
            const float rs2 = 1.0f / sqrtf(wave_sum(s2) * (1.f / DM) + EPS);
            u32x2* o8 = (u32x2*)(aout + (size_t)m * DM) + lane;
#pragma unroll
            for (int j = 0; j < 4; ++j) { const f32x4 gg = ((const f32x4*)gnext + lane)[64 * j]; u32x2 w; w.x = cvt_pk_bf16(hv[j].x * rs2 * gg.x, hv[j].y * rs2 * gg.y); w.y = cvt_pk_bf16(hv[j].z * rs2 * gg.z, hv[j].w * rs2 * gg.w); o8[64 * j] = w; }
        }
    }
}

__device__ __forceinline__ void unpack8(const bf16x8 v, float* f) {
    const u32x4 w = __builtin_bit_cast(u32x4, v);
    f[0] = bflo(w.x); f[1] = bfhi(w.x); f[2] = bflo(w.y); f[3] = bfhi(w.y); f[4] = bflo(w.z); f[5] = bfhi(w.z); f[6] = bflo(w.w); f[7] = bfhi(w.w);
}
__device__ __forceinline__ bf16x8 pack8(const float* f) {
    u32x4 w; w.x = cvt_pk_bf16(f[0], f[1]); w.y = cvt_pk_bf16(f[2], f[3]); w.z = cvt_pk_bf16(f[4], f[5]); w.w = cvt_pk_bf16(f[6], f[7]);
    return __builtin_bit_cast(bf16x8, w);
}

__device__ __forceinline__ void rope_unit(const Ctx& c, int tile) {
    const bf16_t* proj = (const bf16_t*)(c.ws + WS_HID); bf16_t* Qr = (bf16_t*)(c.ws + WS_QR);
    const float* ct = (const float*)(c.ws + WS_COS); const float* st = (const float*)(c.ws + WS_SIN);
    const int lane = c.lane, i0 = (lane & 7) * 4;
    for (int tt = 0; tt < 16; ++tt) {
        const int tg = tile * 16 + tt; const int b = tg / SEQ, t = tg % SEQ;
        const f32x4 cs = *(const f32x4*)(ct + (size_t)tg * 32 + i0), sn = *(const f32x4*)(st + (size_t)tg * 32 + i0);
        {
            const int head = lane >> 3; const bf16_t* src = proj + (size_t)tg * INP + C_Q + head * 64 + i0;
            const u32x2 a = *(const u32x2*)src, bb = *(const u32x2*)(src + 32);
            const f32x4 x1 = (f32x4){bflo(a.x), bfhi(a.x), bflo(a.y), bfhi(a.y)}, x2 = (f32x4){bflo(bb.x), bfhi(bb.x), bflo(bb.y), bfhi(bb.y)};
            const f32x4 o1 = (x1 * cs - x2 * sn) * QSCALE, o2 = (x2 * cs + x1 * sn) * QSCALE;
            bf16_t* dst = Qr + (size_t)tg * 512 + head * 64 + i0;
            u32x2 w; w.x = cvt_pk_bf16(o1.x, o1.y); w.y = cvt_pk_bf16(o1.z, o1.w); *(u32x2*)dst = w;
            w.x = cvt_pk_bf16(o2.x, o2.y); w.y = cvt_pk_bf16(o2.z, o2.w); *(u32x2*)(dst + 32) = w;
        }
        if (lane < 32) {
            const int arr = lane >> 4, kvh = (lane >> 3) & 1; const bf16_t* src = proj + (size_t)tg * INP + (arr ? C_KW : C_KS) + kvh * 64 + i0;
            const u32x2 a = *(const u32x2*)src, bb = *(const u32x2*)(src + 32);
            const f32x4 x1 = (f32x4){bflo(a.x), bfhi(a.x), bflo(a.y), bfhi(a.y)}, x2 = (f32x4){bflo(bb.x), bfhi(bb.x), bflo(bb.y), bfhi(bb.y)};
            const f32x4 o1 = x1 * cs - x2 * sn, o2 = x2 * cs + x1 * sn;
            bf16_t* dst = (bf16_t*)(c.ws + (arr ? WS_KW : WS_KS)) + ((size_t)(b * 2 + kvh) * SEQ + t) * 64 + i0;
            u32x2 w; w.x = cvt_pk_bf16(o1.x, o1.y); w.y = cvt_pk_bf16(o1.z, o1.w); *(u32x2*)dst = w;
            w.x = cvt_pk_bf16(o2.x, o2.y); w.y = cvt_pk_bf16(o2.z, o2.w); *(u32x2*)(dst + 32) = w;
        }
    }
}
__device__ __forceinline__ void vt_unit(const Ctx& c, int u) {
    const int tile = u & 255, bk = (u >> 8) & 3, arr = u >> 10; const int b = bk >> 1, kvh = bk & 1, t0 = tile * 64;
    const bf16_t* src = (const bf16_t*)(c.ws + WS_HID) + (size_t)(b * SEQ + t0) * INP + (arr ? C_VW : C_VS) + kvh * 64 + c.lane;
    bf16_t* dst = (bf16_t*)(c.ws + (arr ? WS_VWT : WS_VST)) + ((size_t)bk * 64 + c.lane) * SEQ + t0;
#pragma unroll
    for (int q = 0; q < 8; ++q) {
        unsigned w[4];
#pragma unroll
        for (int e = 0; e < 4; ++e) { const unsigned lo = src[(size_t)(q * 8 + 2 * e) * INP], hi = src[(size_t)(q * 8 + 2 * e + 1) * INP]; w[e] = lo | (hi << 16); }
        *(u32x4*)(dst + q * 8) = (u32x4){w[0], w[1], w[2], w[3]};
    }
}
__device__ __forceinline__ void pool_unit(const Ctx& c, int u, int layer, const float* pool_scale) {
    const int gp = u & 3, tile = u >> 2; const int lane = c.lane, r16 = lane & 15, g = lane >> 4;
    const int tg = tile * 16 + r16, b = tg / SEQ, t = tg % SEQ; const int w = 2 << gp;
    const bf16_t* proj = (const bf16_t*)(c.ws + WS_HID);
    const bf16_t* WpT = (const bf16_t*)(c.ws + WS_WPOOL) + (size_t)(layer * 4 + gp) * 4096;
    bf16x8 Df[2];
    const int cnt = (t + 1 < w) ? t + 1 : w; const float icnt = 1.0f / (float)cnt;
#pragma unroll
    for (int ks = 0; ks < 2; ++ks) {
        const bf16_t* p = proj + (size_t)(b * SEQ + t) * INP + C_XP + gp * 64 + ks * 32 + g * 8;
        float sum[8], x0[8];
        unpack8(*(const bf16x8*)p, x0);
#pragma unroll
        for (int e = 0; e < 8; ++e) sum[e] = x0[e];
        for (int s = 1; s < cnt; ++s) { float xv[8]; unpack8(*(const bf16x8*)(p - (size_t)s * INP), xv);
#pragma unroll
            for (int e = 0; e < 8; ++e) sum[e] += xv[e]; }
        float d[8];
#pragma unroll
        for (int e = 0; e < 8; ++e) d[e] = sum[e] * icnt - x0[e];
        Df[ks] = pack8(d);
    }
    bf16_t* out = (bf16_t*)(c.ws + WS_A) + (size_t)tg * DM + gp * 64;
#pragma unroll
    for (int jt = 0; jt < 4; ++jt) {
        f32x4 acc = (f32x4){0.f, 0.f, 0.f, 0.f};
#pragma unroll
        for (int ks = 0; ks < 2; ++ks) { const bf16x8 wf = *(const bf16x8*)(WpT + (size_t)(16 * jt + r16) * 64 + ks * 32 + g * 8); acc = MFMA16(wf, Df[ks], acc); }
        const f32x4 sc = *(const f32x4*)(pool_scale + gp * 64 + 16 * jt + 4 * g);
        u32x2 o; o.x = cvt_pk_bf16(acc[0] * sc[0], acc[1] * sc[1]); o.y = cvt_pk_bf16(acc[2] * sc[2], acc[3] * sc[3]);
        *(u32x2*)(out + 16 * jt + 4 * g) = o;
    }
}
__device__ __forceinline__ void lru_unit(const Ctx& c, int u, int layer, const float* conv_w, const float* conv_b, const float* b_r, const float* b_i, const float* lam) {
    const int hh = u & 3, ch = (u >> 2) % LRU_NCH, b = (u >> 2) / LRU_NCH;
    const int lane = c.lane, r16 = lane & 15, g = lane >> 4;
    const bf16_t* proj = (const bf16_t*)(c.ws + WS_HID);
    const bf16_t* WrT = (const bf16_t*)(c.ws + WS_WLRU) + (size_t)((layer * 2 + 0) * 4 + hh) * 4096;
    const bf16_t* WiT = (const bf16_t*)(c.ws + WS_WLRU) + (size_t)((layer * 2 + 1) * 4 + hh) * 4096;
    float* HL = (float*)(c.ws + WS_F); float* CA = HL + (size_t)M * 256;
    float n8sp[4][4], hcar[4][4], acar[4][4];
#pragma unroll
    for (int jt = 0; jt < 4; ++jt)
#pragma unroll
        for (int jj = 0; jj < 4; ++jj) { const float L = lam[hh * 64 + 16 * jt + 4 * g + jj]; n8sp[jt][jj] = -8.0f * log1pf(__expf(-L)); hcar[jt][jj] = 0.f; acar[jt][jj] = 1.f; }
    for (int tile = 0; tile < LRU_CHUNK / 16; ++tile) {
        const int t = ch * LRU_CHUNK + tile * 16 + r16; const size_t tg = (size_t)b * SEQ + t;
        bf16x8 Xf[2];
#pragma unroll
        for (int ks = 0; ks < 2; ++ks) {
            const int c0 = hh * 64 + ks * 32 + g * 8; float acc8[8];
            { const f32x4 b0 = *(const f32x4*)(conv_b + c0), b1 = *(const f32x4*)(conv_b + c0 + 4); acc8[0] = b0[0]; acc8[1] = b0[1]; acc8[2] = b0[2]; acc8[3] = b0[3]; acc8[4] = b1[0]; acc8[5] = b1[1]; acc8[6] = b1[2]; acc8[7] = b1[3]; }
#pragma unroll
            for (int k = 0; k < 4; ++k) { const int tt = t - 3 + k;
                if (tt >= 0) { float xv[8]; unpack8(*(const bf16x8*)(proj + ((size_t)b * SEQ + tt) * INP + C_XL + c0), xv);
                    const f32x4 w0 = *(const f32x4*)(conv_w + k * 256 + c0), w1 = *(const f32x4*)(conv_w + k * 256 + c0 + 4);
                    acc8[0] += w0[0] * xv[0]; acc8[1] += w0[1] * xv[1]; acc8[2] += w0[2] * xv[2]; acc8[3] += w0[3] * xv[3];
                    acc8[4] += w1[0] * xv[4]; acc8[5] += w1[1] * xv[5]; acc8[6] += w1[2] * xv[6]; acc8[7] += w1[3] * xv[7]; } }
            Xf[ks] = pack8(acc8);
        }
#pragma unroll
        for (int jt = 0; jt < 4; ++jt) {
            f32x4 aR = (f32x4){0.f, 0.f, 0.f, 0.f}, aI = (f32x4){0.f, 0.f, 0.f, 0.f};
#pragma unroll
            for (int ks = 0; ks < 2; ++ks) { const size_t wo = (size_t)(16 * jt + r16) * 64 + ks * 32 + g * 8;
                aR = MFMA16(*(const bf16x8*)(WrT + wo), Xf[ks], aR); aI = MFMA16(*(const bf16x8*)(WiT + wo), Xf[ks], aI); }
            const int c4 = hh * 64 + 16 * jt + 4 * g;
            f32x4 xc = *(const f32x4*)(conv_b + c4);
#pragma unroll
            for (int k = 0; k < 4; ++k) { const int tt = t - 3 + k;
                if (tt >= 0) { const u32x2 xw = *(const u32x2*)(proj + ((size_t)b * SEQ + tt) * INP + C_XL + c4); const f32x4 w4 = *(const f32x4*)(conv_w + k * 256 + c4);
                    xc[0] += w4[0] * bflo(xw.x); xc[1] += w4[1] * bfhi(xw.x); xc[2] += w4[2] * bflo(xw.y); xc[3] += w4[3] * bfhi(xw.y); } }
            const f32x4 br4 = *(const f32x4*)(b_r + c4), bi4 = *(const f32x4*)(b_i + c4);
            f32x4 hv, cv;
#pragma unroll
            for (int jj = 0; jj < 4; ++jj) {
                const float r = sigmoidf_(aR[jj] + br4[jj]), ii = sigmoidf_(aI[jj] + bi4[jj]);
                const float la = n8sp[jt][jj] * r; float av = __expf(la); float bv = sqrtf(fmaxf(-expm1f(2.0f * la), 0.f)) * (ii * xc[jj]);
#pragma unroll
                for (int d = 1; d < 16; d <<= 1) { const float ap = __shfl_up(av, d, 16), bp = __shfl_up(bv, d, 16); if (r16 >= d) { bv = av * bp + bv; av = av * ap; } }
                const float h = av * hcar[jt][jj] + bv, ca = av * acar[jt][jj];
                hv[jj] = h; cv[jj] = ca;
                hcar[jt][jj] = __shfl(h, 15, 16); acar[jt][jj] = __shfl(ca, 15, 16);
            }
            *(f32x4*)(HL + tg * 256 + c4) = hv; *(f32x4*)(CA + tg * 256 + c4) = cv;
        }
    }
    if (r16 == 15) {
        float* carA = (float*)(c.ws + WS_CARA) + (size_t)(b * LRU_NCH + ch) * 256; float* carH = (float*)(c.ws + WS_CARH) + (size_t)(b * LRU_NCH + ch) * 256;
#pragma unroll
        for (int jt = 0; jt < 4; ++jt) { const int c4 = hh * 64 + 16 * jt + 4 * g;
            *(f32x4*)(carA + c4) = (f32x4){acar[jt][0], acar[jt][1], acar[jt][2], acar[jt][3]}; *(f32x4*)(carH + c4) = (f32x4){hcar[jt][0], hcar[jt][1], hcar[jt][2], hcar[jt][3]}; }
    }
}
__device__ __forceinline__ void cmp_unit(const Ctx& c, int u, int layer, const float* pe) {
    const int nt_ = u & 63, bk = (u >> 6) & 3, kv = u >> 8; const int b = bk >> 1, kvh = bk & 1;
    const int lane = c.lane, r16 = lane & 15, g = lane >> 4;
    const bf16_t* proj = (const bf16_t*)(c.ws + WS_HID);
    const bf16_t* WT = (const bf16_t*)(c.ws + WS_WCMP) + (size_t)(layer * 2 + kv) * 64 * 2048;
    const float* ct = (const float*)(c.ws + WS_COS); const float* st = (const float*)(c.ws + WS_SIN);
    const int n = nt_ * 16 + r16; const int colb = (kv ? C_VC : C_KC) + kvh * 64;
    f32x4 acc[4];
#pragma unroll
    for (int e = 0; e < 4; ++e) acc[e] = (f32x4){0.f, 0.f, 0.f, 0.f};
    for (int l = 0; l < 32; ++l) {
        int t = 16 * n + l; if (t > SEQ - 1) t = SEQ - 1;
        const size_t tg = (size_t)b * SEQ + t;
        float x1[8], x2[8];
        unpack8(*(const bf16x8*)(proj + tg * INP + colb + g * 8), x1); unpack8(*(const bf16x8*)(proj + tg * INP + colb + 32 + g * 8), x2);
        float o1[8], o2[8];
        if (kv == 0) {
            const f32x4 c0 = *(const f32x4*)(ct + tg * 32 + g * 8), c1 = *(const f32x4*)(ct + tg * 32 + g * 8 + 4), s0 = *(const f32x4*)(st + tg * 32 + g * 8), s1 = *(const f32x4*)(st + tg * 32 + g * 8 + 4);
#pragma unroll
            for (int e = 0; e < 8; ++e) { const float cc = e < 4 ? c0[e & 3] : c1[e & 3], ss = e < 4 ? s0[e & 3] : s1[e & 3]; o1[e] = x1[e] * cc - x2[e] * ss; o2[e] = x2[e] * cc + x1[e] * ss; }
        } else {
#pragma unroll
            for (int e = 0; e < 8; ++e) { o1[e] = x1[e]; o2[e] = x2[e]; }
        }
        { const f32x4 p0 = *(const f32x4*)(pe + l * 64 + g * 8), p1 = *(const f32x4*)(pe + l * 64 + g * 8 + 4), p2 = *(const f32x4*)(pe + l * 64 + 32 + g * 8), p3 = *(const f32x4*)(pe + l * 64 + 32 + g * 8 + 4);
#pragma unroll
            for (int e = 0; e < 4; ++e) { o1[e] += p0[e]; o1[4 + e] += p1[e]; o2[e] += p2[e]; o2[4 + e] += p3[e]; } }
        const bf16x8 X0 = pack8(o1), X1 = pack8(o2);
#pragma unroll
        for (int et = 0; et < 4; ++et) {
            const bf16_t* wp = WT + (size_t)(16 * et + r16) * 2048 + l * 64 + g * 8;
            const bf16x8 W0 = *(const bf16x8*)wp, W1 = *(const bf16x8*)(wp + 32);
            if (kv == 0) { acc[et] = MFMA16(W0, X0, acc[et]); acc[et] = MFMA16(W1, X1, acc[et]); }
            else         { acc[et] = MFMA16(X0, W0, acc[et]); acc[et] = MFMA16(X1, W1, acc[et]); }
        }
    }
    if (kv == 0) {
        bf16_t* dst = (bf16_t*)(c.ws + WS_KCMP) + ((size_t)bk * 1024 + n) * 64;
        const bool z = (n >= 1023);
#pragma unroll
        for (int et = 0; et < 4; ++et) { u32x2 o; o.x = cvt_pk_bf16(acc[et][0], acc[et][1]); o.y = cvt_pk_bf16(acc[et][2], acc[et][3]); if (z) { o.x = 0u; o.y = 0u; } *(u32x2*)(dst + 16 * et + 4 * g) = o; }
    } else {
        bf16_t* dst = (bf16_t*)(c.ws + WS_VCMPT) + (size_t)bk * 64 * 1024;
        const int nb = nt_ * 16 + 4 * g;
#pragma unroll
        for (int et = 0; et < 4; ++et) { float v3 = acc[et][3]; if (nb + 3 >= 1023) v3 = 0.f; u32x2 o; o.x = cvt_pk_bf16(acc[et][0], acc[et][1]); o.y = cvt_pk_bf16(acc[et][2], v3); *(u32x2*)(dst + (size_t)(16 * et + r16) * 1024 + nb) = o; }
    }
}

constexpr int NU_LRU = BATCH * LRU_NCH * 4, NU_CMP = 512, NU_POOL = (M / 16) * 4, NU_ROPE = M / 16, NU_VT = 2048;
__device__ __forceinline__ void phase_prep(const Ctx& c, int layer) {
    const float* pool_scale = INP_F(12) + layer * 256;
    const float* conv_w = INP_F(13) + layer * 1024; const float* conv_b = INP_F(14) + layer * 256;
    const float* b_r = INP_F(16) + layer * 256; const float* b_i = INP_F(18) + layer * 256; const float* lam = INP_F(19) + layer * 256;
    const float* pe = INP_F(22) + layer * 2048;
    for (int u = c.gw; u < NU_LRU; u += c.ngw) lru_unit(c, u, layer, conv_w, conv_b, b_r, b_i, lam);
    for (int u = c.gw; u < NU_CMP; u += c.ngw) cmp_unit(c, u, layer, pe);
    for (int u = c.gw; u < NU_VT; u += c.ngw) vt_unit(c, u);
    for (int u = c.gw; u < NU_ROPE; u += c.ngw) rope_unit(c, u);
    for (int u = c.gw; u < NU_POOL; u += c.ngw) pool_unit(c, u, layer, pool_scale);
}

constexpr int NCG = 2, QPW = 4 * NCG;
struct AttnRegs { f32x4 O[4][NCG]; float m[NCG], l[NCG]; };

__device__ __forceinline__ void attn_reset(AttnRegs& R) {
#pragma unroll
    for (int md = 0; md < 4; ++md)
#pragma unroll
        for (int cg_ = 0; cg_ < NCG; ++cg_) R.O[md][cg_] = (f32x4){0.f, 0.f, 0.f, 0.f};
#pragma unroll
    for (int cg_ = 0; cg_ < NCG; ++cg_) { R.m[cg_] = -1e30f; R.l[cg_] = 0.f; }
}

template <int MODE>
__device__ __forceinline__ void attn_tile(AttnRegs& R, const bf16x8 (&Qf)[NCG][2], const bf16_t* Kb, const bf16_t* Vt, int ldv, int kbase, unsigned act, int tq_base  ,
                                          const unsigned (&selw)[NCG], int bit, int lane, LAS float* imp, int qi, int hg) {
    const int r16 = lane & 15, g = lane >> 4;
    bf16x8 Kf[2][2], Vf[4];
#pragma unroll
    for (int sub = 0; sub < 2; ++sub) { const bf16_t* kp = Kb + (size_t)(kbase + 8 * (r16 >> 2) + (r16 & 3) + 4 * sub) * 64 + g * 8; Kf[sub][0] = *(const bf16x8*)kp; Kf[sub][1] = *(const bf16x8*)(kp + 32); }
#pragma unroll
    for (int md = 0; md < 4; ++md) Vf[md] = *(const bf16x8*)(Vt + (size_t)(16 * md + r16) * ldv + kbase + 8 * g);
    const int key0 = kbase + 8 * g;
#pragma unroll
    for (int cg_ = 0; cg_ < NCG; ++cg_) {
        if (!(act & (1u << cg_))) continue;
        f32x4 s0 = (f32x4){0.f, 0.f, 0.f, 0.f}, s1 = (f32x4){0.f, 0.f, 0.f, 0.f};
        s0 = MFMA16(Kf[0][0], Qf[cg_][0], s0); s0 = MFMA16(Kf[0][1], Qf[cg_][1], s0);
        s1 = MFMA16(Kf[1][0], Qf[cg_][0], s1); s1 = MFMA16(Kf[1][1], Qf[cg_][1], s1);
        float s[8] = {s0[0], s0[1], s0[2], s0[3], s1[0], s1[1], s1[2], s1[3]};
        const int tq = tq_base + 4 * cg_;
#pragma unroll
        for (int i = 0; i < 8; ++i) { const int key = key0 + i; bool ok;
            if (MODE == 0) ok = (key <= tq) && (tq - key < 512);
            else if (MODE == 1) ok = ((selw[cg_] >> bit) & 1u) && (key <= tq);
            else ok = (16 * key + 31 <= tq);
            s[i] = ok ? s[i] : -INFINITY; }
        float p[8];
        if (MODE == 2) {
            const float mm = R.m[cg_], il = R.l[cg_];
#pragma unroll
            for (int i = 0; i < 8; ++i) p[i] = fexp2(s[i] - mm) * il;
            float ps[8];
#pragma unroll
            for (int i = 0; i < 8; ++i) { float v = p[i]; v += __shfl_xor(v, 1); v += __shfl_xor(v, 2); ps[i] = v; }
            if (hg == 0) {
                const int jb = key0 >> 2; LAS float* ip = imp + (4 * cg_ + qi) * 256 + jb;
                __hip_atomic_fetch_add(ip, (ps[0] + ps[1]) + (ps[2] + ps[3]), __ATOMIC_RELAXED, __HIP_MEMORY_SCOPE_WORKGROUP);
                if (jb + 1 < 256) __hip_atomic_fetch_add(ip + 1, ps[3] + (ps[4] + ps[5]) + (ps[6] + ps[7]), __ATOMIC_RELAXED, __HIP_MEMORY_SCOPE_WORKGROUP);
                if (jb + 2 < 256) __hip_atomic_fetch_add(ip + 2, ps[7], __ATOMIC_RELAXED, __HIP_MEMORY_SCOPE_WORKGROUP);
            }
        } else {
            float mx = fmaxf(fmaxf(fmaxf(s[0], s[1]), fmaxf(s[2], s[3])), fmaxf(fmaxf(s[4], s[5]), fmaxf(s[6], s[7])));
            mx = fmaxf(mx, __shfl_xor(mx, 16)); mx = fmaxf(mx, __shfl_xor(mx, 32));
            const float mnew = fmaxf(R.m[cg_], mx), alpha = fexp2(R.m[cg_] - mnew); R.m[cg_] = mnew;
            float sum = 0.f;
#pragma unroll
            for (int i = 0; i < 8; ++i) { p[i] = fexp2(s[i] - mnew); sum += p[i]; }
            R.l[cg_] = R.l[cg_] * alpha + sum;
#pragma unroll
            for (int md = 0; md < 4; ++md) R.O[md][cg_] = R.O[md][cg_] * alpha;
        }
        const bf16x8 P = pack8(p);
#pragma unroll
        for (int md = 0; md < 4; ++md) R.O[md][cg_] = MFMA16(Vf[md], P, R.O[md][cg_]);
    }
}

__device__ __forceinline__ void attn_tile_stats(AttnRegs& R, const bf16x8 (&Qf)[NCG][2], const bf16_t* Kb, int kbase, int tq_base, int lane) {
    const int r16 = lane & 15, g = lane >> 4;
    bf16x8 Kf[2][2];
#pragma unroll
    for (int sub = 0; sub < 2; ++sub) { const bf16_t* kp = Kb + (size_t)(kbase + 8 * (r16 >> 2) + (r16 & 3) + 4 * sub) * 64 + g * 8; Kf[sub][0] = *(const bf16x8*)kp; Kf[sub][1] = *(const bf16x8*)(kp + 32); }
    const int key0 = kbase + 8 * g;
#pragma unroll
    for (int cg_ = 0; cg_ < NCG; ++cg_) {
        f32x4 s0 = (f32x4){0.f, 0.f, 0.f, 0.f}, s1 = (f32x4){0.f, 0.f, 0.f, 0.f};
        s0 = MFMA16(Kf[0][0], Qf[cg_][0], s0); s0 = MFMA16(Kf[0][1], Qf[cg_][1], s0);
        s1 = MFMA16(Kf[1][0], Qf[cg_][0], s1); s1 = MFMA16(Kf[1][1], Qf[cg_][1], s1);
        float s[8] = {s0[0], s0[1], s0[2], s0[3], s1[0], s1[1], s1[2], s1[3]};
        const int tq = tq_base + 4 * cg_;
#pragma unroll
        for (int i = 0; i < 8; ++i) s[i] = (16 * (key0 + i) + 31 <= tq) ? s[i] : -INFINITY;
        float mx = fmaxf(fmaxf(fmaxf(s[0], s[1]), fmaxf(s[2], s[3])), fmaxf(fmaxf(s[4], s[5]), fmaxf(s[6], s[7])));
        mx = fmaxf(mx, __shfl_xor(mx, 16)); mx = fmaxf(mx, __shfl_xor(mx, 32));
        const float mnew = fmaxf(R.m[cg_], mx), alpha = fexp2(R.m[cg_] - mnew); R.m[cg_] = mnew;
        float sum = 0.f;
#pragma unroll
        for (int i = 0; i < 8; ++i) sum += fexp2(s[i] - mnew);
        R.l[cg_] = R.l[cg_] * alpha + sum;
    }
}

template <int MODE, bool NORM>
__device__ __forceinline__ void attn_flush(AttnRegs& R, LAS float* ofin, const bf16_t* gp  , bf16_t* outp, int lane) {
#pragma unroll
    for (int cg_ = 0; cg_ < NCG; ++cg_) {
        float sc = sigmoidf_(bf1(gp[(size_t)(4 * cg_) * INP]));
        if (NORM) { float L = R.l[cg_]; L += __shfl_xor(L, 16); L += __shfl_xor(L, 32); sc = L > 0.f ? sc / L : 0.f; }
#pragma unroll
        for (int md = 0; md < 4; ++md) {
            f32x4 v = R.O[md][cg_] * sc;
            LAS f32x4* slot = (LAS f32x4*)ofin + (md * NCG + cg_) * 64 + lane;
            if (MODE != 0) v = v + *slot;
            if (MODE != 2) *slot = v;
            else { u32x2 o; o.x = cvt_pk_bf16(v[0], v[1]); o.y = cvt_pk_bf16(v[2], v[3]); *(u32x2*)(outp + (size_t)(4 * cg_) * DM + 16 * md) = o; }
        }
    }
}

__device__ __forceinline__ void attn_unit(const Ctx& c, int uid) {
    const int lane = c.lane, r16 = lane & 15, g = lane >> 4, qi = r16 >> 2, hg = r16 & 3;
    const int qt = ((uid >> 5) << 3) | (uid & 7), bk = (uid >> 3) & 3, b = bk >> 1, kvh = bk & 1;
    const int tq0 = qt * QPW, cur = tq0 >> 6, head = kvh * 4 + hg;
    LAS float* imp = (LAS float*)c.wlds;
    LAS unsigned* msk = (LAS unsigned*)(c.wlds + 16384);
    LAS unsigned* uni = (LAS unsigned*)(c.wlds + 16384 + 512);
    const bf16_t* proj = (const bf16_t*)(c.ws + WS_HID);
    const bf16_t* Qr = (const bf16_t*)(c.ws + WS_QR);
    bf16x8 Qf[NCG][2];
#pragma unroll
    for (int cg_ = 0; cg_ < NCG; ++cg_) { const size_t tg = (size_t)b * SEQ + tq0 + 4 * cg_ + qi; const bf16_t* qp = Qr + tg * 512 + head * 64 + g * 8; Qf[cg_][0] = *(const bf16x8*)qp; Qf[cg_][1] = *(const bf16x8*)(qp + 32); }
    const bf16_t* gp = proj + ((size_t)b * SEQ + tq0 + qi) * INP + C_G + head * 3;
    bf16_t* outp = (bf16_t*)(c.ws + WS_A) + ((size_t)b * SEQ + tq0 + qi) * DM + 512 + head * 64 + 4 * g;
    unsigned selw0[NCG];
#pragma unroll
    for (int cg_ = 0; cg_ < NCG; ++cg_) selw0[cg_] = 0u;
    constexpr unsigned ALLCG = (1u << NCG) - 1u;
    AttnRegs R;
#pragma unroll
    for (int i = 0; i < QPW; ++i) ((LAS f32x4*)imp)[i * 64 + lane] = (f32x4){0.f, 0.f, 0.f, 0.f};
    CFENCE();
    {
        const bf16_t* Kc = (const bf16_t*)(c.ws + WS_KCMP) + (size_t)bk * 1024 * 64; const bf16_t* Vc = (const bf16_t*)(c.ws + WS_VCMPT) + (size_t)bk * 64 * 1024;
        const int tl = tq0 + QPW - 1 - 31; const int ncount = tl >= 0 ? (tl >> 4) + 1 : 0;
        attn_reset(R);
        for (int kb = 0; kb < ncount; kb += 32) attn_tile_stats(R, Qf, Kc, kb, tq0 + qi, lane);
#pragma unroll
        for (int cg_ = 0; cg_ < NCG; ++cg_) { float L = R.l[cg_]; L += __shfl_xor(L, 16); L += __shfl_xor(L, 32); R.l[cg_] = L > 0.f ? 1.0f / L : 0.f; }
        for (int kb = 0; kb < ncount; kb += 32) attn_tile<2>(R, Qf, Kc, Vc, 1024, kb, ALLCG, tq0 + qi, selw0, 0, lane, imp, qi, hg);
    }
    LDS_WAIT(); CFENCE();
    if (cur < 16) {
        if (lane < QPW) {
#pragma unroll
            for (int w = 0; w < 8; ++w) { const int lo = 32 * w; unsigned v = 0u; if (cur >= lo) { const int nb = cur - lo + 1; v = nb >= 32 ? 0xFFFFFFFFu : ((1u << nb) - 1u); } msk[lane * 8 + w] = v; }
        }
    } else {
        LAS unsigned short* m16 = (LAS unsigned short*)msk;
        for (int rr = 0; rr < NCG; ++rr) {
            const int qq = 4 * rr + g; int v[16];
#pragma unroll
            for (int i = 0; i < 16; ++i) { const int j = i * 16 + r16; const bool cand = (j <= cur) && (j != 0) && (j != cur) && (j != cur - 1); v[i] = cand ? (int)__float_as_uint(imp[qq * 256 + j]) : -1; }
            int T = 0;
            for (int bitp = 30; bitp >= 0; --bitp) { const int cd = T | (1 << bitp); int cnt = 0;
#pragma unroll
                for (int i = 0; i < 16; ++i) cnt += (v[i] >= cd) ? 1 : 0;
                cnt += __shfl_xor(cnt, 1); cnt += __shfl_xor(cnt, 2); cnt += __shfl_xor(cnt, 4); cnt += __shfl_xor(cnt, 8);
                if (cnt >= 13) T = cd; }
            int gt = 0;
#pragma unroll
            for (int i = 0; i < 16; ++i) gt += (v[i] > T) ? 1 : 0;
            gt += __shfl_xor(gt, 1); gt += __shfl_xor(gt, 2); gt += __shfl_xor(gt, 4); gt += __shfl_xor(gt, 8);
            const int need = 13 - gt; int running = 0;
#pragma unroll
            for (int i = 0; i < 16; ++i) { const int j = i * 16 + r16; const bool eq = (v[i] == T);
                const unsigned long long bal = __ballot(eq); const unsigned be = (unsigned)(bal >> (16 * g)) & 0xFFFFu;
                const int rank = running + __popc(be & ((1u << r16) - 1u)); running += __popc(be);
                const bool forced = (j <= cur) && ((j == 0) || (j == cur) || (j == cur - 1));
                const bool sel = (v[i] > T) || (eq && rank < need) || forced;
                const unsigned long long bs = __ballot(sel);
                if (r16 == 0) m16[qq * 16 + i] = (unsigned short)((bs >> (16 * g)) & 0xFFFFu); }
        }
    }
    LDS_WAIT(); CFENCE();
    if (lane < 8) { unsigned u = 0u;
#pragma unroll
        for (int q = 0; q < QPW; ++q) u |= msk[q * 8 + lane];
        uni[lane] = u; }
    if (lane < 8 * NCG) { const int cg_ = lane >> 3, w = lane & 7; unsigned u = 0u;
#pragma unroll
        for (int q = 0; q < 4; ++q) u |= msk[(4 * cg_ + q) * 8 + w];
        uni[8 + lane] = u; }
    LDS_WAIT(); CFENCE();
    attn_flush<0, false>(R, imp, gp + 0, outp, lane);
    {
        const bf16_t* Ks = (const bf16_t*)(c.ws + WS_KS) + (size_t)bk * SEQ * 64; const bf16_t* Vs = (const bf16_t*)(c.ws + WS_VST) + (size_t)bk * 64 * SEQ;
        attn_reset(R);
        for (int w = 0; w < 8; ++w) {
            unsigned uw = __builtin_amdgcn_readfirstlane(uni[w]);
            if (!uw) continue;
            unsigned cu[NCG], selw[NCG];
#pragma unroll
            for (int cg_ = 0; cg_ < NCG; ++cg_) { cu[cg_] = __builtin_amdgcn_readfirstlane(uni[8 + cg_ * 8 + w]); selw[cg_] = msk[(4 * cg_ + qi) * 8 + w]; }
            while (uw) {
                const int bit = __builtin_ctz(uw); uw &= uw - 1u; const int j = 32 * w + bit;
                unsigned act = 0u;
#pragma unroll
                for (int cg_ = 0; cg_ < NCG; ++cg_) act |= ((cu[cg_] >> bit) & 1u) << cg_;
                attn_tile<1>(R, Qf, Ks, Vs, SEQ, 64 * j, act, tq0 + qi, selw, bit, lane, imp, qi, hg);
                attn_tile<1>(R, Qf, Ks, Vs, SEQ, 64 * j + 32, act, tq0 + qi, selw, bit, lane, imp, qi, hg);
            }
        }
        attn_flush<1, true>(R, imp, gp + 1, outp, lane);
    }
    {
        const bf16_t* Kw = (const bf16_t*)(c.ws + WS_KW) + (size_t)bk * SEQ * 64; const bf16_t* Vw = (const bf16_t*)(c.ws + WS_VWT) + (size_t)bk * 64 * SEQ;
        attn_reset(R);
        int ks0 = tq0 - 511; if (ks0 < 0) ks0 = 0; ks0 &= ~31;
        for (int kb = ks0; kb <= tq0 + QPW - 1; kb += 32) attn_tile<0>(R, Qf, Kw, Vw, SEQ, kb, ALLCG, tq0 + qi, selw0, 0, lane, imp, qi, hg);
        attn_flush<2, true>(R, imp, gp + 2, outp, lane);
    }
    LDS_WAIT(); CFENCE();
}

__device__ __forceinline__ void lru_fin_unit(const Ctx& c, int u) {
    const int hh = u & 3, ch = (u >> 2) % LRU_NCH, b = (u >> 2) / LRU_NCH; const int chn = hh * 64 + c.lane;
    const float* carA = (const float*)(c.ws + WS_CARA) + (size_t)b * LRU_NCH * 256 + chn; const float* carH = (const float*)(c.ws + WS_CARH) + (size_t)b * LRU_NCH * 256 + chn;
    float h = 0.f;
    for (int k = 0; k < ch; ++k) h = carA[k * 256] * h + carH[k * 256];
    const float* HL = (const float*)(c.ws + WS_F); const float* CA = HL + (size_t)M * 256;
    const bf16_t* proj = (const bf16_t*)(c.ws + WS_HID); bf16_t* out = (bf16_t*)(c.ws + WS_A);
    const size_t tg0 = (size_t)b * SEQ + ch * LRU_CHUNK;
#pragma unroll 4
    for (int t = 0; t < LRU_CHUNK; ++t) { const size_t tg = tg0 + t;
        const float hv = HL[tg * 256 + chn] + CA[tg * 256 + chn] * h; const float x = bf1(proj[tg * INP + C_GL + chn]);
        const float u3 = 0.7978845608028654f * (x + 0.044715f * x * x * x); const float th = 1.0f - 2.0f / (1.0f + __expf(2.0f * u3));
        const float y = hv * (0.5f * x * (1.0f + th));
        out[tg * DM + 256 + chn] = (bf16_t)(cvt_pk_bf16(y, 0.f) & 0xffffu); }
}

constexpr int NU_ATT = (SEQ / QPW) * 4;
__device__ __forceinline__ void phase_attn(const Ctx& c) {
    for (int w = c.gw; w < NU_ATT / 2; w += c.ngw) { attn_unit(c, w); attn_unit(c, NU_ATT - 1 - w); }
    for (int u = c.gw; u < NU_LRU; u += c.ngw) lru_fin_unit(c, u);
}

constexpr int N_PHASES = 1 + 11 * DEPTH;
__global__ void __launch_bounds__(NTHREADS, 2) fwd_kernel(Args args) {
    extern __shared__ __attribute__((aligned(16))) unsigned char lds_raw[];
    {
        LAS unsigned long long* tab = (LAS unsigned long long*)((LAS unsigned char*)lds_raw + PTAB_OFF);
        if (threadIdx.x < 28) tab[threadIdx.x] = (unsigned long long)args.in[threadIdx.x];
        if (threadIdx.x == 28) tab[28] = (unsigned long long)args.out;
        if (threadIdx.x == 29) tab[29] = (unsigned long long)args.ws;
        __syncthreads();
    }
    const int ph_lo = args.ph_lo, ph_hi = args.ph_hi;
    using namespace pg8;
    for (int ph = ph_lo; ph < ph_hi; ++ph) {
        Ctx c;
        int tid = threadIdx.x; asm volatile("" : "+v"(tid));
        int bid = blockIdx.x; asm volatile("" : "+s"(bid));
        unsigned ldsb = (unsigned)(size_t)(LAS unsigned char*)lds_raw; asm volatile("" : "+s"(ldsb));
        c.lds = (LAS unsigned char*)(size_t)ldsb; c.tid = tid; c.lane = tid & 63; c.wave = __builtin_amdgcn_readfirstlane(tid >> 6);
        c.G = gridDim.x; c.gw = bid * NWAVES + c.wave; c.ngw = c.G * NWAVES;
        c.wlds = c.lds + c.wave * WAVE_LDS;
        unsigned char* ws = (unsigned char*)ldptr(c.lds, 29); c.ws = ws;
        float* outp = (float*)ldptr(c.lds, 28);
        if (ph == 0) {
#ifndef NO_P0
            p0_prologue(c);
#endif
        } else {
            const int l = (ph - 1) / 11, s = (ph - 1) % 11;
            if (s == 0 || s == 8) {
                const int which = s == 8; Gemm g{(const bf16_t*)(ws + WS_A), (const bf16_t*)(ws + WS_WGU + (size_t)(l * 2 + which) * SZ_WGU), M, NGU, DM};
                StaticOrder S; S.init(M, NGU, c.G, bid); EpiSwiGLU E{(bf16_t*)(ws + WS_HID)};
                gemm_phase<EpiSwiGLU, StaticOrder, true, true>(c.lds, g, S, E, tid);
            } else if (s == 1 || s == 9 || s == 3 || s == 6) {
                const bf16_t* A; const bf16_t* Bt; bf16_t* O; int N, K;
                if (s == 3) { A = (const bf16_t*)(ws + WS_A); Bt = (const bf16_t*)(ws + WS_WIN + (size_t)l * SZ_WIN); O = (bf16_t*)(ws + WS_HID); N = INP; K = DM; }
                else if (s == 6) { A = (const bf16_t*)(ws + WS_A); Bt = (const bf16_t*)(ws + WS_WOUT + (size_t)l * SZ_WOUT); O = (bf16_t*)(ws + WS_F); N = DM; K = DM; }
                else { A = (const bf16_t*)(ws + WS_HID); Bt = (const bf16_t*)(ws + WS_WDN + (size_t)(l * 2 + (s == 9)) * SZ_WDN); O = (bf16_t*)(ws + WS_F); N = DM; K = FF; }
                Gemm g{A, Bt, M, N, K};
                StaticOrder S; S.init(M, N, c.G, bid); EpiStore E{O, N};
                gemm_phase<EpiStore, StaticOrder, true, true>(c.lds, g, S, E, tid);
            } else if (s == 4) {
#ifndef NO_PREP
                phase_prep(c, l);
#endif
            } else if (s == 5) {
#ifndef NO_ATTN
                phase_attn(c);
#endif
            } else {
                const float* hin = (s == 2 && l == 0) ? INP_F(0) : outp;
                const float* gpost = INP_F(s == 2 ? 3 : (s == 7 ? 8 : 24)) + l * DM;
                const float* gnext = s == 2 ? INP_F(7) + l * DM : (s == 7 ? INP_F(23) + l * DM : ((l + 1 < DEPTH) ? INP_F(2) + (l + 1) * DM : nullptr));
                rowpass(c, hin, outp, (const bf16_t*)(ws + WS_F), gpost, s == 7 ? 1.0f : 0.5f, gnext, (bf16_t*)(ws + WS_A));
            }
        }
        if (ph + 1 < ph_hi) { cg::this_grid().sync(); }
    }
}

extern "C" void kernel_launch(void* const* d_in, const int* in_sizes, int n_in, void* d_out, int out_size, void* d_ws, size_t ws_size, hipStream_t stream) {
    static int grid = 0;
    if (grid == 0) {
        if (n_in != 28 || out_size != M * DM || ws_size < WS_END) { fprintf(stderr, "kernel_launch: unexpected shapes (n_in %d out %d ws %zu need %zu)\n", n_in, out_size, ws_size, (size_t)WS_END); grid = -1; return; }
        int dev = 0, cus = 0, per_cu = 0;
        hipGetDevice(&dev); hipDeviceGetAttribute(&cus, hipDeviceAttributeMultiprocessorCount, dev);
        if (hipFuncSetAttribute((const void*)fwd_kernel, hipFuncAttributeMaxDynamicSharedMemorySize, LDS_BYTES) != hipSuccess) { fprintf(stderr, "kernel_launch: hipFuncSetAttribute failed\n"); grid = -1; return; }
        if (hipOccupancyMaxActiveBlocksPerMultiprocessor(&per_cu, (const void*)fwd_kernel, NTHREADS, LDS_BYTES) != hipSuccess || per_cu < 1) { fprintf(stderr, "kernel_launch: occupancy query says %d\n", per_cu); per_cu = 1; }
        (void)hipGetLastError();
        grid = cus * per_cu;
        fprintf(stderr, "kernel_launch: grid %d (cus %d x %d)\n", grid, cus, per_cu);
    }
    if (grid < 0) return;
    Args a{};
    for (int i = 0; i < 28; ++i) a.in[i] = d_in[i];
    a.out = (float*)d_out; a.ws = (unsigned char*)d_ws;
#if N_LAUNCH_MODE == 1
    a.ph_lo = 0; a.ph_hi = N_PHASES;
    void* kargs[] = {&a};
    hipError_t e = hipLaunchCooperativeKernel((const void*)fwd_kernel, dim3(grid), dim3(NTHREADS), kargs, LDS_BYTES, stream);
    if (e != hipSuccess) fprintf(stderr, "cooperative launch failed: %s (grid %d)\n", hipGetErrorString(e), grid);
#else
    for (int ph = 0; ph < N_PHASES; ++ph) {
        a.ph_lo = ph; a.ph_hi = ph + 1;
        hipLaunchKernelGGL(fwd_kernel, dim3(grid), dim3(NTHREADS), LDS_BYTES, stream, a);
    }
#endif
}
```

```cpp
#include <hip/hip_runtime.h>
#include <hip/hip_cooperative_groups.h>
#include <cstdio>
#include <cstdint>
namespace cg = cooperative_groups;

#define LAS __attribute__((address_space(3)))
typedef unsigned short bf16_t;
typedef short bf16x8 __attribute__((ext_vector_type(8)));
typedef float f32x4 __attribute__((ext_vector_type(4)));
typedef float f32x2 __attribute__((ext_vector_type(2)));
typedef unsigned u32x4 __attribute__((ext_vector_type(4)));
typedef unsigned u32x2 __attribute__((ext_vector_type(2)));

#ifndef N_LAUNCH_MODE
#define N_LAUNCH_MODE 1
#endif

constexpr int BATCH = 2, SEQ = 16384, DM = 1024, M = BATCH * SEQ, FF = 2816, NGU = 2 * FF, DEPTH = 2;
constexpr int INC = 2072, INP = 2304;
constexpr int C_XP = 0, C_XL = 256, C_GL = 512, C_Q = 768, C_KC = 1280, C_VC = 1408, C_KS = 1536, C_VS = 1664, C_KW = 1792, C_VW = 1920, C_G = 2048;
constexpr float EPS = 1e-6f;
constexpr float QSCALE = 0.125f * 1.4426950408889634f;
constexpr int NWAVES = 8, NTHREADS = 512;
constexpr int LRU_CHUNK = 128, LRU_NCH = SEQ / LRU_CHUNK;

constexpr size_t SZ_WGU = (size_t)NGU * DM * 2, SZ_WDN = (size_t)DM * FF * 2, SZ_WIN = (size_t)INP * DM * 2, SZ_WOUT = (size_t)DM * DM * 2;
constexpr size_t WS_WGU = 0;
constexpr size_t WS_WDN = WS_WGU + 4 * SZ_WGU;
constexpr size_t WS_WIN = WS_WDN + 4 * SZ_WDN;
constexpr size_t WS_WOUT = WS_WIN + 2 * SZ_WIN;
constexpr size_t WS_WPOOL = WS_WOUT + 2 * SZ_WOUT;
constexpr size_t WS_WLRU = WS_WPOOL + 2 * 4 * 4096 * 2;
constexpr size_t WS_WCMP = WS_WLRU + 2 * 2 * 4 * 4096 * 2;
constexpr size_t WS_COS = WS_WCMP + 2 * 2 * 64 * 2048 * 2;
constexpr size_t WS_SIN = WS_COS + (size_t)M * 32 * 4;
constexpr size_t WS_A = WS_SIN + (size_t)M * 32 * 4;
constexpr size_t WS_HID = WS_A + (size_t)M * DM * 2;
constexpr size_t WS_QR = WS_HID + (size_t)M * INP * 2;
constexpr size_t WS_F = WS_HID + (size_t)M * FF * 2;
constexpr size_t WS_KS = WS_F + (size_t)M * DM * 2;
constexpr size_t WS_KW = WS_KS + (size_t)4 * SEQ * 64 * 2;
constexpr size_t WS_VST = WS_KW + (size_t)4 * SEQ * 64 * 2;
constexpr size_t WS_VWT = WS_VST + (size_t)4 * SEQ * 64 * 2;
constexpr size_t WS_KCMP = WS_VWT + (size_t)4 * SEQ * 64 * 2;
constexpr size_t WS_VCMPT = WS_KCMP + (size_t)4 * 1024 * 64 * 2;
constexpr size_t WS_CARA = WS_VCMPT + (size_t)4 * 1024 * 64 * 2;
constexpr size_t WS_CARH = WS_CARA + (size_t)BATCH * LRU_NCH * 256 * 4;
constexpr size_t WS_END = WS_CARH + (size_t)BATCH * LRU_NCH * 256 * 4;
static_assert(WS_QR + (size_t)M * 512 * 2 == WS_F, "Qr fills the tail of the hidden buffer");
static_assert(WS_END <= (size_t)512 * 1024 * 1024, "workspace map");

constexpr int LDS_BYTES = 147456;
constexpr int WAVE_LDS = 17408;

__device__ __forceinline__ unsigned cvt_pk_bf16(float lo, float hi) { unsigned r; asm volatile("v_cvt_pk_bf16_f32 %0, %1, %2" : "=v"(r) : "v"(lo), "v"(hi)); return r; }
__device__ __forceinline__ float bflo(unsigned w) { return __uint_as_float(w << 16); }
__device__ __forceinline__ float bfhi(unsigned w) { return __uint_as_float(w & 0xffff0000u); }
__device__ __forceinline__ float bf1(unsigned short u) { return __uint_as_float((unsigned)u << 16); }
__device__ __forceinline__ float fexp2(float x) { return __builtin_amdgcn_exp2f(x); }
__device__ __forceinline__ float sigmoidf_(float x) { return 1.0f / (1.0f + __expf(-x)); }
__device__ __forceinline__ float wave_sum(float v) {
#pragma unroll
    for (int o = 1; o < 64; o <<= 1) v += __shfl_xor(v, o);
    return v;
}
#define LDS_WAIT() asm volatile("s_waitcnt lgkmcnt(0)" ::: "memory")
#define CFENCE() asm volatile("" ::: "memory")

namespace pg8 {
constexpr int BM = 256, BK = 64, HALF = 128, HTB = HALF * BK * 2, STAGE_BYTES = 8 * HTB, NXCD = 8, WGM = 8;
__host__ __device__ __forceinline__ int lds_byte(int r, int c) { const int st = (r >> 4) * 2 + (c >> 5), rr = r & 15, cc = c & 31, ob = rr * 64 + cc * 2; return st * 1024 + (ob ^ (((ob >> 9) & 1) << 5)); }
__host__ __device__ __forceinline__ void stage_rc(int b, int& R, int& C) { const int st = b / 1024, sb = b % 1024, swz = sb ^ (((sb >> 9) & 1) << 5); R = (st >> 1) * 16 + swz / 64; C = (st & 1) * 32 + (swz % 64) / 2; }
__host__ __device__ __forceinline__ int perm32(int rho) { const int n = rho >> 4, i = rho & 15; return 8 * (i >> 2) + 4 * n + (i & 3); }
struct Unit { int pm, pn; };
struct Gemm { const bf16_t* A; const bf16_t* Bt; int M, N, K; };
struct StaticOrder {
    int nM, nN, nwg, G, c;
    __device__ void init(int M_, int N_, int G_, int c_) { nM = M_ / BM; nN = N_ / BM; nwg = nM * nN; G = G_; c = c_; }
    __device__ bool next(int i, Unit& u) const {
        const long L = (long)i * G + c; if (L >= nwg) return false;
        int wgid = (int)L; { const int q = nwg / NXCD, r = nwg % NXCD, xcd = wgid % NXCD, off = wgid / NXCD; wgid = (xcd < r ? xcd * (q + 1) : r * (q + 1) + (xcd - r) * q) + off; }
        const int nig = WGM * nN, gid = wgid / nig, fm = gid * WGM, gsz = (nM - fm) < WGM ? (nM - fm) : WGM;
        u.pm = fm + ((wgid % nig) % gsz); u.pn = (wgid % nig) / gsz; return true;
    }
    __device__ __forceinline__ void a_ready(const Unit&) const {}
    __device__ __forceinline__ void done(const Unit&) const {}
};
struct EpiStore {
    static constexpr bool PERM = true, AFTER_DRAIN = false;
    bf16_t* O; int ldc;
    __device__ __forceinline__ void operator()(const f32x4 (&acc)[2][2][4][2], const Unit& u, int wr, int wc, int fr, int fq) const {
        const int row0 = u.pm * BM + wr * 64 + fr, col0 = u.pn * BM + wc * 32 + 8 * fq;
#pragma unroll
        for (int ai = 0; ai < 2; ++ai)
#pragma unroll
            for (int m = 0; m < 4; ++m) { bf16_t* rowp = O + (size_t)(row0 + ai * HALF + m * 16) * ldc + col0;
#pragma unroll
                for (int bj = 0; bj < 2; ++bj) { const f32x4 v0 = acc[ai][bj][m][0], v1 = acc[ai][bj][m][1];
                    u32x4 w; w.x = cvt_pk_bf16(v0[0], v0[1]); w.y = cvt_pk_bf16(v0[2], v0[3]); w.z = cvt_pk_bf16(v1[0], v1[1]); w.w = cvt_pk_bf16(v1[2], v1[3]);
                    *(u32x4*)(rowp + bj * HALF) = w; } }
    }
};
struct EpiSwiGLU {
    static constexpr bool PERM = true, AFTER_DRAIN = false;
    bf16_t* O;
    __device__ __forceinline__ void operator()(const f32x4 (&acc)[2][2][4][2], const Unit& u, int wr, int wc, int fr, int fq) const {
        const int row0 = u.pm * BM + wr * 64 + fr, col0 = u.pn * HALF + wc * 32 + 8 * fq;
#pragma unroll
        for (int ai = 0; ai < 2; ++ai)
#pragma unroll
            for (int m = 0; m < 4; ++m) { bf16_t* rowp = O + (size_t)(row0 + ai * HALF + m * 16) * FF + col0;
                float r[8];
#pragma unroll
                for (int n = 0; n < 2; ++n)
#pragma unroll
                    for (int j = 0; j < 4; ++j) { const float g = acc[ai][0][m][n][j], up = acc[ai][1][m][n][j];
                        r[n * 4 + j] = g * __builtin_amdgcn_rcpf(1.0f + fexp2(-1.4426950408889634f * g)) * up; }
                u32x4 w; w.x = cvt_pk_bf16(r[0], r[1]); w.y = cvt_pk_bf16(r[2], r[3]); w.z = cvt_pk_bf16(r[4], r[5]); w.w = cvt_pk_bf16(r[6], r[7]);
                *(u32x4*)rowp = w; }
    }
};

template <class Epi, class Sched, bool ALIGN_EPI = false, bool SP2 = false>
__device__ __forceinline__ void gemm_phase(LAS unsigned char* lds, const Gemm g, const Sched& S, const Epi& E, const int tid) {
    const int wid = __builtin_amdgcn_readfirstlane(tid >> 6), lane = tid & 63, wr = wid >> 2, wc = wid & 3, fr = lane & 15, fq = lane >> 4;
    const int K = g.K, nt = K / BK;
    unsigned voffA[2], voffB[2];
#pragma unroll
    for (int i = 0; i < 2; ++i) { int R, C; stage_rc(tid * 16 + i * 8192, R, C); const int Rb = Epi::PERM ? ((R & ~31) + perm32(R & 31)) : R;
        voffA[i] = (unsigned)(R * K + C) * 2u; voffB[i] = (unsigned)(Rb * K + C) * 2u; }
    const size_t kstep = (size_t)(BK * 2);
    const size_t hstep = (size_t)HALF * K * 2;
    const size_t tstep = 2 * hstep;
    const unsigned ldsw = (unsigned)wid * 1024u;
    const int aoff = lds_byte(wr * 64 + fr, fq * 8), boff = lds_byte(wc * 32 + fr, fq * 8);
#define PG8_SA(b, h) (((b) * 2 + (h)) * HTB)
#define PG8_SB(b, h) ((4 + (b) * 2 + (h)) * HTB)
#define PG8_STAGE(bufoff, gbase, voff) do { _Pragma("unroll") for (int _i = 0; _i < 2; ++_i) \
        __builtin_amdgcn_global_load_lds((const unsigned*)((const char*)(gbase) + (voff)[_i]), (LAS unsigned*)(lds + (bufoff) + ldsw + _i * 8192), 16, 0, 0); } while (0)
#define PG8_LDA(dst, b, h) do { _Pragma("unroll") for (int m = 0; m < 4; ++m) _Pragma("unroll") for (int k = 0; k < 2; ++k) dst[m][k] = *(const LAS bf16x8*)(lds + PG8_SA(b, h) + aoff + m * 2048 + k * 1024); } while (0)
#define PG8_LDB(dst, b, h) do { _Pragma("unroll") for (int n = 0; n < 2; ++n) _Pragma("unroll") for (int k = 0; k < 2; ++k) dst[n][k] = *(const LAS bf16x8*)(lds + PG8_SB(b, h) + boff + n * 2048 + k * 1024); } while (0)
#define PG8_MMA(ai, bj, At, Bt) do { __builtin_amdgcn_s_setprio(1); _Pragma("unroll") for (int m = 0; m < 4; ++m) _Pragma("unroll") for (int n = 0; n < 2; ++n) _Pragma("unroll") for (int k = 0; k < 2; ++k) \
        acc[ai][bj][m][n] = __builtin_amdgcn_mfma_f32_16x16x32_bf16(Bt[n][k], At[m][k], acc[ai][bj][m][n], 0, 0, 0); __builtin_amdgcn_s_setprio(0); } while (0)
#define PG8_WAIT_V(n) asm volatile("s_waitcnt vmcnt(" #n ")" ::: "memory")
#define PG8_WAIT_L(n) asm volatile("s_waitcnt lgkmcnt(" #n ")" ::: "memory")
#define PG8_BAR __builtin_amdgcn_s_barrier()
#define PG8_SCHED __builtin_amdgcn_sched_barrier(0)
    Unit cur, nxt; int ui = 0;
    if (!S.next(0, cur)) return;
    f32x4 acc[2][2][4][2];
#pragma unroll
    for (int a = 0; a < 2; ++a)
#pragma unroll
        for (int b = 0; b < 2; ++b)
#pragma unroll
            for (int m = 0; m < 4; ++m)
#pragma unroll
                for (int n = 0; n < 2; ++n) acc[a][b][m][n] = (f32x4){0.f, 0.f, 0.f, 0.f};
    bf16x8 At[4][2], B0[2][2], B1[2][2];
    const char* cA = (const char*)g.A + (size_t)cur.pm * tstep; const char* cB = (const char*)g.Bt + (size_t)cur.pn * tstep;
    S.a_ready(cur);
    if constexpr (SP2) {
        PG8_STAGE(PG8_SB(0, 0), cB, voffB); PG8_STAGE(PG8_SB(0, 1), cB + hstep, voffB); PG8_STAGE(PG8_SA(0, 0), cA, voffA); PG8_STAGE(PG8_SA(0, 1), cA + hstep, voffA);
        if (wr == 1) PG8_BAR;
        PG8_WAIT_V(2); PG8_BAR;
        PG8_STAGE(PG8_SB(1, 0), cB + kstep, voffB); PG8_STAGE(PG8_SA(1, 0), cA + kstep, voffA); PG8_STAGE(PG8_SB(1, 1), cB + hstep + kstep, voffB);
        PG8_WAIT_V(6); PG8_BAR;
    } else {
        PG8_STAGE(PG8_SB(0, 0), cB, voffB); PG8_STAGE(PG8_SA(0, 0), cA, voffA); PG8_STAGE(PG8_SB(0, 1), cB + hstep, voffB); PG8_STAGE(PG8_SA(0, 1), cA + hstep, voffA);
        if (wr == 1) PG8_BAR;
        PG8_WAIT_V(4); PG8_BAR;
        PG8_STAGE(PG8_SB(1, 0), cB + kstep, voffB); PG8_STAGE(PG8_SA(1, 0), cA + kstep, voffA); PG8_STAGE(PG8_SB(1, 1), cB + hstep + kstep, voffB);
        PG8_WAIT_V(6); PG8_BAR;
    }
    for (;;) {
        const bool has_next = S.next(ui + 1, nxt);
        const char* nA = has_next ? (const char*)g.A + (size_t)nxt.pm * tstep : cA; const char* nB = has_next ? (const char*)g.Bt + (size_t)nxt.pn * tstep : cB;
        for (int t = 0; t < nt; t += 2) {
            const bool last = (t == nt - 2);
            const char* a1 = cA + (size_t)(t + 1) * kstep;
            const char* a2 = last ? nA : cA + (size_t)(t + 2) * kstep; const char* b2 = last ? nB : cB + (size_t)(t + 2) * kstep;
            const char* a3 = a2 + kstep; const char* b3 = b2 + kstep;
            if (last && has_next) S.a_ready(nxt);
            if constexpr (SP2) {
            PG8_LDB(B0, 0, 0); PG8_LDB(B1, 0, 1); PG8_SCHED; PG8_LDA(At, 0, 0); PG8_STAGE(PG8_SA(1, 1), a1 + hstep, voffA);
            PG8_WAIT_V(8); PG8_WAIT_L(0); PG8_BAR; PG8_MMA(0, 0, At, B0); PG8_MMA(0, 1, At, B1); PG8_BAR; PG8_SCHED;
            PG8_LDA(At, 0, 1); PG8_STAGE(PG8_SB(0, 0), b2, voffB); PG8_STAGE(PG8_SB(0, 1), b2 + hstep, voffB); PG8_STAGE(PG8_SA(0, 0), a2, voffA);
            PG8_WAIT_V(8); PG8_WAIT_L(0); PG8_BAR; PG8_MMA(1, 0, At, B0); PG8_MMA(1, 1, At, B1); PG8_BAR; PG8_SCHED;
            PG8_LDB(B0, 1, 0); PG8_LDB(B1, 1, 1); PG8_SCHED; PG8_LDA(At, 1, 0); PG8_STAGE(PG8_SA(0, 1), a2 + hstep, voffA);
            PG8_WAIT_V(8); PG8_WAIT_L(0); PG8_BAR; PG8_MMA(0, 0, At, B0); PG8_MMA(0, 1, At, B1); PG8_BAR; PG8_SCHED;
            PG8_LDA(At, 1, 1); PG8_STAGE(PG8_SB(1, 0), b3, voffB); PG8_STAGE(PG8_SB(1, 1), b3 + hstep, voffB); PG8_STAGE(PG8_SA(1, 0), a3, voffA);
            PG8_WAIT_V(8); PG8_WAIT_L(0); PG8_BAR; PG8_MMA(1, 0, At, B0); PG8_MMA(1, 1, At, B1); PG8_BAR; PG8_SCHED;
            } else {
            PG8_LDB(B0, 0, 0); PG8_SCHED; PG8_LDA(At, 0, 0); PG8_STAGE(PG8_SA(1, 1), a1 + hstep, voffA);
            PG8_WAIT_L(8); PG8_BAR; PG8_WAIT_L(0); PG8_MMA(0, 0, At, B0); PG8_BAR; PG8_SCHED;
            PG8_LDB(B1, 0, 1); PG8_STAGE(PG8_SB(0, 0), b2, voffB);
            PG8_BAR; PG8_WAIT_L(0); PG8_MMA(0, 1, At, B1); PG8_BAR;
            PG8_LDA(At, 0, 1); PG8_STAGE(PG8_SA(0, 0), a2, voffA);
            PG8_BAR; PG8_WAIT_L(0); PG8_MMA(1, 0, At, B0); PG8_BAR; PG8_SCHED;
            PG8_STAGE(PG8_SB(0, 1), b2 + hstep, voffB);
            PG8_WAIT_V(6); PG8_BAR; PG8_MMA(1, 1, At, B1); PG8_BAR;
            PG8_LDB(B0, 1, 0); PG8_SCHED; PG8_LDA(At, 1, 0); PG8_STAGE(PG8_SA(0, 1), a2 + hstep, voffA);
            PG8_WAIT_L(8); PG8_BAR; PG8_WAIT_L(0); PG8_MMA(0, 0, At, B0); PG8_BAR; PG8_SCHED;
            PG8_LDB(B1, 1, 1); PG8_STAGE(PG8_SB(1, 0), b3, voffB);
            PG8_BAR; PG8_WAIT_L(0); PG8_MMA(0, 1, At, B1); PG8_BAR;
            PG8_LDA(At, 1, 1); PG8_STAGE(PG8_SA(1, 0), a3, voffA);
            PG8_BAR; PG8_WAIT_L(0); PG8_MMA(1, 0, At, B0); PG8_BAR; PG8_SCHED;
            PG8_STAGE(PG8_SB(1, 1), b3 + hstep, voffB);
            PG8_WAIT_V(6); PG8_BAR; PG8_MMA(1, 1, At, B1); PG8_BAR;
            }
        }
        if constexpr (ALIGN_EPI) { if (wr == 0) PG8_BAR; }
        if constexpr (!Epi::AFTER_DRAIN) { E(acc, cur, wr, wc, fr, fq); S.done(cur); }
        if (!has_next) break;
#pragma unroll
        for (int a = 0; a < 2; ++a)
#pragma unroll
            for (int b = 0; b < 2; ++b)
#pragma unroll
                for (int m = 0; m < 4; ++m)
#pragma unroll
                    for (int n = 0; n < 2; ++n) acc[a][b][m][n] = (f32x4){0.f, 0.f, 0.f, 0.f};
        cur = nxt; cA = nA; cB = nB; ++ui;
        if constexpr (ALIGN_EPI) { if (wr == 1) PG8_BAR; }
    }
    PG8_WAIT_V(0);
    if constexpr (!ALIGN_EPI) { if (wr == 0) PG8_BAR; }
    PG8_BAR;
#undef PG8_SA
#undef PG8_SB
#undef PG8_STAGE
#undef PG8_LDA
#undef PG8_LDB
#undef PG8_MMA
#undef PG8_WAIT_V
#undef PG8_WAIT_L
#undef PG8_BAR
#undef PG8_SCHED
}
}

struct Args { const void* in[28]; float* out; unsigned char* ws; int ph_lo, ph_hi; int rep_attn, rep_fin, rep_prep, rep_pad; };

struct Ctx {
    LAS unsigned char* lds; LAS unsigned char* wlds;
    int tid, lane, wave, gw, ngw, G;
    unsigned char* ws;
};
constexpr int PTAB_OFF = 147456 - 256;
__device__ __forceinline__ const void* ldptr(LAS unsigned char* lds, int i) {
    volatile LAS unsigned* t = (volatile LAS unsigned*)(lds + PTAB_OFF) + 2 * i;
    const unsigned lo = __builtin_amdgcn_readfirstlane(t[0]), hi = __builtin_amdgcn_readfirstlane(t[1]);
    return (const void*)(((unsigned long long)hi << 32) | lo);
}
#define INP_F(i) ((const float*)ldptr(c.lds, (i)))

#define MFMA16(a, b, c) __builtin_amdgcn_mfma_f32_16x16x32_bf16((a), (b), (c), 0, 0, 0)

__device__ __forceinline__ void tr_item(const float* W, int K, int N, int nblk, bf16_t* WT, int mode, LAS float* scr, int item, int lane) {
    const int kb = item / nblk, nb = item % nblk, k0 = 64 * kb, n0 = 32 * nb;
    const int nn = n0 + (lane & 31);
#pragma unroll 8
    for (int i = 0; i < 32; ++i) { const int kk = 2 * i + (lane >> 5); scr[kk * 33 + (lane & 31)] = (nn < N) ? W[(size_t)(k0 + kk) * N + nn] : 0.f; }
    LDS_WAIT();
    const int row_off = mode == 0 ? 0 : ((n0 >> 7) * 128 + (mode == 2 ? 128 : 0));
    const int c = lane & 7;
#pragma unroll
    for (int j = 0; j < 4; ++j) { const int n = (lane >> 3) + 8 * j; const LAS float* s = scr + (8 * c) * 33 + n;
        u32x4 o; o.x = cvt_pk_bf16(s[0 * 33], s[1 * 33]); o.y = cvt_pk_bf16(s[2 * 33], s[3 * 33]); o.z = cvt_pk_bf16(s[4 * 33], s[5 * 33]); o.w = cvt_pk_bf16(s[6 * 33], s[7 * 33]);
        *(u32x4*)(WT + (size_t)(row_off + n0 + n) * K + k0 + 8 * c) = o; }
    LDS_WAIT();
}

__device__ __forceinline__ void norm_row_to_bf16(const float* xrow, const float* g, bf16_t* orow, int lane) {
    const f32x4* xr = (const f32x4*)xrow + lane; const f32x4* gr = (const f32x4*)g + lane;
    f32x4 v[4]; float s = 0.f;
#pragma unroll
    for (int j = 0; j < 4; ++j) { v[j] = xr[64 * j]; s += (v[j].x * v[j].x + v[j].y * v[j].y) + (v[j].z * v[j].z + v[j].w * v[j].w); }
    const float rs = 1.0f / sqrtf(wave_sum(s) * (1.f / DM) + EPS);
    u32x2* o8 = (u32x2*)orow + lane;
#pragma unroll
    for (int j = 0; j < 4; ++j) { const f32x4 gg = gr[64 * j]; u32x2 w; w.x = cvt_pk_bf16(v[j].x * rs * gg.x, v[j].y * rs * gg.y); w.y = cvt_pk_bf16(v[j].z * rs * gg.z, v[j].w * rs * gg.w); o8[64 * j] = w; }
}

constexpr int TR_BIG = 1408, TR_PER_LAYER = 6 * 1408 + 1152 + 512 + 8 + 16 + 128, TR_TOTAL = DEPTH * TR_PER_LAYER;

__device__ __forceinline__ void p0_prologue(const Ctx& c) {
    LAS float* scr = (LAS float*)c.wlds;
    unsigned char* ws = c.ws;
    for (int it = c.gw; it < TR_TOTAL; it += c.ngw) {
        const int l = it / TR_PER_LAYER; int r = it % TR_PER_LAYER;
        const float* src; bf16_t* dst; int K, N, nblk, mode = 0;
        if (r < 4 * TR_BIG) { const int q = r / TR_BIG; r -= q * TR_BIG; const int which = q >> 1, isup = q & 1;
            src = INP_F(which ? (isup ? 26 : 25) : (isup ? 5 : 4)) + (size_t)l * DM * FF; dst = (bf16_t*)(ws + WS_WGU + (size_t)(l * 2 + which) * SZ_WGU); K = DM; N = FF; nblk = FF / 32; mode = 1 + isup; }
        else if (r < 6 * TR_BIG) { r -= 4 * TR_BIG; const int which = r / TR_BIG; r -= which * TR_BIG;
            src = INP_F(which ? 27 : 6) + (size_t)l * DM * FF; dst = (bf16_t*)(ws + WS_WDN + (size_t)(l * 2 + which) * SZ_WDN); K = FF; N = DM; nblk = DM / 32; }
        else if (r < 6 * TR_BIG + 1152) { r -= 6 * TR_BIG; src = INP_F(9) + (size_t)l * DM * INC; dst = (bf16_t*)(ws + WS_WIN + (size_t)l * SZ_WIN); K = DM; N = INC; nblk = INP / 32; }
        else if (r < 6 * TR_BIG + 1152 + 512) { r -= 6 * TR_BIG + 1152; src = INP_F(10) + (size_t)l * DM * DM; dst = (bf16_t*)(ws + WS_WOUT + (size_t)l * SZ_WOUT); K = DM; N = DM; nblk = DM / 32; }
        else if (r < 6 * TR_BIG + 1152 + 512 + 8) { r -= 6 * TR_BIG + 1152 + 512; const int g = r >> 1; r &= 1;
            src = INP_F(11) + (size_t)(l * 4 + g) * 4096; dst = (bf16_t*)(ws + WS_WPOOL) + (size_t)(l * 4 + g) * 4096; K = 64; N = 64; nblk = 2; }
        else if (r < 6 * TR_BIG + 1152 + 512 + 8 + 16) { r -= 6 * TR_BIG + 1152 + 512 + 8; const int q = r >> 1; r &= 1; const int ri = q >> 2, h = q & 3;
            src = INP_F(ri ? 17 : 15) + (size_t)(l * 4 + h) * 4096; dst = (bf16_t*)(ws + WS_WLRU) + (size_t)((l * 2 + ri) * 4 + h) * 4096; K = 64; N = 64; nblk = 2; }
        else { r -= 6 * TR_BIG + 1152 + 512 + 8 + 16; const int kv = r >> 6; r &= 63;
            src = INP_F(kv ? 21 : 20) + (size_t)l * 2048 * 64; dst = (bf16_t*)(ws + WS_WCMP) + (size_t)(l * 2 + kv) * 64 * 2048; K = 2048; N = 64; nblk = 2; }
        tr_item(src, K, N, nblk, dst, mode, scr, r, c.lane);
    }
    {
        const int* pos = (const int*)ldptr(c.lds, 1); float* ct = (float*)(ws + WS_COS); float* st = (float*)(ws + WS_SIN);
        for (int e = c.gw * 64 + c.lane; e < M * 32; e += c.ngw * 64) {
            const int m = e >> 5, i = e & 31;
            const float inv = powf(10000.0f, -(float)(2 * i) / 64.0f);
            const float ang = (float)pos[m] * inv;
            const double ad = (double)ang; const double k = rint(ad * 0.15915494309189535); const float rr = (float)(ad - k * 6.283185307179586);
            ct[e] = cosf(rr); st[e] = sinf(rr);
        }
    }
    const float* x0 = INP_F(0); const float* g0 = INP_F(2);
    for (int m = c.gw; m < M; m += c.ngw) norm_row_to_bf16(x0 + (size_t)m * DM, g0, (bf16_t*)(ws + WS_A) + (size_t)m * DM, c.lane);
}

__device__ __forceinline__ void rowpass(const Ctx& c, const float* hin, float* hout, const bf16_t* f, const float* gpost, float coef, const float* gnext, bf16_t* aout) {
    const int lane = c.lane;
    for (int m = c.gw; m < M; m += c.ngw) {
        const u32x2* fr = (const u32x2*)(f + (size_t)m * DM) + lane;
        const f32x4* hr = (const f32x4*)(hin + (size_t)m * DM) + lane;
        f32x4 fv[4], hv[4]; float s = 0.f;
#pragma unroll
        for (int j = 0; j < 4; ++j) { const u32x2 w = fr[64 * j]; fv[j] = (f32x4){bflo(w.x), bfhi(w.x), bflo(w.y), bfhi(w.y)}; hv[j] = hr[64 * j];
            s += (fv[j].x * fv[j].x + fv[j].y * fv[j].y) + (fv[j].z * fv[j].z + fv[j].w * fv[j].w); }
        const float rs = coef / sqrtf(wave_sum(s) * (1.f / DM) + EPS);
        float s2 = 0.f;
#pragma unroll
        for (int j = 0; j < 4; ++j) { const f32x4 gg = ((const f32x4*)gpost + lane)[64 * j]; hv[j] = hv[j] + fv[j] * rs * gg;
            s2 += (hv[j].x * hv[j].x + hv[j].y * hv[j].y) + (hv[j].z * hv[j].z + hv[j].w * hv[j].w); }
        f32x4* ho = (f32x4*)(hout + (size_t)m * DM) + lane;
#pragma unroll
        for (int j = 0; j < 4; ++j) ho[64 * j] = hv[j];
        if (gnext) {
            const float rs2 = 1.0f / sqrtf(wave_sum(s2) * (1.f / DM) + EPS);
            u32x2* o8 = (u32x2*)(aout + (size_t)m * DM) + lane;
#pragma unroll
            for (int j = 0; j < 4; ++j) { const f32x4 gg = ((const f32x4*)gnext + lane)[64 * j]; u32x2 w; w.x = cvt_pk_bf16(hv[j].x * rs2 * gg.x, hv[j].y * rs2 * gg.y); w.y = cvt_pk_bf16(hv[j].z * rs2 * gg.z, hv[j].w * rs2 * gg.w); o8[64 * j] = w; }
        }
    }
}

__device__ __forceinline__ void unpack8(const bf16x8 v, float* f) {
    const u32x4 w = __builtin_bit_cast(u32x4, v);
    f[0] = bflo(w.x); f[1] = bfhi(w.x); f[2] = bflo(w.y); f[3] = bfhi(w.y); f[4] = bflo(w.z); f[5] = bfhi(w.z); f[6] = bflo(w.w); f[7] = bfhi(w.w);
}
__device__ __forceinline__ bf16x8 pack8(const float* f) {
    u32x4 w; w.x = cvt_pk_bf16(f[0], f[1]); w.y = cvt_pk_bf16(f[2], f[3]); w.z = cvt_pk_bf16(f[4], f[5]); w.w = cvt_pk_bf16(f[6], f[7]);
    return __builtin_bit_cast(bf16x8, w);
}

__device__ __forceinline__ void rope_unit(const Ctx& c, int tile) {
    const bf16_t* proj = (const bf16_t*)(c.ws + WS_HID); bf16_t* Qr = (bf16_t*)(c.ws + WS_QR);
    const float* ct = (const float*)(c.ws + WS_COS); const float* st = (const float*)(c.ws + WS_SIN);
    const int lane = c.lane, i0 = (lane & 7) * 4;
    for (int tt = 0; tt < 16; ++tt) {
        const int tg = tile * 16 + tt; const int b = tg / SEQ, t = tg % SEQ;
        const f32x4 cs = *(const f32x4*)(ct + (size_t)tg * 32 + i0), sn = *(const f32x4*)(st + (size_t)tg * 32 + i0);
        {
            const int head = lane >> 3; const bf16_t* src = proj + (size_t)tg * INP + C_Q + head * 64 + i0;
            const u32x2 a = *(const u32x2*)src, bb = *(const u32x2*)(src + 32);
            const f32x4 x1 = (f32x4){bflo(a.x), bfhi(a.x), bflo(a.y), bfhi(a.y)}, x2 = (f32x4){bflo(bb.x), bfhi(bb.x), bflo(bb.y), bfhi(bb.y)};
            const f32x4 o1 = (x1 * cs - x2 * sn) * QSCALE, o2 = (x2 * cs + x1 * sn) * QSCALE;
            bf16_t* dst = Qr + (size_t)tg * 512 + head * 64 + i0;
            u32x2 w; w.x = cvt_pk_bf16(o1.x, o1.y); w.y = cvt_pk_bf16(o1.z, o1.w); *(u32x2*)dst = w;
            w.x = cvt_pk_bf16(o2.x, o2.y); w.y = cvt_pk_bf16(o2.z, o2.w); *(u32x2*)(dst + 32) = w;
        }
        if (lane < 32) {
            const int arr = lane >> 4, kvh = (lane >> 3) & 1; const bf16_t* src = proj + (size_t)tg * INP + (arr ? C_KW : C_KS) + kvh * 64 + i0;
            const u32x2 a = *(const u32x2*)src, bb = *(const u32x2*)(src + 32);
            const f32x4 x1 = (f32x4){bflo(a.x), bfhi(a.x), bflo(a.y), bfhi(a.y)}, x2 = (f32x4){bflo(bb.x), bfhi(bb.x), bflo(bb.y), bfhi(bb.y)};
            const f32x4 o1 = x1 * cs - x2 * sn, o2 = x2 * cs + x1 * sn;
            bf16_t* dst = (bf16_t*)(c.ws + (arr ? WS_KW : WS_KS)) + ((size_t)(b * 2 + kvh) * SEQ + t) * 64 + i0;
            u32x2 w; w.x = cvt_pk_bf16(o1.x, o1.y); w.y = cvt_pk_bf16(o1.z, o1.w); *(u32x2*)dst = w;
            w.x = cvt_pk_bf16(o2.x, o2.y); w.y = cvt_pk_bf16(o2.z, o2.w); *(u32x2*)(dst + 32) = w;
        }
    }
}
__device__ __forceinline__ void vt_unit(const Ctx& c, int u) {
    const int tile = u & 255, bk = (u >> 8) & 3, arr = u >> 10; const int b = bk >> 1, kvh = bk & 1, t0 = tile * 64;
    const bf16_t* src = (const bf16_t*)(c.ws + WS_HID) + (size_t)(b * SEQ + t0) * INP + (arr ? C_VW : C_VS) + kvh * 64 + c.lane;
    bf16_t* dst = (bf16_t*)(c.ws + (arr ? WS_VWT : WS_VST)) + (((size_t)bk * 256 + tile) * 64 + c.lane) * 64;
#pragma unroll
    for (int q = 0; q < 8; ++q) {
        unsigned w[4];
#pragma unroll
        for (int e = 0; e < 4; ++e) { const unsigned lo = src[(size_t)(q * 8 + 2 * e) * INP], hi = src[(size_t)(q * 8 + 2 * e + 1) * INP]; w[e] = lo | (hi << 16); }
        *(u32x4*)(dst + q * 8) = (u32x4){w[0], w[1], w[2], w[3]};
    }
}
__device__ __forceinline__ void pool_unit(const Ctx& c, int u, int layer, const float* pool_scale) {
    const int gp = u & 3, tile = u >> 2; const int lane = c.lane, r16 = lane & 15, g = lane >> 4;
    const int tg = tile * 16 + r16, b = tg / SEQ, t = tg % SEQ; const int w = 2 << gp;
    const bf16_t* proj = (const bf16_t*)(c.ws + WS_HID);
    const bf16_t* WpT = (const bf16_t*)(c.ws + WS_WPOOL) + (size_t)(layer * 4 + gp) * 4096;
    bf16x8 Df[2];
    const int cnt = (t + 1 < w) ? t + 1 : w; const float icnt = 1.0f / (float)cnt;
#pragma unroll
    for (int ks = 0; ks < 2; ++ks) {
        const bf16_t* p = proj + (size_t)(b * SEQ + t) * INP + C_XP + gp * 64 + ks * 32 + g * 8;
        float sum[8], x0[8];
        unpack8(*(const bf16x8*)p, x0);
#pragma unroll
        for (int e = 0; e < 8; ++e) sum[e] = x0[e];
        for (int s = 1; s < cnt; ++s) { float xv[8]; unpack8(*(const bf16x8*)(p - (size_t)s * INP), xv);
#pragma unroll
            for (int e = 0; e < 8; ++e) sum[e] += xv[e]; }
        float d[8];
#pragma unroll
        for (int e = 0; e < 8; ++e) d[e] = sum[e] * icnt - x0[e];
        Df[ks] = pack8(d);
    }
    bf16_t* out = (bf16_t*)(c.ws + WS_A) + (size_t)tg * DM + gp * 64;
#pragma unroll
    for (int jt = 0; jt < 4; ++jt) {
        f32x4 acc = (f32x4){0.f, 0.f, 0.f, 0.f};
#pragma unroll
        for (int ks = 0; ks < 2; ++ks) { const bf16x8 wf = *(const bf16x8*)(WpT + (size_t)(16 * jt + r16) * 64 + ks * 32 + g * 8); acc = MFMA16(wf, Df[ks], acc); }
        const f32x4 sc = *(const f32x4*)(pool_scale + gp * 64 + 16 * jt + 4 * g);
        u32x2 o; o.x = cvt_pk_bf16(acc[0] * sc[0], acc[1] * sc[1]); o.y = cvt_pk_bf16(acc[2] * sc[2], acc[3] * sc[3]);
        *(u32x2*)(out + 16 * jt + 4 * g) = o;
    }
}
__device__ __forceinline__ void lru_unit(const Ctx& c, int u, int layer, const float* conv_w, const float* conv_b, const float* b_r, const float* b_i, const float* lam) {
    const int hh = u & 3, ch = (u >> 2) % LRU_NCH, b = (u >> 2) / LRU_NCH;
    const int lane = c.lane, r16 = lane & 15, g = lane >> 4;
    const bf16_t* proj = (const bf16_t*)(c.ws + WS_HID);
    const bf16_t* WrT = (const bf16_t*)(c.ws + WS_WLRU) + (size_t)((layer * 2 + 0) * 4 + hh) * 4096;
    const bf16_t* WiT = (const bf16_t*)(c.ws + WS_WLRU) + (size_t)((layer * 2 + 1) * 4 + hh) * 4096;
    float* HL = (float*)(c.ws + WS_F); float* CA = HL + (size_t)M * 256;
    float n8sp[4][4], hcar[4][4], acar[4][4];
#pragma unroll
    for (int jt = 0; jt < 4; ++jt)
#pragma unroll
        for (int jj = 0; jj < 4; ++jj) { const float L = lam[hh * 64 + 16 * jt + 4 * g + jj]; n8sp[jt][jj] = -8.0f * log1pf(__expf(-L)); hcar[jt][jj] = 0.f; acar[jt][jj] = 1.f; }
    for (int tile = 0; tile < LRU_CHUNK / 16; ++tile) {
        const int t = ch * LRU_CHUNK + tile * 16 + r16; const size_t tg = (size_t)b * SEQ + t;
        bf16x8 Xf[2];
#pragma unroll
        for (int ks = 0; ks < 2; ++ks) {
            const int c0 = hh * 64 + ks * 32 + g * 8; float acc8[8];
            { const f32x4 b0 = *(const f32x4*)(conv_b + c0), b1 = *(const f32x4*)(conv_b + c0 + 4); acc8[0] = b0[0]; acc8[1] = b0[1]; acc8[2] = b0[2]; acc8[3] = b0[3]; acc8[4] = b1[0]; acc8[5] = b1[1]; acc8[6] = b1[2]; acc8[7] = b1[3]; }
#pragma unroll
            for (int k = 0; k < 4; ++k) { const int tt = t - 3 + k;
                if (tt >= 0) { float xv[8]; unpack8(*(const bf16x8*)(proj + ((size_t)b * SEQ + tt) * INP + C_XL + c0), xv);
                    const f32x4 w0 = *(const f32x4*)(conv_w + k * 256 + c0), w1 = *(const f32x4*)(conv_w + k * 256 + c0 + 4);
                    acc8[0] += w0[0] * xv[0]; acc8[1] += w0[1] * xv[1]; acc8[2] += w0[2] * xv[2]; acc8[3] += w0[3] * xv[3];
                    acc8[4] += w1[0] * xv[4]; acc8[5] += w1[1] * xv[5]; acc8[6] += w1[2] * xv[6]; acc8[7] += w1[3] * xv[7]; } }
            Xf[ks] = pack8(acc8);
        }
#pragma unroll
        for (int jt = 0; jt < 4; ++jt) {
            f32x4 aR = (f32x4){0.f, 0.f, 0.f, 0.f}, aI = (f32x4){0.f, 0.f, 0.f, 0.f};
#pragma unroll
            for (int ks = 0; ks < 2; ++ks) { const size_t wo = (size_t)(16 * jt + r16) * 64 + ks * 32 + g * 8;
                aR = MFMA16(*(const bf16x8*)(WrT + wo), Xf[ks], aR); aI = MFMA16(*(const bf16x8*)(WiT + wo), Xf[ks], aI); }
            const int c4 = hh * 64 + 16 * jt + 4 * g;
            f32x4 xc = *(const f32x4*)(conv_b + c4);
#pragma unroll
            for (int k = 0; k < 4; ++k) { const int tt = t - 3 + k;
                if (tt >= 0) { const u32x2 xw = *(const u32x2*)(proj + ((size_t)b * SEQ + tt) * INP + C_XL + c4); const f32x4 w4 = *(const f32x4*)(conv_w + k * 256 + c4);
                    xc[0] += w4[0] * bflo(xw.x); xc[1] += w4[1] * bfhi(xw.x); xc[2] += w4[2] * bflo(xw.y); xc[3] += w4[3] * bfhi(xw.y); } }
            const f32x4 br4 = *(const f32x4*)(b_r + c4), bi4 = *(const f32x4*)(b_i + c4);
            f32x4 hv, cv;
#pragma unroll
            for (int jj = 0; jj < 4; ++jj) {
                const float r = sigmoidf_(aR[jj] + br4[jj]), ii = sigmoidf_(aI[jj] + bi4[jj]);
                const float la = n8sp[jt][jj] * r; float av = __expf(la); float bv = sqrtf(fmaxf(-expm1f(2.0f * la), 0.f)) * (ii * xc[jj]);
#pragma unroll
                for (int d = 1; d < 16; d <<= 1) { const float ap = __shfl_up(av, d, 16), bp = __shfl_up(bv, d, 16); if (r16 >= d) { bv = av * bp + bv; av = av * ap; } }
                const float h = av * hcar[jt][jj] + bv, ca = av * acar[jt][jj];
                hv[jj] = h; cv[jj] = ca;
                hcar[jt][jj] = __shfl(h, 15, 16); acar[jt][jj] = __shfl(ca, 15, 16);
            }
            *(f32x4*)(HL + tg * 256 + c4) = hv; *(f32x4*)(CA + tg * 256 + c4) = cv;
        }
    }
    if (r16 == 15) {
        float* carA = (float*)(c.ws + WS_CARA) + (size_t)(b * LRU_NCH + ch) * 256; float* carH = (float*)(c.ws + WS_CARH) + (size_t)(b * LRU_NCH + ch) * 256;
#pragma unroll
        for (int jt = 0; jt < 4; ++jt) { const int c4 = hh * 64 + 16 * jt + 4 * g;
            *(f32x4*)(carA + c4) = (f32x4){acar[jt][0], acar[jt][1], acar[jt][2], acar[jt][3]}; *(f32x4*)(carH + c4) = (f32x4){hcar[jt][0], hcar[jt][1], hcar[jt][2], hcar[jt][3]}; }
    }
}
__device__ __forceinline__ void cmp_unit(const Ctx& c, int u, int layer, const float* pe) {
    const int nt_ = u & 63, bk = (u >> 6) & 3, kv = u >> 8; const int b = bk >> 1, kvh = bk & 1;
    const int lane = c.lane, r16 = lane & 15, g = lane >> 4;
    const bf16_t* proj = (const bf16_t*)(c.ws + WS_HID);
    const bf16_t* WT = (const bf16_t*)(c.ws + WS_WCMP) + (size_t)(layer * 2 + kv) * 64 * 2048;
    const float* ct = (const float*)(c.ws + WS_COS); const float* st = (const float*)(c.ws + WS_SIN);
    const int n = nt_ * 16 + r16; const int colb = (kv ? C_VC : C_KC) + kvh * 64;
    f32x4 acc[4];
#pragma unroll
    for (int e = 0; e < 4; ++e) acc[e] = (f32x4){0.f, 0.f, 0.f, 0.f};
    for (int l = 0; l < 32; ++l) {
        int t = 16 * n + l; if (t > SEQ - 1) t = SEQ - 1;
        const size_t tg = (size_t)b * SEQ + t;
        float x1[8], x2[8];
        unpack8(*(const bf16x8*)(proj + tg * INP + colb + g * 8), x1); unpack8(*(const bf16x8*)(proj + tg * INP + colb + 32 + g * 8), x2);
        float o1[8], o2[8];
        if (kv == 0) {
            const f32x4 c0 = *(const f32x4*)(ct + tg * 32 + g * 8), c1 = *(const f32x4*)(ct + tg * 32 + g * 8 + 4), s0 = *(const f32x4*)(st + tg * 32 + g * 8), s1 = *(const f32x4*)(st + tg * 32 + g * 8 + 4);
#pragma unroll
            for (int e = 0; e < 8; ++e) { const float cc = e < 4 ? c0[e & 3] : c1[e & 3], ss = e < 4 ? s0[e & 3] : s1[e & 3]; o1[e] = x1[e] * cc - x2[e] * ss; o2[e] = x2[e] * cc + x1[e] * ss; }
        } else {
#pragma unroll
            for (int e = 0; e < 8; ++e) { o1[e] = x1[e]; o2[e] = x2[e]; }
        }
        { const f32x4 p0 = *(const f32x4*)(pe + l * 64 + g * 8), p1 = *(const f32x4*)(pe + l * 64 + g * 8 + 4), p2 = *(const f32x4*)(pe + l * 64 + 32 + g * 8), p3 = *(const f32x4*)(pe + l * 64 + 32 + g * 8 + 4);
#pragma unroll
            for (int e = 0; e < 4; ++e) { o1[e] += p0[e]; o1[4 + e] += p1[e]; o2[e] += p2[e]; o2[4 + e] += p3[e]; } }
        const bf16x8 X0 = pack8(o1), X1 = pack8(o2);
#pragma unroll
        for (int et = 0; et < 4; ++et) {
            const bf16_t* wp = WT + (size_t)(16 * et + r16) * 2048 + l * 64 + g * 8;
            const bf16x8 W0 = *(const bf16x8*)wp, W1 = *(const bf16x8*)(wp + 32);
            if (kv == 0) { acc[et] = MFMA16(W0, X0, acc[et]); acc[et] = MFMA16(W1, X1, acc[et]); }
            else         { acc[et] = MFMA16(X0, W0, acc[et]); acc[et] = MFMA16(X1, W1, acc[et]); }
        }
    }
    if (kv == 0) {
        bf16_t* dst = (bf16_t*)(c.ws + WS_KCMP) + ((size_t)bk * 1024 + n) * 64;
        const bool z = (n >= 1023);
#pragma unroll
        for (int et = 0; et < 4; ++et) { u32x2 o; o.x = cvt_pk_bf16(acc[et][0], acc[et][1]); o.y = cvt_pk_bf16(acc[et][2], acc[et][3]); if (z) { o.x = 0u; o.y = 0u; } *(u32x2*)(dst + 16 * et + 4 * g) = o; }
    } else {
        bf16_t* dst = (bf16_t*)(c.ws + WS_VCMPT) + (size_t)bk * 64 * 1024;
        const int nb = nt_ * 16 + 4 * g;
#pragma unroll
        for (int et = 0; et < 4; ++et) { float v3 = acc[et][3]; if (nb + 3 >= 1023) v3 = 0.f; u32x2 o; o.x = cvt_pk_bf16(acc[et][0], acc[et][1]); o.y = cvt_pk_bf16(acc[et][2], v3); *(u32x2*)(dst + ((size_t)(nb >> 6) * 64 + 16 * et + r16) * 64 + (nb & 63)) = o; }
    }
}

constexpr int NU_LRU = BATCH * LRU_NCH * 4, NU_CMP = 512, NU_POOL = (M / 16) * 4, NU_ROPE = M / 16, NU_VT = 2048;
__device__ __forceinline__ void phase_prep(const Ctx& c, int layer) {
    const float* pool_scale = INP_F(12) + layer * 256;
    const float* conv_w = INP_F(13) + layer * 1024; const float* conv_b = INP_F(14) + layer * 256;
    const float* b_r = INP_F(16) + layer * 256; const float* b_i = INP_F(18) + layer * 256; const float* lam = INP_F(19) + layer * 256;
    const float* pe = INP_F(22) + layer * 2048;
    for (int u = c.gw; u < NU_LRU; u += c.ngw) lru_unit(c, u, layer, conv_w, conv_b, b_r, b_i, lam);
    for (int u = c.gw; u < NU_CMP; u += c.ngw) cmp_unit(c, u, layer, pe);
    for (int u = c.gw; u < NU_VT; u += c.ngw) vt_unit(c, u);
    for (int u = c.gw; u < NU_ROPE; u += c.ngw) rope_unit(c, u);
    for (int u = c.gw; u < NU_POOL; u += c.ngw) pool_unit(c, u, layer, pool_scale);
}

constexpr int NCG = 2, QPW = 4 * NCG;
struct AttnRegs { f32x4 O[4][NCG]; float m[NCG], l[NCG]; };

__device__ __forceinline__ void attn_reset(AttnRegs& R) {
#pragma unroll
    for (int md = 0; md < 4; ++md)
#pragma unroll
        for (int cg_ = 0; cg_ < NCG; ++cg_) R.O[md][cg_] = (f32x4){0.f, 0.f, 0.f, 0.f};
#pragma unroll
    for (int cg_ = 0; cg_ < NCG; ++cg_) { R.m[cg_] = -1e30f; R.l[cg_] = 0.f; }
}

constexpr int ATT_SLOT = 16384, ATT_WBASE = 2 * ATT_SLOT, ATT_WLDS = 9216;
#define ATT_BAR() do { asm volatile("s_waitcnt lgkmcnt(0)" ::: "memory"); __builtin_amdgcn_s_barrier(); asm volatile("" ::: "memory"); } while (0)

template <int CTRL> __device__ __forceinline__ int dpp_i(int v) { return __builtin_amdgcn_update_dpp(v, v, CTRL, 0xF, 0xF, false); }
template <int CTRL> __device__ __forceinline__ float dpp_f(float v) { return __int_as_float(dpp_i<CTRL>(__float_as_int(v))); }
__device__ __forceinline__ int row16_sum(int v) { v += dpp_i<0xB1>(v); v += dpp_i<0x4E>(v); v += dpp_i<0x141>(v); v += dpp_i<0x140>(v); return v; }
__device__ __forceinline__ float rowmax4(float x) {
    auto r = __builtin_amdgcn_permlane16_swap(__float_as_uint(x), __float_as_uint(x), false, false);
    const float a = fmaxf(__uint_as_float(r[0]), __uint_as_float(r[1]));
    auto q = __builtin_amdgcn_permlane32_swap(__float_as_uint(a), __float_as_uint(a), false, false);
    return fmaxf(__uint_as_float(q[0]), __uint_as_float(q[1]));
}
__device__ __forceinline__ float rowsum4(float x) {
    auto r = __builtin_amdgcn_permlane16_swap(__float_as_uint(x), __float_as_uint(x), false, false);
    const float a = __uint_as_float(r[0]) + __uint_as_float(r[1]);
    auto q = __builtin_amdgcn_permlane32_swap(__float_as_uint(a), __float_as_uint(a), false, false);
    return __uint_as_float(q[0]) + __uint_as_float(q[1]);
}

template <int MODE, bool MASKED>
__device__ __forceinline__ void attn_tile64(AttnRegs& R, const bf16x8 (&Qf)[NCG][2], LAS unsigned char* slot, int kb0, unsigned act, int tq_base, const unsigned (&selw)[NCG], int bit,
                                            int lane, LAS float* imp, int qi, int hg) {
    const int r16 = lane & 15, g = lane >> 4;
    const int fK = (r16 >> 2) | (((r16 >> 1) & 1) << 2), fV = (r16 >> 1) & 7;
    const int krow = 8 * (r16 >> 2) + (r16 & 3);
    LAS unsigned char* kp0 = slot + krow * 128 + ((g ^ fK) << 4);
    LAS unsigned char* kp1 = slot + krow * 128 + (((4 + g) ^ fK) << 4);
    LAS unsigned char* vp0 = slot + 8192 + r16 * 128 + ((g ^ fV) << 4);
    LAS unsigned char* vp1 = slot + 8192 + r16 * 128 + (((4 + g) ^ fV) << 4);
#pragma unroll
    for (int cg_ = 0; cg_ < NCG; ++cg_) {
        if (!(act & (1u << cg_))) continue;
        float s[16];
#pragma unroll
        for (int half = 0; half < 2; ++half) {
            const bf16x8 k00 = *(const LAS bf16x8*)(kp0 + half * 4096), k01 = *(const LAS bf16x8*)(kp1 + half * 4096);
            const bf16x8 k10 = *(const LAS bf16x8*)(kp0 + half * 4096 + 512), k11 = *(const LAS bf16x8*)(kp1 + half * 4096 + 512);
            f32x4 s0 = (f32x4){0.f, 0.f, 0.f, 0.f}, s1 = (f32x4){0.f, 0.f, 0.f, 0.f};
            s0 = MFMA16(k00, Qf[cg_][0], s0); s1 = MFMA16(k10, Qf[cg_][0], s1);
            s0 = MFMA16(k01, Qf[cg_][1], s0); s1 = MFMA16(k11, Qf[cg_][1], s1);
#pragma unroll
            for (int j = 0; j < 4; ++j) { s[half * 8 + j] = s0[j]; s[half * 8 + 4 + j] = s1[j]; }
        }
        const int tq = tq_base + 4 * cg_;
        if (MASKED) {
#pragma unroll
            for (int i = 0; i < 16; ++i) { const int key = kb0 + 32 * (i >> 3) + 8 * g + (i & 7); bool ok;
                if (MODE == 0) ok = (key <= tq) && (tq - key < 512);
                else if (MODE == 1) ok = (key <= tq);
                else ok = (16 * key + 31 <= tq);
                s[i] = ok ? s[i] : -INFINITY; }
        }
        const bool lane_on = (MODE == 1) ? (((selw[cg_] >> bit) & 1u) != 0u) : true;
        float p[16];
        if (MODE == 2) {
            const float mm = R.m[cg_], il = R.l[cg_];
#pragma unroll
            for (int i = 0; i < 16; ++i) p[i] = fexp2(s[i] - mm) * il;
#pragma unroll
            for (int half = 0; half < 2; ++half) {
                float ps[8];
#pragma unroll
                for (int i = 0; i < 8; ++i) { float v = p[half * 8 + i]; v += dpp_f<0xB1>(v); v += dpp_f<0x4E>(v); ps[i] = v; }
                if (hg == 0) {
                    const int jb = (kb0 + 32 * half + 8 * g) >> 2; LAS float* ip = imp + (4 * cg_ + qi) * 256 + jb;
                    __hip_atomic_fetch_add(ip, (ps[0] + ps[1]) + (ps[2] + ps[3]), __ATOMIC_RELAXED, __HIP_MEMORY_SCOPE_WORKGROUP);
                    if (jb + 1 < 256) __hip_atomic_fetch_add(ip + 1, ps[3] + (ps[4] + ps[5]) + (ps[6] + ps[7]), __ATOMIC_RELAXED, __HIP_MEMORY_SCOPE_WORKGROUP);
                    if (jb + 2 < 256) __hip_atomic_fetch_add(ip + 2, ps[7], __ATOMIC_RELAXED, __HIP_MEMORY_SCOPE_WORKGROUP);
                }
            }
        } else {
            float mx = fmaxf(fmaxf(fmaxf(s[0], s[1]), s[2]), fmaxf(fmaxf(s[3], s[4]), s[5])); mx = fmaxf(fmaxf(mx, s[6]), s[7]);
            float my = fmaxf(fmaxf(fmaxf(s[8], s[9]), s[10]), fmaxf(fmaxf(s[11], s[12]), s[13])); my = fmaxf(fmaxf(my, s[14]), s[15]);
            mx = fmaxf(mx, my);
            if (MODE == 1) mx = lane_on ? mx : -INFINITY;
            mx = rowmax4(mx);
            const float mold = R.m[cg_], mnew = fmaxf(mold, mx);
            if (__builtin_amdgcn_ballot_w64(mnew > mold) != 0ull) {
                const float alpha = fexp2(mold - mnew); R.m[cg_] = mnew; R.l[cg_] *= alpha;
                if (MODE != 3) {
#pragma unroll
                    for (int md = 0; md < 4; ++md) R.O[md][cg_] = R.O[md][cg_] * alpha;
                }
            }
            const float msub = ((MODE == 1) && !lane_on) ? INFINITY : mnew;
            float sum0 = 0.f, sum1 = 0.f;
#pragma unroll
            for (int i = 0; i < 8; ++i) { p[i] = fexp2(s[i] - msub); sum0 += p[i]; p[8 + i] = fexp2(s[8 + i] - msub); sum1 += p[8 + i]; }
            R.l[cg_] += sum0 + sum1;
        }
        if (MODE != 3) {
            const bf16x8 P0 = pack8(p), P1 = pack8(p + 8);
#pragma unroll
            for (int md = 0; md < 4; ++md) { const bf16x8 v0 = *(const LAS bf16x8*)(vp0 + md * 2048), v1 = *(const LAS bf16x8*)(vp1 + md * 2048);
                R.O[md][cg_] = MFMA16(v0, P0, R.O[md][cg_]); R.O[md][cg_] = MFMA16(v1, P1, R.O[md][cg_]); }
        }
    }
}

template <int MODE>
__device__ __forceinline__ void attn_stream(AttnRegs& R, const bf16x8 (&Qf)[NCG][2], LAS unsigned char* ring, const bf16_t* Kg, const bf16_t* Vg, int ldv, int t0, int nt, int tq_base,
                                            LAS unsigned* msk, LAS unsigned* uni, LAS float* imp, int tid, int lane, int qi, int hg) {
    constexpr bool HASV = (MODE != 3);
    const int tq_min_ = __builtin_amdgcn_readfirstlane(tq_base - qi), qb_ = tq_min_ >> 6;
    const int row = tid >> 3, cpos = tid & 7;
    const int cK = cpos ^ (((row >> 3) & 3) | (((row >> 1) & 1) << 2)), cV = cpos ^ ((row >> 1) & 7);
    const unsigned offk = (unsigned)(row * 64 + cK * 8) * 2u, offv = (unsigned)(row * 64 + cV * 8) * 2u;
    const char* gk = (const char*)Kg + (size_t)t0 * 8192; const char* gv = (const char*)Vg + (size_t)t0 * 8192;
    u32x4 ka = *(const u32x4*)(gk + offk), va = (u32x4){0u, 0u, 0u, 0u}, kb2 = (u32x4){0u, 0u, 0u, 0u}, vb2 = (u32x4){0u, 0u, 0u, 0u};
    if (HASV) va = *(const u32x4*)(gv + offv);
    *(LAS u32x4*)(ring + tid * 16) = ka; if (HASV) *(LAS u32x4*)(ring + 8192 + tid * 16) = va;
    if (nt > 1) { ka = *(const u32x4*)(gk + 8192 + offk); if (HASV) va = *(const u32x4*)(gv + 8192 + offv); }
    ATT_BAR();
    unsigned selw[NCG];
#pragma unroll
    for (int cg_ = 0; cg_ < NCG; ++cg_) selw[cg_] = 0u;
#define ATT_STEP(I, PK, PV, WK, WV) do { \
        if ((I) + 2 < nt) { PK = *(const u32x4*)(gk + (size_t)((I) + 2) * 8192 + offk); if (HASV) PV = *(const u32x4*)(gv + (size_t)((I) + 2) * 8192 + offv); } \
        LAS unsigned char* slot = ring + ((I) & 1) * ATT_SLOT; \
        const int tile = t0 + (I); \
        unsigned act = (1u << NCG) - 1u; int bit = 0; \
        if (MODE == 1) { const int w = tile >> 5; bit = tile & 31; act = 0u; \
            _Pragma("unroll") for (int cg_ = 0; cg_ < NCG; ++cg_) { act |= ((__builtin_amdgcn_readfirstlane(uni[8 + cg_ * 8 + w]) >> bit) & 1u) << cg_; selw[cg_] = msk[(4 * cg_ + qi) * 8 + w]; } } \
        bool masked_; \
        if (MODE == 0) masked_ = (tile == qb_) || (tile == qb_ - 8); \
        else if (MODE == 1) masked_ = (tile == qb_); \
        else masked_ = (16 * (64 * tile + 63) + 31 > tq_min_); \
        if (act) { if (masked_) attn_tile64<MODE, true>(R, Qf, slot, tile * 64, act, tq_base, selw, bit, lane, imp, qi, hg); \
                   else attn_tile64<MODE, false>(R, Qf, slot, tile * 64, act, tq_base, selw, bit, lane, imp, qi, hg); } \
        if ((I) + 1 < nt) { LAS unsigned char* ns = ring + (((I) + 1) & 1) * ATT_SLOT; *(LAS u32x4*)(ns + tid * 16) = WK; if (HASV) *(LAS u32x4*)(ns + 8192 + tid * 16) = WV; } \
        ATT_BAR(); } while (0)
    for (int i = 0; i < nt; i += 2) {
        ATT_STEP(i, kb2, vb2, ka, va);
        if (i + 1 >= nt) break;
        ATT_STEP(i + 1, ka, va, kb2, vb2);
    }
#undef ATT_STEP
}

template <int MODE, bool NORM>
__device__ __forceinline__ void attn_flush(AttnRegs& R, LAS float* ofin, const bf16_t* gp  , bf16_t* outp, int lane) {
#pragma unroll
    for (int cg_ = 0; cg_ < NCG; ++cg_) {
        float sc = sigmoidf_(bf1(gp[(size_t)(4 * cg_) * INP]));
        if (NORM) { const float L = rowsum4(R.l[cg_]); sc = L > 0.f ? sc / L : 0.f; }
#pragma unroll
        for (int md = 0; md < 4; ++md) {
            f32x4 v = R.O[md][cg_] * sc;
            LAS f32x4* slot = (LAS f32x4*)ofin + (md * NCG + cg_) * 64 + lane;
            if (MODE != 0) v = v + *slot;
            if (MODE != 2) *slot = v;
            else { u32x2 o; o.x = cvt_pk_bf16(v[0], v[1]); o.y = cvt_pk_bf16(v[2], v[3]); *(u32x2*)(outp + (size_t)(4 * cg_) * DM + 16 * md) = o; }
        }
    }
}

__device__ __forceinline__ void attn_unit(const Ctx& c, int bk, int qb) {
    const int lane = c.lane, r16 = lane & 15, g = lane >> 4, qi = r16 >> 2, hg = r16 & 3;
    const int b = bk >> 1, kvh = bk & 1;
    const int tq0 = qb * 64 + c.wave * QPW, cur = qb, head = kvh * 4 + hg;
    LAS unsigned char* ring = c.lds;
    LAS unsigned char* wl = c.lds + ATT_WBASE + c.wave * ATT_WLDS;
    unsigned char* wsu = c.ws; asm volatile("" : "+s"(wsu));
    LAS float* imp = (LAS float*)wl;
    LAS unsigned* msk = (LAS unsigned*)(wl + 8192);
    LAS unsigned* uni = (LAS unsigned*)(wl + 8192 + 256);
    const bf16_t* proj = (const bf16_t*)(wsu + WS_HID);
    const bf16_t* Qr = (const bf16_t*)(wsu + WS_QR);
    bf16x8 Qf[NCG][2];
#pragma unroll
    for (int cg_ = 0; cg_ < NCG; ++cg_) { const size_t tg = (size_t)b * SEQ + tq0 + 4 * cg_ + qi; const bf16_t* qp = Qr + tg * 512 + head * 64 + g * 8; Qf[cg_][0] = *(const bf16x8*)qp; Qf[cg_][1] = *(const bf16x8*)(qp + 32); }
    const bf16_t* gp = proj + ((size_t)b * SEQ + tq0 + qi) * INP + C_G + head * 3;
    bf16_t* outp = (bf16_t*)(wsu + WS_A) + ((size_t)b * SEQ + tq0 + qi) * DM + 512 + head * 64 + 4 * g;
    AttnRegs R;
    const unsigned pf = (unsigned)(unsigned long long)ldptr(c.lds, 31);
    for (int rep_c = 0; rep_c <= (int)(pf & 1u); ++rep_c) {
#pragma unroll
    for (int i = 0; i < QPW; ++i) ((LAS f32x4*)imp)[i * 64 + lane] = (f32x4){0.f, 0.f, 0.f, 0.f};
    CFENCE();
    {
        const bf16_t* Kc = (const bf16_t*)(wsu + WS_KCMP) + (size_t)bk * 1024 * 64; const bf16_t* Vc = (const bf16_t*)(wsu + WS_VCMPT) + (size_t)bk * 64 * 1024;
        const int ncount = 4 * qb + 3; const int nt = (ncount + 63) >> 6;
        attn_reset(R);
        attn_stream<3>(R, Qf, ring, Kc, Vc, 1024, 0, nt, tq0 + qi, msk, uni, imp, c.tid, lane, qi, hg);
#pragma unroll
        for (int cg_ = 0; cg_ < NCG; ++cg_) { const float L = rowsum4(R.l[cg_]); R.l[cg_] = L > 0.f ? 1.0f / L : 0.f; }
        attn_stream<2>(R, Qf, ring, Kc, Vc, 1024, 0, nt, tq0 + qi, msk, uni, imp, c.tid, lane, qi, hg);
    }
    LDS_WAIT(); CFENCE();
    }
    for (int rep_t = 0; rep_t <= (int)((pf >> 3) & 1u); ++rep_t) {
    if (cur < 16) {
        if (lane < QPW) {
#pragma unroll
            for (int w = 0; w < 8; ++w) { const int lo = 32 * w; unsigned v = 0u; if (cur >= lo) { const int nb = cur - lo + 1; v = nb >= 32 ? 0xFFFFFFFFu : ((1u << nb) - 1u); } msk[lane * 8 + w] = v; }
        }
    } else {
        LAS unsigned short* m16 = (LAS unsigned short*)msk;
        for (int rr = 0; rr < NCG; ++rr) {
            const int qq = 4 * rr + g; int v[16];
#pragma unroll
            for (int i = 0; i < 16; ++i) { const int j = i * 16 + r16; const bool cand = (j <= cur) && (j != 0) && (j != cur) && (j != cur - 1); v[i] = cand ? (int)__float_as_uint(imp[qq * 256 + j]) : -1; }
            int T = 0;
            for (int bitp = 30; bitp >= 0; --bitp) { const int cd = T | (1 << bitp); int cnt = 0;
#pragma unroll
                for (int i = 0; i < 16; ++i) cnt += (v[i] >= cd) ? 1 : 0;
                cnt = row16_sum(cnt);
                if (cnt >= 13) T = cd; }
            int gt = 0;
#pragma unroll
            for (int i = 0; i < 16; ++i) gt += (v[i] > T) ? 1 : 0;
            gt = row16_sum(gt);
            const int need = 13 - gt; int running = 0;
#pragma unroll
            for (int i = 0; i < 16; ++i) { const int j = i * 16 + r16; const bool eq = (v[i] == T);
                const unsigned long long bal = __ballot(eq); const unsigned be = (unsigned)(bal >> (16 * g)) & 0xFFFFu;
                const int rank = running + __popc(be & ((1u << r16) - 1u)); running += __popc(be);
                const bool forced = (j <= cur) && ((j == 0) || (j == cur) || (j == cur - 1));
                const bool sel = (v[i] > T) || (eq && rank < need) || forced;
                const unsigned long long bs = __ballot(sel);
                if (r16 == 0) m16[qq * 16 + i] = (unsigned short)((bs >> (16 * g)) & 0xFFFFu); }
        }
    }
    LDS_WAIT(); CFENCE();
    }
    if (lane < 8) { unsigned u = 0u;
#pragma unroll
        for (int q = 0; q < QPW; ++q) u |= msk[q * 8 + lane];
        uni[lane] = u; }
    if (lane < 8 * NCG) { const int cg_ = lane >> 3, w = lane & 7; unsigned u = 0u;
#pragma unroll
        for (int q = 0; q < 4; ++q) u |= msk[(4 * cg_ + q) * 8 + w];
        uni[8 + lane] = u; }
    LDS_WAIT(); CFENCE();
    attn_flush<0, false>(R, imp, gp + 0, outp, lane);
    {
        const bf16_t* Ks = (const bf16_t*)(wsu + WS_KS) + (size_t)bk * SEQ * 64; const bf16_t* Vs = (const bf16_t*)(wsu + WS_VST) + (size_t)bk * 64 * SEQ;
        for (int rep_s = 0; rep_s <= (int)((pf >> 1) & 1u); ++rep_s) {
        attn_reset(R);
        attn_stream<1>(R, Qf, ring, Ks, Vs, SEQ, 0, cur + 1, tq0 + qi, msk, uni, imp, c.tid, lane, qi, hg);
        }
        attn_flush<1, true>(R, imp, gp + 1, outp, lane);
    }
    {
        const bf16_t* Kw = (const bf16_t*)(wsu + WS_KW) + (size_t)bk * SEQ * 64; const bf16_t* Vw = (const bf16_t*)(wsu + WS_VWT) + (size_t)bk * 64 * SEQ;
        int t0 = qb - 8; if (t0 < 0) t0 = 0;
        for (int rep_w = 0; rep_w <= (int)((pf >> 2) & 1u); ++rep_w) {
        attn_reset(R);
        attn_stream<0>(R, Qf, ring, Kw, Vw, SEQ, t0, qb - t0 + 1, tq0 + qi, msk, uni, imp, c.tid, lane, qi, hg);
        }
        attn_flush<2, true>(R, imp, gp + 2, outp, lane);
    }
    LDS_WAIT(); CFENCE();
}

__device__ __forceinline__ void lru_fin_unit(const Ctx& c, int u) {
    const int hh = u & 3, ch = (u >> 2) % LRU_NCH, b = (u >> 2) / LRU_NCH; const int chn = hh * 64 + c.lane;
    const float* carA = (const float*)(c.ws + WS_CARA) + (size_t)b * LRU_NCH * 256 + chn; const float* carH = (const float*)(c.ws + WS_CARH) + (size_t)b * LRU_NCH * 256 + chn;
    float h = 0.f;
    for (int k = 0; k < ch; ++k) h = carA[k * 256] * h + carH[k * 256];
    const float* HL = (const float*)(c.ws + WS_F); const float* CA = HL + (size_t)M * 256;
    const bf16_t* proj = (const bf16_t*)(c.ws + WS_HID); bf16_t* out = (bf16_t*)(c.ws + WS_A);
    const size_t tg0 = (size_t)b * SEQ + ch * LRU_CHUNK;
#pragma unroll 4
    for (int t = 0; t < LRU_CHUNK; ++t) { const size_t tg = tg0 + t;
        const float hv = HL[tg * 256 + chn] + CA[tg * 256 + chn] * h; const float x = bf1(proj[tg * INP + C_GL + chn]);
        const float u3 = 0.7978845608028654f * (x + 0.044715f * x * x * x); const float th = 1.0f - 2.0f / (1.0f + __expf(2.0f * u3));
        const float y = hv * (0.5f * x * (1.0f + th));
        out[tg * DM + 256 + chn] = (bf16_t)(cvt_pk_bf16(y, 0.f) & 0xffffu); }
}

constexpr int NU_ATT = (SEQ / QPW) * 4;
__device__ __forceinline__ void phase_attn_units(const Ctx& c) {
    for (int p2 = (c.gw / NWAVES) * 2; p2 < 1024; p2 += c.G * 2) { const int p = p2 >> 1;
        for (int r = 0; r < 2; ++r) { const int bk = p & 3, ql = p >> 2; attn_unit(c, bk, r ? 255 - ql : ql); } }
    __syncthreads();
}
__device__ __forceinline__ void phase_attn_fin(const Ctx& c) {
    for (int u = c.gw; u < NU_LRU; u += c.ngw) lru_fin_unit(c, u);
}
__device__ __forceinline__ void phase_attn(const Ctx& c) {
    const unsigned long long reps = (unsigned long long)ldptr(c.lds, 30);
    const int ra = (int)(unsigned)reps, rf = (int)(unsigned)(reps >> 32);
    for (int r = 0; r < ra; ++r) phase_attn_units(c);
    for (int r = 0; r < rf; ++r) phase_attn_fin(c);
}

constexpr int N_PHASES = 1 + 11 * DEPTH;
__global__ void __launch_bounds__(NTHREADS, 2) fwd_kernel(Args args) {
    extern __shared__ __attribute__((aligned(16))) unsigned char lds_raw[];
    {
        LAS unsigned long long* tab = (LAS unsigned long long*)((LAS unsigned char*)lds_raw + PTAB_OFF);
        if (threadIdx.x < 28) tab[threadIdx.x] = (unsigned long long)args.in[threadIdx.x];
        if (threadIdx.x == 28) tab[28] = (unsigned long long)args.out;
        if (threadIdx.x == 29) tab[29] = (unsigned long long)args.ws;
        if (threadIdx.x == 30) tab[30] = (unsigned long long)(unsigned)args.rep_attn | ((unsigned long long)(unsigned)args.rep_fin << 32);
        if (threadIdx.x == 31) tab[31] = (unsigned long long)(unsigned)args.rep_prep;
        __syncthreads();
    }
    const int ph_lo = args.ph_lo, ph_hi = args.ph_hi;
    const int wave_s = __builtin_amdgcn_readfirstlane(threadIdx.x >> 6);
    using namespace pg8;
    for (int ph = ph_lo; ph < ph_hi; ++ph) {
        Ctx c;
        int tid = threadIdx.x; asm volatile("" : "+v"(tid));
        int bid = blockIdx.x; asm volatile("" : "+s"(bid));
        unsigned ldsb = (unsigned)(size_t)(LAS unsigned char*)lds_raw; asm volatile("" : "+s"(ldsb));
        c.lds = (LAS unsigned char*)(size_t)ldsb; c.tid = tid; c.lane = tid & 63; c.wave = __builtin_amdgcn_readfirstlane(tid >> 6);
        c.G = gridDim.x; c.gw = bid * NWAVES + c.wave; c.ngw = c.G * NWAVES;
        c.wlds = c.lds + c.wave * WAVE_LDS;
        unsigned char* ws = (unsigned char*)ldptr(c.lds, 29); c.ws = ws;
        float* outp = (float*)ldptr(c.lds, 28);
        if (ph == 0) {
#ifndef NO_P0
            p0_prologue(c);
#endif
        } else {
            const int l = (ph - 1) / 11, s = (ph - 1) % 11;
            if (s == 0 || s == 8) {
                const int which = s == 8; Gemm g{(const bf16_t*)(ws + WS_A), (const bf16_t*)(ws + WS_WGU + (size_t)(l * 2 + which) * SZ_WGU), M, NGU, DM};
                StaticOrder S; S.init(M, NGU, c.G, bid); EpiSwiGLU E{(bf16_t*)(ws + WS_HID)};
                gemm_phase<EpiSwiGLU, StaticOrder, true, true>(c.lds, g, S, E, tid);
            } else if (s == 1 || s == 9 || s == 3 || s == 6) {
                const bf16_t* A; const bf16_t* Bt; bf16_t* O; int N, K;
                if (s == 3) { A = (const bf16_t*)(ws + WS_A); Bt = (const bf16_t*)(ws + WS_WIN + (size_t)l * SZ_WIN); O = (bf16_t*)(ws + WS_HID); N = INP; K = DM; }
                else if (s == 6) { A = (const bf16_t*)(ws + WS_A); Bt = (const bf16_t*)(ws + WS_WOUT + (size_t)l * SZ_WOUT); O = (bf16_t*)(ws + WS_F); N = DM; K = DM; }
                else { A = (const bf16_t*)(ws + WS_HID); Bt = (const bf16_t*)(ws + WS_WDN + (size_t)(l * 2 + (s == 9)) * SZ_WDN); O = (bf16_t*)(ws + WS_F); N = DM; K = FF; }
                Gemm g{A, Bt, M, N, K};
                StaticOrder S; S.init(M, N, c.G, bid); EpiStore E{O, N};
                gemm_phase<EpiStore, StaticOrder, true, true>(c.lds, g, S, E, tid);
            } else if (s == 4) {
#ifndef NO_PREP
                phase_prep(c, l);
#endif
            } else if (s == 5) {
#ifndef NO_ATTN
                phase_attn(c);
#endif
            } else {
                const float* hin = (s == 2 && l == 0) ? INP_F(0) : outp;
                const float* gpost = INP_F(s == 2 ? 3 : (s == 7 ? 8 : 24)) + l * DM;
                const float* gnext = s == 2 ? INP_F(7) + l * DM : (s == 7 ? INP_F(23) + l * DM : ((l + 1 < DEPTH) ? INP_F(2) + (l + 1) * DM : nullptr));
                rowpass(c, hin, outp, (const bf16_t*)(ws + WS_F), gpost, s == 7 ? 1.0f : 0.5f, gnext, (bf16_t*)(ws + WS_A));
            }
        }
        if (ph + 1 < ph_hi) { cg::this_grid().sync(); }
    }
}

extern "C" void kernel_launch(void* const* d_in, const int* in_sizes, int n_in, void* d_out, int out_size, void* d_ws, size_t ws_size, hipStream_t stream) {
    static int grid = 0;
    if (grid == 0) {
        if (n_in != 28 || out_size != M * DM || ws_size < WS_END) { fprintf(stderr, "kernel_launch: unexpected shapes (n_in %d out %d ws %zu need %zu)\n", n_in, out_size, ws_size, (size_t)WS_END); grid = -1; return; }
        int dev = 0, cus = 0, per_cu = 0;
        hipGetDevice(&dev); hipDeviceGetAttribute(&cus, hipDeviceAttributeMultiprocessorCount, dev);
        if (hipFuncSetAttribute((const void*)fwd_kernel, hipFuncAttributeMaxDynamicSharedMemorySize, LDS_BYTES) != hipSuccess) { fprintf(stderr, "kernel_launch: hipFuncSetAttribute failed\n"); grid = -1; return; }
        if (hipOccupancyMaxActiveBlocksPerMultiprocessor(&per_cu, (const void*)fwd_kernel, NTHREADS, LDS_BYTES) != hipSuccess || per_cu < 1) { fprintf(stderr, "kernel_launch: occupancy query says %d\n", per_cu); per_cu = 1; }
        (void)hipGetLastError();
        grid = cus * per_cu;
        fprintf(stderr, "kernel_launch: grid %d (cus %d x %d)\n", grid, cus, per_cu);
    }
    if (grid < 0) return;
    Args a{};
    for (int i = 0; i < 28; ++i) a.in[i] = d_in[i];
    a.out = (float*)d_out; a.ws = (unsigned char*)d_ws;
#ifndef REP_ATTN
#define REP_ATTN 1
#endif
#ifndef REP_FIN
#define REP_FIN 1
#endif
#ifndef REP_PREP
#define REP_PREP 0
#endif
    a.rep_attn = REP_ATTN; a.rep_fin = REP_FIN; a.rep_prep = REP_PREP; a.rep_pad = 0;
#if N_LAUNCH_MODE == 1
    a.ph_lo = 0; a.ph_hi = N_PHASES;
    void* kargs[] = {&a};
    hipError_t e = hipLaunchCooperativeKernel((const void*)fwd_kernel, dim3(grid), dim3(NTHREADS), kargs, LDS_BYTES, stream);
    if (e != hipSuccess) fprintf(stderr, "cooperative launch failed: %s (grid %d)\n", hipGetErrorString(e), grid);
#else
    for (int ph = 0; ph < N_PHASES; ++ph) {
        a.ph_lo = ph; a.ph_hi = ph + 1;
        hipLaunchKernelGGL(fwd_kernel, dim3(grid), dim3(NTHREADS), LDS_BYTES, stream, a);
    }
#endif
}
```

```cpp
#include <hip/hip_runtime.h>
#include <hip/hip_cooperative_groups.h>
#include <cstdio>
#include <cstdint>
namespace cg = cooperative_groups;

#define LAS __attribute__((address_space(3)))
typedef unsigned short bf16_t;
typedef short bf16x8 __attribute__((ext_vector_type(8)));
typedef float f32x4 __attribute__((ext_vector_type(4)));
typedef float f32x2 __attribute__((ext_vector_type(2)));
typedef unsigned u32x4 __attribute__((ext_vector_type(4)));
typedef unsigned u32x2 __attribute__((ext_vector_type(2)));

#ifndef N_LAUNCH_MODE
#define N_LAUNCH_MODE 1
#endif

constexpr int BATCH = 2, SEQ = 16384, DM = 1024, M = BATCH * SEQ, FF = 2816, NGU = 2 * FF, DEPTH = 2;
constexpr int INC = 2072, INP = 2304;
constexpr int C_XP = 0, C_XL = 256, C_GL = 512, C_Q = 768, C_KC = 1280, C_VC = 1408, C_KS = 1536, C_VS = 1664, C_KW = 1792, C_VW = 1920, C_G = 2048;
constexpr float EPS = 1e-6f;
constexpr float QSCALE = 0.125f * 1.4426950408889634f;
constexpr int NWAVES = 8, NTHREADS = 512;
constexpr int LRU_CHUNK = 128, LRU_NCH = SEQ / LRU_CHUNK;

constexpr size_t SZ_WGU = (size_t)NGU * DM * 2, SZ_WDN = (size_t)DM * FF * 2, SZ_WIN = (size_t)INP * DM * 2, SZ_WOUT = (size_t)DM * DM * 2;
constexpr size_t WS_WGU = 0;
constexpr size_t WS_WDN = WS_WGU + 4 * SZ_WGU;
constexpr size_t WS_WIN = WS_WDN + 4 * SZ_WDN;
constexpr size_t WS_WOUT = WS_WIN + 2 * SZ_WIN;
constexpr size_t WS_WPOOL = WS_WOUT + 2 * SZ_WOUT;
constexpr size_t WS_WLRU = WS_WPOOL + 2 * 4 * 4096 * 2;
constexpr size_t WS_WCMP = WS_WLRU + 2 * 2 * 4 * 4096 * 2;
constexpr size_t WS_COS = WS_WCMP + 2 * 2 * 64 * 2048 * 2;
constexpr size_t WS_SIN = WS_COS + (size_t)M * 32 * 4;
constexpr size_t WS_A = WS_SIN + (size_t)M * 32 * 4;
constexpr size_t WS_HID = WS_A + (size_t)M * DM * 2;
constexpr size_t WS_QR = WS_HID + (size_t)M * INP * 2;
constexpr size_t WS_F = WS_HID + (size_t)M * FF * 2;
constexpr size_t WS_KS = WS_F + (size_t)M * DM * 2;
constexpr size_t WS_KW = WS_KS + (size_t)4 * SEQ * 64 * 2;
constexpr size_t WS_VST = WS_KW + (size_t)4 * SEQ * 64 * 2;
constexpr size_t WS_VWT = WS_VST + (size_t)4 * SEQ * 64 * 2;
constexpr size_t WS_KCMP = WS_VWT + (size_t)4 * SEQ * 64 * 2;
constexpr size_t WS_VCMPT = WS_KCMP + (size_t)4 * 1024 * 64 * 2;
constexpr size_t WS_CARA = WS_VCMPT + (size_t)4 * 1024 * 64 * 2;
constexpr size_t WS_CARH = WS_CARA + (size_t)BATCH * LRU_NCH * 256 * 4;
constexpr size_t WS_END = WS_CARH + (size_t)BATCH * LRU_NCH * 256 * 4;
static_assert(WS_QR + (size_t)M * 512 * 2 == WS_F, "Qr fills the tail of the hidden buffer");
static_assert(WS_END <= (size_t)512 * 1024 * 1024, "workspace map");
static_assert(2 * 32768 + 8 * 9216 <= 147456 - 256, "attention LDS map");

constexpr int LDS_BYTES = 147456;
constexpr int WAVE_LDS = 17408;

__device__ __forceinline__ unsigned cvt_pk_bf16(float lo, float hi) { unsigned r; asm volatile("v_cvt_pk_bf16_f32 %0, %1, %2" : "=v"(r) : "v"(lo), "v"(hi)); return r; }
__device__ __forceinline__ float bflo(unsigned w) { return __uint_as_float(w << 16); }
__device__ __forceinline__ float bfhi(unsigned w) { return __uint_as_float(w & 0xffff0000u); }
__device__ __forceinline__ float bf1(unsigned short u) { return __uint_as_float((unsigned)u << 16); }
__device__ __forceinline__ float fexp2(float x) { return __builtin_amdgcn_exp2f(x); }
__device__ __forceinline__ float sigmoidf_(float x) { return 1.0f / (1.0f + __expf(-x)); }
__device__ __forceinline__ float wave_sum(float v) {
#pragma unroll
    for (int o = 1; o < 64; o <<= 1) v += __shfl_xor(v, o);
    return v;
}
#define LDS_WAIT() asm volatile("s_waitcnt lgkmcnt(0)" ::: "memory")
#define CFENCE() asm volatile("" ::: "memory")

namespace pg8 {
constexpr int BM = 256, BK = 64, HALF = 128, HTB = HALF * BK * 2, STAGE_BYTES = 8 * HTB, NXCD = 8, WGM = 8;
__host__ __device__ __forceinline__ int lds_byte(int r, int c) { const int st = (r >> 4) * 2 + (c >> 5), rr = r & 15, cc = c & 31, ob = rr * 64 + cc * 2; return st * 1024 + (ob ^ (((ob >> 9) & 1) << 5)); }
__host__ __device__ __forceinline__ void stage_rc(int b, int& R, int& C) { const int st = b / 1024, sb = b % 1024, swz = sb ^ (((sb >> 9) & 1) << 5); R = (st >> 1) * 16 + swz / 64; C = (st & 1) * 32 + (swz % 64) / 2; }
__host__ __device__ __forceinline__ int perm32(int rho) { const int n = rho >> 4, i = rho & 15; return 8 * (i >> 2) + 4 * n + (i & 3); }
struct Unit { int pm, pn; };
struct Gemm { const bf16_t* A; const bf16_t* Bt; int M, N, K; };
struct StaticOrder {
    int nM, nN, nwg, G, c;
    __device__ void init(int M_, int N_, int G_, int c_) { nM = M_ / BM; nN = N_ / BM; nwg = nM * nN; G = G_; c = c_; }
    __device__ bool next(int i, Unit& u) const {
        const long L = (long)i * G + c; if (L >= nwg) return false;
        int wgid = (int)L; { const int q = nwg / NXCD, r = nwg % NXCD, xcd = wgid % NXCD, off = wgid / NXCD; wgid = (xcd < r ? xcd * (q + 1) : r * (q + 1) + (xcd - r) * q) + off; }
        const int nig = WGM * nN, gid = wgid / nig, fm = gid * WGM, gsz = (nM - fm) < WGM ? (nM - fm) : WGM;
        u.pm = fm + ((wgid % nig) % gsz); u.pn = (wgid % nig) / gsz; return true;
    }
    __device__ __forceinline__ void a_ready(const Unit&) const {}
    __device__ __forceinline__ void done(const Unit&) const {}
};
struct EpiStore {
    static constexpr bool PERM = true, AFTER_DRAIN = false;
    bf16_t* O; int ldc;
    __device__ __forceinline__ void operator()(const f32x4 (&acc)[2][2][4][2], const Unit& u, int wr, int wc, int fr, int fq) const {
        const int row0 = u.pm * BM + wr * 64 + fr, col0 = u.pn * BM + wc * 32 + 8 * fq;
#pragma unroll
        for (int ai = 0; ai < 2; ++ai)
#pragma unroll
            for (int m = 0; m < 4; ++m) { bf16_t* rowp = O + (size_t)(row0 + ai * HALF + m * 16) * ldc + col0;
#pragma unroll
                for (int bj = 0; bj < 2; ++bj) { const f32x4 v0 = acc[ai][bj][m][0], v1 = acc[ai][bj][m][1];
                    u32x4 w; w.x = cvt_pk_bf16(v0[0], v0[1]); w.y = cvt_pk_bf16(v0[2], v0[3]); w.z = cvt_pk_bf16(v1[0], v1[1]); w.w = cvt_pk_bf16(v1[2], v1[3]);
                    *(u32x4*)(rowp + bj * HALF) = w; } }
    }
};
struct EpiSwiGLU {
    static constexpr bool PERM = true, AFTER_DRAIN = false;
    bf16_t* O;
    __device__ __forceinline__ void operator()(const f32x4 (&acc)[2][2][4][2], const Unit& u, int wr, int wc, int fr, int fq) const {
        const int row0 = u.pm * BM + wr * 64 + fr, col0 = u.pn * HALF + wc * 32 + 8 * fq;
#pragma unroll
        for (int ai = 0; ai < 2; ++ai)
#pragma unroll
            for (int m = 0; m < 4; ++m) { bf16_t* rowp = O + (size_t)(row0 + ai * HALF + m * 16) * FF + col0;
                float r[8];
#pragma unroll
                for (int n = 0; n < 2; ++n)
#pragma unroll
                    for (int j = 0; j < 4; ++j) { const float g = acc[ai][0][m][n][j], up = acc[ai][1][m][n][j];
                        r[n * 4 + j] = g * __builtin_amdgcn_rcpf(1.0f + fexp2(-1.4426950408889634f * g)) * up; }
                u32x4 w; w.x = cvt_pk_bf16(r[0], r[1]); w.y = cvt_pk_bf16(r[2], r[3]); w.z = cvt_pk_bf16(r[4], r[5]); w.w = cvt_pk_bf16(r[6], r[7]);
                *(u32x4*)rowp = w; }
    }
};

template <class Epi, class Sched, bool ALIGN_EPI = false, bool SP2 = false>
__device__ __forceinline__ void gemm_phase(LAS unsigned char* lds, const Gemm g, const Sched& S, const Epi& E, const int tid) {
    const int wid = __builtin_amdgcn_readfirstlane(tid >> 6), lane = tid & 63, wr = wid >> 2, wc = wid & 3, fr = lane & 15, fq = lane >> 4;
    const int K = g.K, nt = K / BK;
    unsigned voffA[2], voffB[2];
#pragma unroll
    for (int i = 0; i < 2; ++i) { int R, C; stage_rc(tid * 16 + i * 8192, R, C); const int Rb = Epi::PERM ? ((R & ~31) + perm32(R & 31)) : R;
        voffA[i] = (unsigned)(R * K + C) * 2u; voffB[i] = (unsigned)(Rb * K + C) * 2u; }
    const size_t kstep = (size_t)(BK * 2);
    const size_t hstep = (size_t)HALF * K * 2;
    const size_t tstep = 2 * hstep;
    const unsigned ldsw = (unsigned)wid * 1024u;
    const int aoff = lds_byte(wr * 64 + fr, fq * 8), boff = lds_byte(wc * 32 + fr, fq * 8);
#define PG8_SA(b, h) (((b) * 2 + (h)) * HTB)
#define PG8_SB(b, h) ((4 + (b) * 2 + (h)) * HTB)
#define PG8_STAGE(bufoff, gbase, voff) do { _Pragma("unroll") for (int _i = 0; _i < 2; ++_i) \
        __builtin_amdgcn_global_load_lds((const unsigned*)((const char*)(gbase) + (voff)[_i]), (LAS unsigned*)(lds + (bufoff) + ldsw + _i * 8192), 16, 0, 0); } while (0)
#define PG8_LDA(dst, b, h) do { _Pragma("unroll") for (int m = 0; m < 4; ++m) _Pragma("unroll") for (int k = 0; k < 2; ++k) dst[m][k] = *(const LAS bf16x8*)(lds + PG8_SA(b, h) + aoff + m * 2048 + k * 1024); } while (0)
#define PG8_LDB(dst, b, h) do { _Pragma("unroll") for (int n = 0; n < 2; ++n) _Pragma("unroll") for (int k = 0; k < 2; ++k) dst[n][k] = *(const LAS bf16x8*)(lds + PG8_SB(b, h) + boff + n * 2048 + k * 1024); } while (0)
#define PG8_MMA(ai, bj, At, Bt) do { __builtin_amdgcn_s_setprio(1); _Pragma("unroll") for (int m = 0; m < 4; ++m) _Pragma("unroll") for (int n = 0; n < 2; ++n) _Pragma("unroll") for (int k = 0; k < 2; ++k) \
        acc[ai][bj][m][n] = __builtin_amdgcn_mfma_f32_16x16x32_bf16(Bt[n][k], At[m][k], acc[ai][bj][m][n], 0, 0, 0); __builtin_amdgcn_s_setprio(0); } while (0)
#define PG8_WAIT_V(n) asm volatile("s_waitcnt vmcnt(" #n ")" ::: "memory")
#define PG8_WAIT_L(n) asm volatile("s_waitcnt lgkmcnt(" #n ")" ::: "memory")
#define PG8_BAR __builtin_amdgcn_s_barrier()
#define PG8_SCHED __builtin_amdgcn_sched_barrier(0)
    Unit cur, nxt; int ui = 0;
    if (!S.next(0, cur)) return;
    f32x4 acc[2][2][4][2];
#pragma unroll
    for (int a = 0; a < 2; ++a)
#pragma unroll
        for (int b = 0; b < 2; ++b)
#pragma unroll
            for (int m = 0; m < 4; ++m)
#pragma unroll
                for (int n = 0; n < 2; ++n) acc[a][b][m][n] = (f32x4){0.f, 0.f, 0.f, 0.f};
    bf16x8 At[4][2], B0[2][2], B1[2][2];
    const char* cA = (const char*)g.A + (size_t)cur.pm * tstep; const char* cB = (const char*)g.Bt + (size_t)cur.pn * tstep;
    S.a_ready(cur);
    if constexpr (SP2) {
        PG8_STAGE(PG8_SB(0, 0), cB, voffB); PG8_STAGE(PG8_SB(0, 1), cB + hstep, voffB); PG8_STAGE(PG8_SA(0, 0), cA, voffA); PG8_STAGE(PG8_SA(0, 1), cA + hstep, voffA);
        if (wr == 1) PG8_BAR;
        PG8_WAIT_V(2); PG8_BAR;
        PG8_STAGE(PG8_SB(1, 0), cB + kstep, voffB); PG8_STAGE(PG8_SA(1, 0), cA + kstep, voffA); PG8_STAGE(PG8_SB(1, 1), cB + hstep + kstep, voffB);
        PG8_WAIT_V(6); PG8_BAR;
    } else {
        PG8_STAGE(PG8_SB(0, 0), cB, voffB); PG8_STAGE(PG8_SA(0, 0), cA, voffA); PG8_STAGE(PG8_SB(0, 1), cB + hstep, voffB); PG8_STAGE(PG8_SA(0, 1), cA + hstep, voffA);
        if (wr == 1) PG8_BAR;
        PG8_WAIT_V(4); PG8_BAR;
        PG8_STAGE(PG8_SB(1, 0), cB + kstep, voffB); PG8_STAGE(PG8_SA(1, 0), cA + kstep, voffA); PG8_STAGE(PG8_SB(1, 1), cB + hstep + kstep, voffB);
        PG8_WAIT_V(6); PG8_BAR;
    }
    for (;;) {
        const bool has_next = S.next(ui + 1, nxt);
        const char* nA = has_next ? (const char*)g.A + (size_t)nxt.pm * tstep : cA; const char* nB = has_next ? (const char*)g.Bt + (size_t)nxt.pn * tstep : cB;
        for (int t = 0; t < nt; t += 2) {
            const bool last = (t == nt - 2);
            const char* a1 = cA + (size_t)(t + 1) * kstep;
            const char* a2 = last ? nA : cA + (size_t)(t + 2) * kstep; const char* b2 = last ? nB : cB + (size_t)(t + 2) * kstep;
            const char* a3 = a2 + kstep; const char* b3 = b2 + kstep;
            if (last && has_next) S.a_ready(nxt);
            if constexpr (SP2) {
            PG8_LDB(B0, 0, 0); PG8_LDB(B1, 0, 1); PG8_SCHED; PG8_LDA(At, 0, 0); PG8_STAGE(PG8_SA(1, 1), a1 + hstep, voffA);
            PG8_WAIT_V(8); PG8_WAIT_L(0); PG8_BAR; PG8_MMA(0, 0, At, B0); PG8_MMA(0, 1, At, B1); PG8_BAR; PG8_SCHED;
            PG8_LDA(At, 0, 1); PG8_STAGE(PG8_SB(0, 0), b2, voffB); PG8_STAGE(PG8_SB(0, 1), b2 + hstep, voffB); PG8_STAGE(PG8_SA(0, 0), a2, voffA);
            PG8_WAIT_V(8); PG8_WAIT_L(0); PG8_BAR; PG8_MMA(1, 0, At, B0); PG8_MMA(1, 1, At, B1); PG8_BAR; PG8_SCHED;
            PG8_LDB(B0, 1, 0); PG8_LDB(B1, 1, 1); PG8_SCHED; PG8_LDA(At, 1, 0); PG8_STAGE(PG8_SA(0, 1), a2 + hstep, voffA);
            PG8_WAIT_V(8); PG8_WAIT_L(0); PG8_BAR; PG8_MMA(0, 0, At, B0); PG8_MMA(0, 1, At, B1); PG8_BAR; PG8_SCHED;
            PG8_LDA(At, 1, 1); PG8_STAGE(PG8_SB(1, 0), b3, voffB); PG8_STAGE(PG8_SB(1, 1), b3 + hstep, voffB); PG8_STAGE(PG8_SA(1, 0), a3, voffA);
            PG8_WAIT_V(8); PG8_WAIT_L(0); PG8_BAR; PG8_MMA(1, 0, At, B0); PG8_MMA(1, 1, At, B1); PG8_BAR; PG8_SCHED;
            } else {
            PG8_LDB(B0, 0, 0); PG8_SCHED; PG8_LDA(At, 0, 0); PG8_STAGE(PG8_SA(1, 1), a1 + hstep, voffA);
            PG8_WAIT_L(8); PG8_BAR; PG8_WAIT_L(0); PG8_MMA(0, 0, At, B0); PG8_BAR; PG8_SCHED;
            PG8_LDB(B1, 0, 1); PG8_STAGE(PG8_SB(0, 0), b2, voffB);
            PG8_BAR; PG8_WAIT_L(0); PG8_MMA(0, 1, At, B1); PG8_BAR;
            PG8_LDA(At, 0, 1); PG8_STAGE(PG8_SA(0, 0), a2, voffA);
            PG8_BAR; PG8_WAIT_L(0); PG8_MMA(1, 0, At, B0); PG8_BAR; PG8_SCHED;
            PG8_STAGE(PG8_SB(0, 1), b2 + hstep, voffB);
            PG8_WAIT_V(6); PG8_BAR; PG8_MMA(1, 1, At, B1); PG8_BAR;
            PG8_LDB(B0, 1, 0); PG8_SCHED; PG8_LDA(At, 1, 0); PG8_STAGE(PG8_SA(0, 1), a2 + hstep, voffA);
            PG8_WAIT_L(8); PG8_BAR; PG8_WAIT_L(0); PG8_MMA(0, 0, At, B0); PG8_BAR; PG8_SCHED;
            PG8_LDB(B1, 1, 1); PG8_STAGE(PG8_SB(1, 0), b3, voffB);
            PG8_BAR; PG8_WAIT_L(0); PG8_MMA(0, 1, At, B1); PG8_BAR;
            PG8_LDA(At, 1, 1); PG8_STAGE(PG8_SA(1, 0), a3, voffA);
            PG8_BAR; PG8_WAIT_L(0); PG8_MMA(1, 0, At, B0); PG8_BAR; PG8_SCHED;
            PG8_STAGE(PG8_SB(1, 1), b3 + hstep, voffB);
            PG8_WAIT_V(6); PG8_BAR; PG8_MMA(1, 1, At, B1); PG8_BAR;
            }
        }
        if constexpr (ALIGN_EPI) { if (wr == 0) PG8_BAR; }
        if constexpr (!Epi::AFTER_DRAIN) { E(acc, cur, wr, wc, fr, fq); S.done(cur); }
        if (!has_next) break;
#pragma unroll
        for (int a = 0; a < 2; ++a)
#pragma unroll
            for (int b = 0; b < 2; ++b)
#pragma unroll
                for (int m = 0; m < 4; ++m)
#pragma unroll
                    for (int n = 0; n < 2; ++n) acc[a][b][m][n] = (f32x4){0.f, 0.f, 0.f, 0.f};
        cur = nxt; cA = nA; cB = nB; ++ui;
        if constexpr (ALIGN_EPI) { if (wr == 1) PG8_BAR; }
    }
    PG8_WAIT_V(0);
    if constexpr (!ALIGN_EPI) { if (wr == 0) PG8_BAR; }
    PG8_BAR;
#undef PG8_SA
#undef PG8_SB
#undef PG8_STAGE
#undef PG8_LDA
#undef PG8_LDB
#undef PG8_MMA
#undef PG8_WAIT_V
#undef PG8_WAIT_L
#undef PG8_BAR
#undef PG8_SCHED
}
}

struct Args { const void* in[28]; float* out; unsigned char* ws; int ph_lo, ph_hi; int rep_attn, rep_fin, rep_prep, rep_pad; };

struct Ctx {
    LAS unsigned char* lds; LAS unsigned char* wlds;
    int tid, lane, wave, gw, ngw, G;
    unsigned char* ws;
};
constexpr int PTAB_OFF = 147456 - 256;
__device__ __forceinline__ const void* ldptr(LAS unsigned char* lds, int i) {
    volatile LAS unsigned* t = (volatile LAS unsigned*)(lds + PTAB_OFF) + 2 * i;
    const unsigned lo = __builtin_amdgcn_readfirstlane(t[0]), hi = __builtin_amdgcn_readfirstlane(t[1]);
    return (const void*)(const __attribute__((address_space(1))) unsigned char*)(((unsigned long long)hi << 32) | lo);
}
#define INP_F(i) ((const float*)ldptr(c.lds, (i)))

#define MFMA16(a, b, c) __builtin_amdgcn_mfma_f32_16x16x32_bf16((a), (b), (c), 0, 0, 0)

__device__ __forceinline__ void tr_item(const float* W, int K, int N, int nblk, bf16_t* WT, int mode, LAS float* scr, int item, int lane) {
    const int kb = item / nblk, nb = item % nblk, k0 = 64 * kb, n0 = 32 * nb;
    const int nn = n0 + (lane & 31);
#pragma unroll 8
    for (int i = 0; i < 32; ++i) { const int kk = 2 * i + (lane >> 5); scr[kk * 33 + (lane & 31)] = (nn < N) ? W[(size_t)(k0 + kk) * N + nn] : 0.f; }
    LDS_WAIT();
    const int row_off = mode == 0 ? 0 : ((n0 >> 7) * 128 + (mode == 2 ? 128 : 0));
    const int c = lane & 7;
#pragma unroll
    for (int j = 0; j < 4; ++j) { const int n = (lane >> 3) + 8 * j; const LAS float* s = scr + (8 * c) * 33 + n;
        u32x4 o; o.x = cvt_pk_bf16(s[0 * 33], s[1 * 33]); o.y = cvt_pk_bf16(s[2 * 33], s[3 * 33]); o.z = cvt_pk_bf16(s[4 * 33], s[5 * 33]); o.w = cvt_pk_bf16(s[6 * 33], s[7 * 33]);
        *(u32x4*)(WT + (size_t)(row_off + n0 + n) * K + k0 + 8 * c) = o; }
    LDS_WAIT();
}

__device__ __forceinline__ void norm_row_to_bf16(const float* xrow, const float* g, bf16_t* orow, int lane) {
    const f32x4* xr = (const f32x4*)xrow + lane; const f32x4* gr = (const f32x4*)g + lane;
    f32x4 v[4]; float s = 0.f;
#pragma unroll
    for (int j = 0; j < 4; ++j) { v[j] = xr[64 * j]; s += (v[j].x * v[j].x + v[j].y * v[j].y) + (v[j].z * v[j].z + v[j].w * v[j].w); }
    const float rs = 1.0f / sqrtf(wave_sum(s) * (1.f / DM) + EPS);
    u32x2* o8 = (u32x2*)orow + lane;
#pragma unroll
    for (int j = 0; j < 4; ++j) { const f32x4 gg = gr[64 * j]; u32x2 w; w.x = cvt_pk_bf16(v[j].x * rs * gg.x, v[j].y * rs * gg.y); w.y = cvt_pk_bf16(v[j].z * rs * gg.z, v[j].w * rs * gg.w); o8[64 * j] = w; }
}

constexpr int TR_BIG = 1408, TR_PER_LAYER = 6 * 1408 + 1152 + 512 + 8 + 16 + 128, TR_TOTAL = DEPTH * TR_PER_LAYER;

__device__ __forceinline__ void p0_prologue(const Ctx& c) {
    LAS float* scr = (LAS float*)c.wlds;
    unsigned char* ws = c.ws;
    for (int it = c.gw; it < TR_TOTAL; it += c.ngw) {
        const int l = it / TR_PER_LAYER; int r = it % TR_PER_LAYER;
        const float* src; bf16_t* dst; int K, N, nblk, mode = 0;
        if (r < 4 * TR_BIG) { const int q = r / TR_BIG; r -= q * TR_BIG; const int which = q >> 1, isup = q & 1;
            src = INP_F(which ? (isup ? 26 : 25) : (isup ? 5 : 4)) + (size_t)l * DM * FF; dst = (bf16_t*)(ws + WS_WGU + (size_t)(l * 2 + which) * SZ_WGU); K = DM; N = FF; nblk = FF / 32; mode = 1 + isup; }
        else if (r < 6 * TR_BIG) { r -= 4 * TR_BIG; const int which = r / TR_BIG; r -= which * TR_BIG;
            src = INP_F(which ? 27 : 6) + (size_t)l * DM * FF; dst = (bf16_t*)(ws + WS_WDN + (size_t)(l * 2 + which) * SZ_WDN); K = FF; N = DM; nblk = DM / 32; }
        else if (r < 6 * TR_BIG + 1152) { r -= 6 * TR_BIG; src = INP_F(9) + (size_t)l * DM * INC; dst = (bf16_t*)(ws + WS_WIN + (size_t)l * SZ_WIN); K = DM; N = INC; nblk = INP / 32; }
        else if (r < 6 * TR_BIG + 1152 + 512) { r -= 6 * TR_BIG + 1152; src = INP_F(10) + (size_t)l * DM * DM; dst = (bf16_t*)(ws + WS_WOUT + (size_t)l * SZ_WOUT); K = DM; N = DM; nblk = DM / 32; }
        else if (r < 6 * TR_BIG + 1152 + 512 + 8) { r -= 6 * TR_BIG + 1152 + 512; const int g = r >> 1; r &= 1;
            src = INP_F(11) + (size_t)(l * 4 + g) * 4096; dst = (bf16_t*)(ws + WS_WPOOL) + (size_t)(l * 4 + g) * 4096; K = 64; N = 64; nblk = 2; }
        else if (r < 6 * TR_BIG + 1152 + 512 + 8 + 16) { r -= 6 * TR_BIG + 1152 + 512 + 8; const int q = r >> 1; r &= 1; const int ri = q >> 2, h = q & 3;
            src = INP_F(ri ? 17 : 15) + (size_t)(l * 4 + h) * 4096; dst = (bf16_t*)(ws + WS_WLRU) + (size_t)((l * 2 + ri) * 4 + h) * 4096; K = 64; N = 64; nblk = 2; }
        else { r -= 6 * TR_BIG + 1152 + 512 + 8 + 16; const int kv = r >> 6; r &= 63;
            src = INP_F(kv ? 21 : 20) + (size_t)l * 2048 * 64; dst = (bf16_t*)(ws + WS_WCMP) + (size_t)(l * 2 + kv) * 64 * 2048; K = 2048; N = 64; nblk = 2; }
        tr_item(src, K, N, nblk, dst, mode, scr, r, c.lane);
    }
    {
        const int* pos = (const int*)ldptr(c.lds, 1); float* ct = (float*)(ws + WS_COS); float* st = (float*)(ws + WS_SIN);
        for (int e = c.gw * 64 + c.lane; e < M * 32; e += c.ngw * 64) {
            const int m = e >> 5, i = e & 31;
            const float inv = powf(10000.0f, -(float)(2 * i) / 64.0f);
            const float ang = (float)pos[m] * inv;
            const double ad = (double)ang; const double k = rint(ad * 0.15915494309189535); const float rr = (float)(ad - k * 6.283185307179586);
            ct[e] = cosf(rr); st[e] = sinf(rr);
        }
    }
    const float* x0 = INP_F(0); const float* g0 = INP_F(2);
    for (int m = c.gw; m < M; m += c.ngw) norm_row_to_bf16(x0 + (size_t)m * DM, g0, (bf16_t*)(ws + WS_A) + (size_t)m * DM, c.lane);
}

__device__ __forceinline__ void rowpass(const Ctx& c, const float* hin, float* hout, const bf16_t* f, const float* gpost, float coef, const float* gnext, bf16_t* aout) {
    const int lane = c.lane;
    for (int m = c.gw; m < M; m += c.ngw) {
        const u32x2* fr = (const u32x2*)(f + (size_t)m * DM) + lane;
        const f32x4* hr = (const f32x4*)(hin + (size_t)m * DM) + lane;
        f32x4 fv[4], hv[4]; float s = 0.f;
#pragma unroll
        for (int j = 0; j < 4; ++j) { const u32x2 w = fr[64 * j]; fv[j] = (f32x4){bflo(w.x), bfhi(w.x), bflo(w.y), bfhi(w.y)}; hv[j] = hr[64 * j];
            s += (fv[j].x * fv[j].x + fv[j].y * fv[j].y) + (fv[j].z * fv[j].z + fv[j].w * fv[j].w); }
        const float rs = coef / sqrtf(wave_sum(s) * (1.f / DM) + EPS);
        float s2 = 0.f;
#pragma unroll
        for (int j = 0; j < 4; ++j) { const f32x4 gg = ((const f32x4*)gpost + lane)[64 * j]; hv[j] = hv[j] + fv[j] * rs * gg;
            s2 += (hv[j].x * hv[j].x + hv[j].y * hv[j].y) + (hv[j].z * hv[j].z + hv[j].w * hv[j].w); }
        f32x4* ho = (f32x4*)(hout + (size_t)m * DM) + lane;
#pragma unroll
        for (int j = 0; j < 4; ++j) ho[64 * j] = hv[j];
        if (gnext) {
            const float rs2 = 1.0f / sqrtf(wave_sum(s2) * (1.f / DM) + EPS);
            u32x2* o8 = (u32x2*)(aout + (size_t)m * DM) + lane;
#pragma unroll
            for (int j = 0; j < 4; ++j) { const f32x4 gg = ((const f32x4*)gnext + lane)[64 * j]; u32x2 w; w.x = cvt_pk_bf16(hv[j].x * rs2 * gg.x, hv[j].y * rs2 * gg.y); w.y = cvt_pk_bf16(hv[j].z * rs2 * gg.z, hv[j].w * rs2 * gg.w); o8[64 * j] = w; }
        }
    }
}

__device__ __forceinline__ void unpack8(const bf16x8 v, float* f) {
    const u32x4 w = __builtin_bit_cast(u32x4, v);
    f[0] = bflo(w.x); f[1] = bfhi(w.x); f[2] = bflo(w.y); f[3] = bfhi(w.y); f[4] = bflo(w.z); f[5] = bfhi(w.z); f[6] = bflo(w.w); f[7] = bfhi(w.w);
}
__device__ __forceinline__ bf16x8 pack8(const float* f) {
    u32x4 w; w.x = cvt_pk_bf16(f[0], f[1]); w.y = cvt_pk_bf16(f[2], f[3]); w.z = cvt_pk_bf16(f[4], f[5]); w.w = cvt_pk_bf16(f[6], f[7]);
    return __builtin_bit_cast(bf16x8, w);
}

__device__ __forceinline__ void rope_unit(const Ctx& c, int tile) {
    const bf16_t* proj = (const bf16_t*)(c.ws + WS_HID); bf16_t* Qr = (bf16_t*)(c.ws + WS_QR);
    const float* ct = (const float*)(c.ws + WS_COS); const float* st = (const float*)(c.ws + WS_SIN);
    const int lane = c.lane, i0 = (lane & 7) * 4;
    for (int tt = 0; tt < 16; ++tt) {
        const int tg = tile * 16 + tt; const int b = tg / SEQ, t = tg % SEQ;
        const f32x4 cs = *(const f32x4*)(ct + (size_t)tg * 32 + i0), sn = *(const f32x4*)(st + (size_t)tg * 32 + i0);
        {
            const int head = lane >> 3; const bf16_t* src = proj + (size_t)tg * INP + C_Q + head * 64 + i0;
            const u32x2 a = *(const u32x2*)src, bb = *(const u32x2*)(src + 32);
            const f32x4 x1 = (f32x4){bflo(a.x), bfhi(a.x), bflo(a.y), bfhi(a.y)}, x2 = (f32x4){bflo(bb.x), bfhi(bb.x), bflo(bb.y), bfhi(bb.y)};
            const f32x4 o1 = (x1 * cs - x2 * sn) * QSCALE, o2 = (x2 * cs + x1 * sn) * QSCALE;
            bf16_t* dst = Qr + (size_t)tg * 512 + head * 64 + i0;
            u32x2 w; w.x = cvt_pk_bf16(o1.x, o1.y); w.y = cvt_pk_bf16(o1.z, o1.w); *(u32x2*)dst = w;
            w.x = cvt_pk_bf16(o2.x, o2.y); w.y = cvt_pk_bf16(o2.z, o2.w); *(u32x2*)(dst + 32) = w;
        }
        if (lane < 32) {
            const int arr = lane >> 4, kvh = (lane >> 3) & 1; const bf16_t* src = proj + (size_t)tg * INP + (arr ? C_KW : C_KS) + kvh * 64 + i0;
            const u32x2 a = *(const u32x2*)src, bb = *(const u32x2*)(src + 32);
            const f32x4 x1 = (f32x4){bflo(a.x), bfhi(a.x), bflo(a.y), bfhi(a.y)}, x2 = (f32x4){bflo(bb.x), bfhi(bb.x), bflo(bb.y), bfhi(bb.y)};
            const f32x4 o1 = x1 * cs - x2 * sn, o2 = x2 * cs + x1 * sn;
            bf16_t* dst = (bf16_t*)(c.ws + (arr ? WS_KW : WS_KS)) + ((size_t)(b * 2 + kvh) * SEQ + t) * 64 + i0;
            u32x2 w; w.x = cvt_pk_bf16(o1.x, o1.y); w.y = cvt_pk_bf16(o1.z, o1.w); *(u32x2*)dst = w;
            w.x = cvt_pk_bf16(o2.x, o2.y); w.y = cvt_pk_bf16(o2.z, o2.w); *(u32x2*)(dst + 32) = w;
        }
    }
}
__device__ __forceinline__ void vt_unit(const Ctx& c, int u) {
    const int tile = u & 255, bk = (u >> 8) & 3, arr = u >> 10; const int b = bk >> 1, kvh = bk & 1, t0 = tile * 64;
    const bf16_t* src = (const bf16_t*)(c.ws + WS_HID) + (size_t)(b * SEQ + t0) * INP + (arr ? C_VW : C_VS) + kvh * 64 + c.lane;
    bf16_t* dst = (bf16_t*)(c.ws + (arr ? WS_VWT : WS_VST)) + (((size_t)bk * 256 + tile) * 64 + c.lane) * 64;
#pragma unroll
    for (int q = 0; q < 8; ++q) {
        unsigned w[4];
#pragma unroll
        for (int e = 0; e < 4; ++e) { const unsigned lo = src[(size_t)(q * 8 + 2 * e) * INP], hi = src[(size_t)(q * 8 + 2 * e + 1) * INP]; w[e] = lo | (hi << 16); }
        *(u32x4*)(dst + q * 8) = (u32x4){w[0], w[1], w[2], w[3]};
    }
}
__device__ __forceinline__ void pool_unit(const Ctx& c, int u, int layer, const float* pool_scale) {
    const int gp = u & 3, tile = u >> 2; const int lane = c.lane, r16 = lane & 15, g = lane >> 4;
    const int tg = tile * 16 + r16, b = tg / SEQ, t = tg % SEQ; const int w = 2 << gp;
    const bf16_t* proj = (const bf16_t*)(c.ws + WS_HID);
    const bf16_t* WpT = (const bf16_t*)(c.ws + WS_WPOOL) + (size_t)(layer * 4 + gp) * 4096;
    bf16x8 Df[2];
    const int cnt = (t + 1 < w) ? t + 1 : w; const float icnt = 1.0f / (float)cnt;
#pragma unroll
    for (int ks = 0; ks < 2; ++ks) {
        const bf16_t* p = proj + (size_t)(b * SEQ + t) * INP + C_XP + gp * 64 + ks * 32 + g * 8;
        float sum[8], x0[8];
        unpack8(*(const bf16x8*)p, x0);
#pragma unroll
        for (int e = 0; e < 8; ++e) sum[e] = x0[e];
        for (int s = 1; s < cnt; ++s) { float xv[8]; unpack8(*(const bf16x8*)(p - (size_t)s * INP), xv);
#pragma unroll
            for (int e = 0; e < 8; ++e) sum[e] += xv[e]; }
        float d[8];
#pragma unroll
        for (int e = 0; e < 8; ++e) d[e] = sum[e] * icnt - x0[e];
        Df[ks] = pack8(d);
    }
    bf16_t* out = (bf16_t*)(c.ws + WS_A) + (size_t)tg * DM + gp * 64;
#pragma unroll
    for (int jt = 0; jt < 4; ++jt) {
        f32x4 acc = (f32x4){0.f, 0.f, 0.f, 0.f};
#pragma unroll
        for (int ks = 0; ks < 2; ++ks) { const bf16x8 wf = *(const bf16x8*)(WpT + (size_t)(16 * jt + r16) * 64 + ks * 32 + g * 8); acc = MFMA16(wf, Df[ks], acc); }
        const f32x4 sc = *(const f32x4*)(pool_scale + gp * 64 + 16 * jt + 4 * g);
        u32x2 o; o.x = cvt_pk_bf16(acc[0] * sc[0], acc[1] * sc[1]); o.y = cvt_pk_bf16(acc[2] * sc[2], acc[3] * sc[3]);
        *(u32x2*)(out + 16 * jt + 4 * g) = o;
    }
}
__device__ __forceinline__ void lru_unit(const Ctx& c, int u, int layer, const float* conv_w, const float* conv_b, const float* b_r, const float* b_i, const float* lam) {
    const int hh = u & 3, ch = (u >> 2) % LRU_NCH, b = (u >> 2) / LRU_NCH;
    const int lane = c.lane, r16 = lane & 15, g = lane >> 4;
    const bf16_t* proj = (const bf16_t*)(c.ws + WS_HID);
    const bf16_t* WrT = (const bf16_t*)(c.ws + WS_WLRU) + (size_t)((layer * 2 + 0) * 4 + hh) * 4096;
    const bf16_t* WiT = (const bf16_t*)(c.ws + WS_WLRU) + (size_t)((layer * 2 + 1) * 4 + hh) * 4096;
    float* HL = (float*)(c.ws + WS_F); float* CA = HL + (size_t)M * 256;
    float n8sp[4][4], hcar[4][4], acar[4][4];
#pragma unroll
    for (int jt = 0; jt < 4; ++jt)
#pragma unroll
        for (int jj = 0; jj < 4; ++jj) { const float L = lam[hh * 64 + 16 * jt + 4 * g + jj]; n8sp[jt][jj] = -8.0f * log1pf(__expf(-L)); hcar[jt][jj] = 0.f; acar[jt][jj] = 1.f; }
    for (int tile = 0; tile < LRU_CHUNK / 16; ++tile) {
        const int t = ch * LRU_CHUNK + tile * 16 + r16; const size_t tg = (size_t)b * SEQ + t;
        bf16x8 Xf[2];
#pragma unroll
        for (int ks = 0; ks < 2; ++ks) {
            const int c0 = hh * 64 + ks * 32 + g * 8; float acc8[8];
            { const f32x4 b0 = *(const f32x4*)(conv_b + c0), b1 = *(const f32x4*)(conv_b + c0 + 4); acc8[0] = b0[0]; acc8[1] = b0[1]; acc8[2] = b0[2]; acc8[3] = b0[3]; acc8[4] = b1[0]; acc8[5] = b1[1]; acc8[6] = b1[2]; acc8[7] = b1[3]; }
#pragma unroll
            for (int k = 0; k < 4; ++k) { const int tt = t - 3 + k;
                if (tt >= 0) { float xv[8]; unpack8(*(const bf16x8*)(proj + ((size_t)b * SEQ + tt) * INP + C_XL + c0), xv);
                    const f32x4 w0 = *(const f32x4*)(conv_w + k * 256 + c0), w1 = *(const f32x4*)(conv_w + k * 256 + c0 + 4);
                    acc8[0] += w0[0] * xv[0]; acc8[1] += w0[1] * xv[1]; acc8[2] += w0[2] * xv[2]; acc8[3] += w0[3] * xv[3];
                    acc8[4] += w1[0] * xv[4]; acc8[5] += w1[1] * xv[5]; acc8[6] += w1[2] * xv[6]; acc8[7] += w1[3] * xv[7]; } }
            Xf[ks] = pack8(acc8);
        }
#pragma unroll
        for (int jt = 0; jt < 4; ++jt) {
            f32x4 aR = (f32x4){0.f, 0.f, 0.f, 0.f}, aI = (f32x4){0.f, 0.f, 0.f, 0.f};
#pragma unroll
            for (int ks = 0; ks < 2; ++ks) { const size_t wo = (size_t)(16 * jt + r16) * 64 + ks * 32 + g * 8;
                aR = MFMA16(*(const bf16x8*)(WrT + wo), Xf[ks], aR); aI = MFMA16(*(const bf16x8*)(WiT + wo), Xf[ks], aI); }
            const int c4 = hh * 64 + 16 * jt + 4 * g;
            f32x4 xc = *(const f32x4*)(conv_b + c4);
#pragma unroll
            for (int k = 0; k < 4; ++k) { const int tt = t - 3 + k;
                if (tt >= 0) { const u32x2 xw = *(const u32x2*)(proj + ((size_t)b * SEQ + tt) * INP + C_XL + c4); const f32x4 w4 = *(const f32x4*)(conv_w + k * 256 + c4);
                    xc[0] += w4[0] * bflo(xw.x); xc[1] += w4[1] * bfhi(xw.x); xc[2] += w4[2] * bflo(xw.y); xc[3] += w4[3] * bfhi(xw.y); } }
            const f32x4 br4 = *(const f32x4*)(b_r + c4), bi4 = *(const f32x4*)(b_i + c4);
            f32x4 hv, cv;
#pragma unroll
            for (int jj = 0; jj < 4; ++jj) {
                const float r = sigmoidf_(aR[jj] + br4[jj]), ii = sigmoidf_(aI[jj] + bi4[jj]);
                const float la = n8sp[jt][jj] * r; float av = __expf(la); float bv = sqrtf(fmaxf(-expm1f(2.0f * la), 0.f)) * (ii * xc[jj]);
#pragma unroll
                for (int d = 1; d < 16; d <<= 1) { const float ap = __shfl_up(av, d, 16), bp = __shfl_up(bv, d, 16); if (r16 >= d) { bv = av * bp + bv; av = av * ap; } }
                const float h = av * hcar[jt][jj] + bv, ca = av * acar[jt][jj];
                hv[jj] = h; cv[jj] = ca;
                hcar[jt][jj] = __shfl(h, 15, 16); acar[jt][jj] = __shfl(ca, 15, 16);
            }
            *(f32x4*)(HL + tg * 256 + c4) = hv; *(f32x4*)(CA + tg * 256 + c4) = cv;
        }
    }
    if (r16 == 15) {
        float* carA = (float*)(c.ws + WS_CARA) + (size_t)(b * LRU_NCH + ch) * 256; float* carH = (float*)(c.ws + WS_CARH) + (size_t)(b * LRU_NCH + ch) * 256;
#pragma unroll
        for (int jt = 0; jt < 4; ++jt) { const int c4 = hh * 64 + 16 * jt + 4 * g;
            *(f32x4*)(carA + c4) = (f32x4){acar[jt][0], acar[jt][1], acar[jt][2], acar[jt][3]}; *(f32x4*)(carH + c4) = (f32x4){hcar[jt][0], hcar[jt][1], hcar[jt][2], hcar[jt][3]}; }
    }
}
__device__ __forceinline__ void cmp_unit(const Ctx& c, int u, int layer, const float* pe) {
    const int nt_ = u & 63, bk = (u >> 6) & 3, kv = u >> 8; const int b = bk >> 1, kvh = bk & 1;
    const int lane = c.lane, r16 = lane & 15, g = lane >> 4;
    const bf16_t* proj = (const bf16_t*)(c.ws + WS_HID);
    const bf16_t* WT = (const bf16_t*)(c.ws + WS_WCMP) + (size_t)(layer * 2 + kv) * 64 * 2048;
    const float* ct = (const float*)(c.ws + WS_COS); const float* st = (const float*)(c.ws + WS_SIN);
    const int n = nt_ * 16 + r16; const int colb = (kv ? C_VC : C_KC) + kvh * 64;
    f32x4 acc[4];
#pragma unroll
    for (int e = 0; e < 4; ++e) acc[e] = (f32x4){0.f, 0.f, 0.f, 0.f};
    for (int l = 0; l < 32; ++l) {
        int t = 16 * n + l; if (t > SEQ - 1) t = SEQ - 1;
        const size_t tg = (size_t)b * SEQ + t;
        float x1[8], x2[8];
        unpack8(*(const bf16x8*)(proj + tg * INP + colb + g * 8), x1); unpack8(*(const bf16x8*)(proj + tg * INP + colb + 32 + g * 8), x2);
        float o1[8], o2[8];
        if (kv == 0) {
            const f32x4 c0 = *(const f32x4*)(ct + tg * 32 + g * 8), c1 = *(const f32x4*)(ct + tg * 32 + g * 8 + 4), s0 = *(const f32x4*)(st + tg * 32 + g * 8), s1 = *(const f32x4*)(st + tg * 32 + g * 8 + 4);
#pragma unroll
            for (int e = 0; e < 8; ++e) { const float cc = e < 4 ? c0[e & 3] : c1[e & 3], ss = e < 4 ? s0[e & 3] : s1[e & 3]; o1[e] = x1[e] * cc - x2[e] * ss; o2[e] = x2[e] * cc + x1[e] * ss; }
        } else {
#pragma unroll
            for (int e = 0; e < 8; ++e) { o1[e] = x1[e]; o2[e] = x2[e]; }
        }
        { const f32x4 p0 = *(const f32x4*)(pe + l * 64 + g * 8), p1 = *(const f32x4*)(pe + l * 64 + g * 8 + 4), p2 = *(const f32x4*)(pe + l * 64 + 32 + g * 8), p3 = *(const f32x4*)(pe + l * 64 + 32 + g * 8 + 4);
#pragma unroll
            for (int e = 0; e < 4; ++e) { o1[e] += p0[e]; o1[4 + e] += p1[e]; o2[e] += p2[e]; o2[4 + e] += p3[e]; } }
        const bf16x8 X0 = pack8(o1), X1 = pack8(o2);
#pragma unroll
        for (int et = 0; et < 4; ++et) {
            const bf16_t* wp = WT + (size_t)(16 * et + r16) * 2048 + l * 64 + g * 8;
            const bf16x8 W0 = *(const bf16x8*)wp, W1 = *(const bf16x8*)(wp + 32);
            if (kv == 0) { acc[et] = MFMA16(W0, X0, acc[et]); acc[et] = MFMA16(W1, X1, acc[et]); }
            else         { acc[et] = MFMA16(X0, W0, acc[et]); acc[et] = MFMA16(X1, W1, acc[et]); }
        }
    }
    if (kv == 0) {
        bf16_t* dst = (bf16_t*)(c.ws + WS_KCMP) + ((size_t)bk * 1024 + n) * 64;
        const bool z = (n >= 1023);
#pragma unroll
        for (int et = 0; et < 4; ++et) { u32x2 o; o.x = cvt_pk_bf16(acc[et][0], acc[et][1]); o.y = cvt_pk_bf16(acc[et][2], acc[et][3]); if (z) { o.x = 0u; o.y = 0u; } *(u32x2*)(dst + 16 * et + 4 * g) = o; }
    } else {
        bf16_t* dst = (bf16_t*)(c.ws + WS_VCMPT) + (size_t)bk * 64 * 1024;
        const int nb = nt_ * 16 + 4 * g;
#pragma unroll
        for (int et = 0; et < 4; ++et) { float v3 = acc[et][3]; if (nb + 3 >= 1023) v3 = 0.f; u32x2 o; o.x = cvt_pk_bf16(acc[et][0], acc[et][1]); o.y = cvt_pk_bf16(acc[et][2], v3); *(u32x2*)(dst + ((size_t)(nb >> 6) * 64 + 16 * et + r16) * 64 + (nb & 63)) = o; }
    }
}

constexpr int NU_LRU = BATCH * LRU_NCH * 4, NU_CMP = 512, NU_POOL = (M / 16) * 4, NU_ROPE = M / 16, NU_VT = 2048;
__device__ __forceinline__ void phase_prep(const Ctx& c, int layer) {
    const float* pool_scale = INP_F(12) + layer * 256;
    const float* conv_w = INP_F(13) + layer * 1024; const float* conv_b = INP_F(14) + layer * 256;
    const float* b_r = INP_F(16) + layer * 256; const float* b_i = INP_F(18) + layer * 256; const float* lam = INP_F(19) + layer * 256;
    const float* pe = INP_F(22) + layer * 2048;
    for (int u = c.gw; u < NU_LRU; u += c.ngw) lru_unit(c, u, layer, conv_w, conv_b, b_r, b_i, lam);
    for (int u = c.gw; u < NU_CMP; u += c.ngw) cmp_unit(c, u, layer, pe);
    for (int u = c.gw; u < NU_VT; u += c.ngw) vt_unit(c, u);
    for (int u = c.gw; u < NU_ROPE; u += c.ngw) rope_unit(c, u);
    for (int u = c.gw; u < NU_POOL; u += c.ngw) pool_unit(c, u, layer, pool_scale);
}

constexpr int NCG = 2, QPW = 4 * NCG;
struct AttnRegs { f32x4 O[4][NCG]; float m[NCG], l[NCG]; };

__device__ __forceinline__ void attn_reset(AttnRegs& R) {
#pragma unroll
    for (int md = 0; md < 4; ++md)
#pragma unroll
        for (int cg_ = 0; cg_ < NCG; ++cg_) R.O[md][cg_] = (f32x4){0.f, 0.f, 0.f, 0.f};
#pragma unroll
    for (int cg_ = 0; cg_ < NCG; ++cg_) { R.m[cg_] = -1e30f; R.l[cg_] = 0.f; }
}

constexpr int ATT_SLOT = 32768, ATT_WBASE = 2 * ATT_SLOT, ATT_WLDS = 9216;
#define ATT_BAR() do { asm volatile("s_waitcnt lgkmcnt(0)" ::: "memory"); __builtin_amdgcn_s_barrier(); asm volatile("" ::: "memory"); } while (0)

template <int CTRL> __device__ __forceinline__ int dpp_i(int v) { return __builtin_amdgcn_update_dpp(v, v, CTRL, 0xF, 0xF, false); }
template <int CTRL> __device__ __forceinline__ float dpp_f(float v) { return __int_as_float(dpp_i<CTRL>(__float_as_int(v))); }
__device__ __forceinline__ int row16_sum(int v) { v += dpp_i<0xB1>(v); v += dpp_i<0x4E>(v); v += dpp_i<0x141>(v); v += dpp_i<0x140>(v); return v; }
__device__ __forceinline__ float rowmax4(float x) {
    auto r = __builtin_amdgcn_permlane16_swap(__float_as_uint(x), __float_as_uint(x), false, false);
    const float a = fmaxf(__uint_as_float(r[0]), __uint_as_float(r[1]));
    auto q = __builtin_amdgcn_permlane32_swap(__float_as_uint(a), __float_as_uint(a), false, false);
    return fmaxf(__uint_as_float(q[0]), __uint_as_float(q[1]));
}
__device__ __forceinline__ float rowsum4(float x) {
    auto r = __builtin_amdgcn_permlane16_swap(__float_as_uint(x), __float_as_uint(x), false, false);
    const float a = __uint_as_float(r[0]) + __uint_as_float(r[1]);
    auto q = __builtin_amdgcn_permlane32_swap(__float_as_uint(a), __float_as_uint(a), false, false);
    return __uint_as_float(q[0]) + __uint_as_float(q[1]);
}

template <int MODE, bool MASKED>
__device__ __forceinline__ void attn_tile64(AttnRegs& R, const bf16x8 (&Qf)[NCG][2], LAS unsigned char* slot, int kb0, unsigned act, int tq_base, const unsigned (&selw)[NCG], int bit,
                                            int lane, LAS float* imp, int qi, int hg) {
    const int r16 = lane & 15, g = lane >> 4;
    const int fK = (r16 >> 2) | (((r16 >> 1) & 1) << 2), fV = (r16 >> 1) & 7;
    const int krow = 8 * (r16 >> 2) + (r16 & 3);
    LAS unsigned char* kp0 = slot + krow * 128 + ((g ^ fK) << 4);
    LAS unsigned char* kp1 = slot + krow * 128 + (((4 + g) ^ fK) << 4);
    LAS unsigned char* vp0 = slot + 8192 + r16 * 128 + ((g ^ fV) << 4);
    LAS unsigned char* vp1 = slot + 8192 + r16 * 128 + (((4 + g) ^ fV) << 4);
#pragma unroll
    for (int cg_ = 0; cg_ < NCG; ++cg_) {
        if (!(act & (1u << cg_))) continue;
        float s[16];
#pragma unroll
        for (int half = 0; half < 2; ++half) {
            const bf16x8 k00 = *(const LAS bf16x8*)(kp0 + half * 4096), k01 = *(const LAS bf16x8*)(kp1 + half * 4096);
            const bf16x8 k10 = *(const LAS bf16x8*)(kp0 + half * 4096 + 512), k11 = *(const LAS bf16x8*)(kp1 + half * 4096 + 512);
            f32x4 s0 = (f32x4){0.f, 0.f, 0.f, 0.f}, s1 = (f32x4){0.f, 0.f, 0.f, 0.f};
            s0 = MFMA16(k00, Qf[cg_][0], s0); s1 = MFMA16(k10, Qf[cg_][0], s1);
            s0 = MFMA16(k01, Qf[cg_][1], s0); s1 = MFMA16(k11, Qf[cg_][1], s1);
#pragma unroll
            for (int j = 0; j < 4; ++j) { s[half * 8 + j] = s0[j]; s[half * 8 + 4 + j] = s1[j]; }
        }
        const int tq = tq_base + 4 * cg_;
        if (MASKED) {
#pragma unroll
            for (int i = 0; i < 16; ++i) { const int key = kb0 + 32 * (i >> 3) + 8 * g + (i & 7); bool ok;
                if (MODE == 0) ok = (key <= tq) && (tq - key < 512);
                else if (MODE == 1) ok = (key <= tq);
                else ok = (16 * key + 31 <= tq);
                s[i] = ok ? s[i] : -INFINITY; }
        }
        const bool lane_on = (MODE == 1) ? (((selw[cg_] >> bit) & 1u) != 0u) : true;
        float p[16];
        if (MODE == 2) {
            const float mm = R.m[cg_], il = R.l[cg_];
#pragma unroll
            for (int i = 0; i < 16; ++i) p[i] = fexp2(s[i] - mm) * il;
#pragma unroll
            for (int half = 0; half < 2; ++half) {
                float ps[8];
#pragma unroll
                for (int i = 0; i < 8; ++i) { float v = p[half * 8 + i]; v += dpp_f<0xB1>(v); v += dpp_f<0x4E>(v); ps[i] = v; }
                if (hg == 0) {
                    const int jb = (kb0 + 32 * half + 8 * g) >> 2; LAS float* ip = imp + (4 * cg_ + qi) * 256 + jb;
                    __hip_atomic_fetch_add(ip, (ps[0] + ps[1]) + (ps[2] + ps[3]), __ATOMIC_RELAXED, __HIP_MEMORY_SCOPE_WORKGROUP);
                    if (jb + 1 < 256) __hip_atomic_fetch_add(ip + 1, ps[3] + (ps[4] + ps[5]) + (ps[6] + ps[7]), __ATOMIC_RELAXED, __HIP_MEMORY_SCOPE_WORKGROUP);
                    if (jb + 2 < 256) __hip_atomic_fetch_add(ip + 2, ps[7], __ATOMIC_RELAXED, __HIP_MEMORY_SCOPE_WORKGROUP);
                }
            }
        } else {
            float mx = fmaxf(fmaxf(fmaxf(s[0], s[1]), s[2]), fmaxf(fmaxf(s[3], s[4]), s[5])); mx = fmaxf(fmaxf(mx, s[6]), s[7]);
            float my = fmaxf(fmaxf(fmaxf(s[8], s[9]), s[10]), fmaxf(fmaxf(s[11], s[12]), s[13])); my = fmaxf(fmaxf(my, s[14]), s[15]);
            mx = fmaxf(mx, my);
            if (MODE == 1) mx = lane_on ? mx : -INFINITY;
            mx = rowmax4(mx);
            const float mold = R.m[cg_], mnew = fmaxf(mold, mx);
            if (__builtin_amdgcn_ballot_w64(mnew > mold) != 0ull) {
                const float alpha = fexp2(mold - mnew); R.m[cg_] = mnew; R.l[cg_] *= alpha;
                if (MODE != 3) {
#pragma unroll
                    for (int md = 0; md < 4; ++md) R.O[md][cg_] = R.O[md][cg_] * alpha;
                }
            }
            const float msub = ((MODE == 1) && !lane_on) ? INFINITY : mnew;
            float sum0 = 0.f, sum1 = 0.f;
#pragma unroll
            for (int i = 0; i < 8; ++i) { p[i] = fexp2(s[i] - msub); sum0 += p[i]; p[8 + i] = fexp2(s[8 + i] - msub); sum1 += p[8 + i]; }
            R.l[cg_] += sum0 + sum1;
        }
        if (MODE != 3) {
            const bf16x8 P0 = pack8(p), P1 = pack8(p + 8);
#pragma unroll
            for (int md = 0; md < 4; ++md) { const bf16x8 v0 = *(const LAS bf16x8*)(vp0 + md * 2048), v1 = *(const LAS bf16x8*)(vp1 + md * 2048);
                R.O[md][cg_] = MFMA16(v0, P0, R.O[md][cg_]); R.O[md][cg_] = MFMA16(v1, P1, R.O[md][cg_]); }
        }
    }
}

template <int MODE>
__device__ __forceinline__ void attn_stream(AttnRegs& R, const bf16x8 (&Qf)[NCG][2], LAS unsigned char* ring, const bf16_t* Kg, const bf16_t* Vg, int ldv, int t0, int nt, int tq_base,
                                            LAS unsigned* msk, LAS unsigned* uni, LAS float* imp, int tid, int lane, int qi, int hg) {
    constexpr bool HASV = (MODE != 3);
    const int tq_min_ = __builtin_amdgcn_readfirstlane(tq_base - qi), qb_ = tq_min_ >> 6;
    const int row = tid >> 3, cpos = tid & 7;
    const int cK = cpos ^ (((row >> 3) & 3) | (((row >> 1) & 1) << 2)), cV = cpos ^ ((row >> 1) & 7);
    const unsigned offk = (unsigned)(row * 64 + cK * 8) * 2u, offv = (unsigned)(row * 64 + cV * 8) * 2u;
    typedef const __attribute__((address_space(1))) char gcchar;
    gcchar* gk = (gcchar*)Kg + (size_t)t0 * 8192; gcchar* gv = (gcchar*)Vg + (size_t)t0 * 8192;
    const u32x4 z4 = (u32x4){0u, 0u, 0u, 0u};
    u32x4 ka0 = z4, va0 = z4, ka1 = z4, va1 = z4, kb0 = z4, vb0 = z4, kb1 = z4, vb1 = z4;
    const int ng = (nt + 1) >> 1;
#define ATT_LOADG(G, K0, V0, K1, V1) do { int T0_ = 2 * (G), T1_ = T0_ + 1; T0_ = T0_ < nt ? T0_ : nt - 1; T1_ = T1_ < nt ? T1_ : nt - 1;     \
        K0 = *(const __attribute__((address_space(1))) u32x4*)(gk + (size_t)T0_ * 8192 + offk); if (HASV) V0 = *(const __attribute__((address_space(1))) u32x4*)(gv + (size_t)T0_ * 8192 + offv); \
        K1 = *(const __attribute__((address_space(1))) u32x4*)(gk + (size_t)T1_ * 8192 + offk); if (HASV) V1 = *(const __attribute__((address_space(1))) u32x4*)(gv + (size_t)T1_ * 8192 + offv); } while (0)
#define ATT_STOREG(G, K0, V0, K1, V1) do { LAS unsigned char* ns_ = ring + ((G) & 1) * ATT_SLOT + tid * 16; \
        *(LAS u32x4*)ns_ = K0; if (HASV) *(LAS u32x4*)(ns_ + 8192) = V0; \
        *(LAS u32x4*)(ns_ + 16384) = K1; if (HASV) *(LAS u32x4*)(ns_ + 24576) = V1; } while (0)
    ATT_LOADG(0, ka0, va0, ka1, va1);
    ATT_STOREG(0, ka0, va0, ka1, va1);
    ATT_LOADG(1, ka0, va0, ka1, va1);
    ATT_BAR();
    unsigned selw[NCG];
#pragma unroll
    for (int cg_ = 0; cg_ < NCG; ++cg_) selw[cg_] = 0u;
#define ATT_STEP(I, PK0, PV0, PK1, PV1, WK0, WV0, WK1, WV1) do { \
        ATT_LOADG((I) + 2, PK0, PV0, PK1, PV1); \
        _Pragma("unroll 1") for (int sub_ = 0; sub_ < 2; ++sub_) { \
            if (2 * (I) + sub_ >= nt) break; \
            LAS unsigned char* slot = ring + ((I) & 1) * ATT_SLOT + sub_ * 16384; \
            const int tile = t0 + 2 * (I) + sub_; \
            unsigned act = (1u << NCG) - 1u; int bit = 0; \
            if (MODE == 1) { const int w = tile >> 5; bit = tile & 31; act = 0u; \
                _Pragma("unroll") for (int cg_ = 0; cg_ < NCG; ++cg_) { act |= ((__builtin_amdgcn_readfirstlane(uni[8 + cg_ * 8 + w]) >> bit) & 1u) << cg_; selw[cg_] = msk[(4 * cg_ + qi) * 8 + w]; } } \
            bool masked_; \
            if (MODE == 0) masked_ = (tile == qb_) || (tile == qb_ - 8); \
            else if (MODE == 1) masked_ = (tile == qb_); \
            else masked_ = (16 * (64 * tile + 63) + 31 > tq_min_); \
            if (act) { if (masked_) attn_tile64<MODE, true>(R, Qf, slot, tile * 64, act, tq_base, selw, bit, lane, imp, qi, hg); \
                       else attn_tile64<MODE, false>(R, Qf, slot, tile * 64, act, tq_base, selw, bit, lane, imp, qi, hg); } \
        } \
        ATT_STOREG((I) + 1, WK0, WV0, WK1, WV1); \
        ATT_BAR(); } while (0)
    for (int i = 0; i < ng; i += 2) {
        ATT_STEP(i, kb0, vb0, kb1, vb1, ka0, va0, ka1, va1);
        if (i + 1 >= ng) break;
        ATT_STEP(i + 1, ka0, va0, ka1, va1, kb0, vb0, kb1, vb1);
    }
#undef ATT_STEP
#undef ATT_LOADG
#undef ATT_STOREG
}

template <int MODE, bool NORM>
__device__ __forceinline__ void attn_flush(AttnRegs& R, LAS float* ofin, const bf16_t* gp  , bf16_t* outp, int lane) {
#pragma unroll
    for (int cg_ = 0; cg_ < NCG; ++cg_) {
        float sc = sigmoidf_(bf1(gp[(size_t)(4 * cg_) * INP]));
        if (NORM) { const float L = rowsum4(R.l[cg_]); sc = L > 0.f ? sc / L : 0.f; }
#pragma unroll
        for (int md = 0; md < 4; ++md) {
            f32x4 v = R.O[md][cg_] * sc;
            LAS f32x4* slot = (LAS f32x4*)ofin + (md * NCG + cg_) * 64 + lane;
            if (MODE != 0) v = v + *slot;
            if (MODE != 2) *slot = v;
            else { u32x2 o; o.x = cvt_pk_bf16(v[0], v[1]); o.y = cvt_pk_bf16(v[2], v[3]); *(u32x2*)(outp + (size_t)(4 * cg_) * DM + 16 * md) = o; }
        }
    }
}

__device__ __forceinline__ void attn_unit(const Ctx& c, int bk, int qb) {
    int lane_ = c.lane, tid_ = c.tid; asm volatile("" : "+v"(lane_), "+v"(tid_));
    const int lane = lane_, r16 = lane & 15, g = lane >> 4, qi = r16 >> 2, hg = r16 & 3;
    const int b = bk >> 1, kvh = bk & 1;
    const int tq0 = qb * 64 + c.wave * QPW, cur = qb, head = kvh * 4 + hg;
    LAS unsigned char* ring = c.lds;
    LAS unsigned char* wl = c.lds + ATT_WBASE + c.wave * ATT_WLDS;
    unsigned long long wsi_ = (unsigned long long)c.ws; asm volatile("" : "+s"(wsi_)); unsigned char* wsu = (unsigned char*)(__attribute__((address_space(1))) unsigned char*)wsi_;
    LAS float* imp = (LAS float*)wl;
    LAS unsigned* msk = (LAS unsigned*)(wl + 8192);
    LAS unsigned* uni = (LAS unsigned*)(wl + 8192 + 256);
    const bf16_t* proj = (const bf16_t*)(wsu + WS_HID);
    const bf16_t* Qr = (const bf16_t*)(wsu + WS_QR);
    bf16x8 Qf[NCG][2];
#pragma unroll
    for (int cg_ = 0; cg_ < NCG; ++cg_) { const size_t tg = (size_t)b * SEQ + tq0 + 4 * cg_ + qi; const bf16_t* qp = Qr + tg * 512 + head * 64 + g * 8; Qf[cg_][0] = *(const bf16x8*)qp; Qf[cg_][1] = *(const bf16x8*)(qp + 32); }
    const bf16_t* gp = proj + ((size_t)b * SEQ + tq0 + qi) * INP + C_G + head * 3;
    bf16_t* outp = (bf16_t*)(wsu + WS_A) + ((size_t)b * SEQ + tq0 + qi) * DM + 512 + head * 64 + 4 * g;
    AttnRegs R;
    {
#pragma unroll
    for (int i = 0; i < QPW; ++i) ((LAS f32x4*)imp)[i * 64 + lane] = (f32x4){0.f, 0.f, 0.f, 0.f};
    CFENCE();
    {
        const bf16_t* Kc = (const bf16_t*)(wsu + WS_KCMP) + (size_t)bk * 1024 * 64; const bf16_t* Vc = (const bf16_t*)(wsu + WS_VCMPT) + (size_t)bk * 64 * 1024;
        const int ncount = 4 * qb + 3; const int nt = (ncount + 63) >> 6;
        attn_reset(R);
        attn_stream<3>(R, Qf, ring, Kc, Vc, 1024, 0, nt, tq0 + qi, msk, uni, imp, tid_, lane, qi, hg);
#pragma unroll
        for (int cg_ = 0; cg_ < NCG; ++cg_) { const float L = rowsum4(R.l[cg_]); R.l[cg_] = L > 0.f ? 1.0f / L : 0.f; }
        attn_stream<2>(R, Qf, ring, Kc, Vc, 1024, 0, nt, tq0 + qi, msk, uni, imp, tid_, lane, qi, hg);
    }
    LDS_WAIT(); CFENCE();
    }
    {
    if (cur < 16) {
        if (lane < QPW) {
#pragma unroll
            for (int w = 0; w < 8; ++w) { const int lo = 32 * w; unsigned v = 0u; if (cur >= lo) { const int nb = cur - lo + 1; v = nb >= 32 ? 0xFFFFFFFFu : ((1u << nb) - 1u); } msk[lane * 8 + w] = v; }
        }
    } else {
        LAS unsigned short* m16 = (LAS unsigned short*)msk;
        for (int rr = 0; rr < NCG; ++rr) {
            const int qq = 4 * rr + g; int v[16];
#pragma unroll
            for (int i = 0; i < 16; ++i) { const int j = i * 16 + r16; const bool cand = (j <= cur) && (j != 0) && (j != cur) && (j != cur - 1); v[i] = cand ? (int)__float_as_uint(imp[qq * 256 + j]) : -1; }
            int T = 0;
            for (int bitp = 30; bitp >= 0; --bitp) { const int cd = T | (1 << bitp); int cnt = 0;
#pragma unroll
                for (int i = 0; i < 16; ++i) cnt += (v[i] >= cd) ? 1 : 0;
                cnt = row16_sum(cnt);
                if (cnt >= 13) T = cd; }
            int gt = 0;
#pragma unroll
            for (int i = 0; i < 16; ++i) gt += (v[i] > T) ? 1 : 0;
            gt = row16_sum(gt);
            const int need = 13 - gt; int running = 0;
#pragma unroll
            for (int i = 0; i < 16; ++i) { const int j = i * 16 + r16; const bool eq = (v[i] == T);
                const unsigned long long bal = __ballot(eq); const unsigned be = (unsigned)(bal >> (16 * g)) & 0xFFFFu;
                const int rank = running + __popc(be & ((1u << r16) - 1u)); running += __popc(be);
                const bool forced = (j <= cur) && ((j == 0) || (j == cur) || (j == cur - 1));
                const bool sel = (v[i] > T) || (eq && rank < need) || forced;
                const unsigned long long bs = __ballot(sel);
                if (r16 == 0) m16[qq * 16 + i] = (unsigned short)((bs >> (16 * g)) & 0xFFFFu); }
        }
    }
    LDS_WAIT(); CFENCE();
    }
    if (lane < 8) { unsigned u = 0u;
#pragma unroll
        for (int q = 0; q < QPW; ++q) u |= msk[q * 8 + lane];
        uni[lane] = u; }
    if (lane < 8 * NCG) { const int cg_ = lane >> 3, w = lane & 7; unsigned u = 0u;
#pragma unroll
        for (int q = 0; q < 4; ++q) u |= msk[(4 * cg_ + q) * 8 + w];
        uni[8 + lane] = u; }
    LDS_WAIT(); CFENCE();
    attn_flush<0, false>(R, imp, gp + 0, outp, lane);
    {
        const bf16_t* Ks = (const bf16_t*)(wsu + WS_KS) + (size_t)bk * SEQ * 64; const bf16_t* Vs = (const bf16_t*)(wsu + WS_VST) + (size_t)bk * 64 * SEQ;
        {
        attn_reset(R);
        attn_stream<1>(R, Qf, ring, Ks, Vs, SEQ, 0, cur + 1, tq0 + qi, msk, uni, imp, tid_, lane, qi, hg);
        }
        attn_flush<1, true>(R, imp, gp + 1, outp, lane);
    }
    {
        const bf16_t* Kw = (const bf16_t*)(wsu + WS_KW) + (size_t)bk * SEQ * 64; const bf16_t* Vw = (const bf16_t*)(wsu + WS_VWT) + (size_t)bk * 64 * SEQ;
        int t0 = qb - 8; if (t0 < 0) t0 = 0;
        {
        attn_reset(R);
        attn_stream<0>(R, Qf, ring, Kw, Vw, SEQ, t0, qb - t0 + 1, tq0 + qi, msk, uni, imp, tid_, lane, qi, hg);
        }
        attn_flush<2, true>(R, imp, gp + 2, outp, lane);
    }
    LDS_WAIT(); CFENCE();
}

__device__ __forceinline__ void lru_fin_unit(const Ctx& c, int u) {
    const int hh = u & 3, ch = (u >> 2) % LRU_NCH, b = (u >> 2) / LRU_NCH; const int chn = hh * 64 + c.lane;
    const float* carA = (const float*)(c.ws + WS_CARA) + (size_t)b * LRU_NCH * 256 + chn; const float* carH = (const float*)(c.ws + WS_CARH) + (size_t)b * LRU_NCH * 256 + chn;
    float h = 0.f;
    for (int k = 0; k < ch; ++k) h = carA[k * 256] * h + carH[k * 256];
    const float* HL = (const float*)(c.ws + WS_F); const float* CA = HL + (size_t)M * 256;
    const bf16_t* proj = (const bf16_t*)(c.ws + WS_HID); bf16_t* out = (bf16_t*)(c.ws + WS_A);
    const size_t tg0 = (size_t)b * SEQ + ch * LRU_CHUNK;
#pragma unroll 4
    for (int t = 0; t < LRU_CHUNK; ++t) { const size_t tg = tg0 + t;
        const float hv = HL[tg * 256 + chn] + CA[tg * 256 + chn] * h; const float x = bf1(proj[tg * INP + C_GL + chn]);
        const float u3 = 0.7978845608028654f * (x + 0.044715f * x * x * x); const float th = 1.0f - 2.0f / (1.0f + __expf(2.0f * u3));
        const float y = hv * (0.5f * x * (1.0f + th));
        out[tg * DM + 256 + chn] = (bf16_t)(cvt_pk_bf16(y, 0.f) & 0xffffu); }
}

constexpr int NU_ATT = (SEQ / QPW) * 4;
__device__ __forceinline__ void phase_attn_units(const Ctx& c) {
    for (int p2 = (c.gw / NWAVES) * 2; p2 < 1024; p2 += c.G * 2) { const int p = p2 >> 1;
        for (int r = 0; r < 2; ++r) { const int bk = p & 3, ql = p >> 2; attn_unit(c, bk, r ? 255 - ql : ql); } }
    __syncthreads();
}
__device__ __forceinline__ void phase_attn_fin(const Ctx& c) {
    for (int u = c.gw; u < NU_LRU; u += c.ngw) lru_fin_unit(c, u);
}
__device__ __forceinline__ void phase_attn(const Ctx& c) {
    phase_attn_units(c);
    phase_attn_fin(c);
}

constexpr int N_PHASES = 1 + 11 * DEPTH;
__global__ void __launch_bounds__(NTHREADS, 2) fwd_kernel(Args args) {
    extern __shared__ __attribute__((aligned(16))) unsigned char lds_raw[];
    {
        LAS unsigned long long* tab = (LAS unsigned long long*)((LAS unsigned char*)lds_raw + PTAB_OFF);
        if (threadIdx.x < 28) tab[threadIdx.x] = (unsigned long long)args.in[threadIdx.x];
        if (threadIdx.x == 28) tab[28] = (unsigned long long)args.out;
        if (threadIdx.x == 29) tab[29] = (unsigned long long)args.ws;
        if (threadIdx.x == 30) tab[30] = (unsigned long long)(unsigned)args.rep_attn | ((unsigned long long)(unsigned)args.rep_fin << 32);
        if (threadIdx.x == 31) tab[31] = (unsigned long long)(unsigned)args.rep_prep;
        __syncthreads();
    }
    const int ph_lo = args.ph_lo, ph_hi = args.ph_hi;
    const int wave_s = __builtin_amdgcn_readfirstlane(threadIdx.x >> 6);
    using namespace pg8;
    for (int ph = ph_lo; ph < ph_hi; ++ph) {
        Ctx c;
        int tid = threadIdx.x; asm volatile("" : "+v"(tid));
        int bid = blockIdx.x; asm volatile("" : "+s"(bid));
        unsigned ldsb = (unsigned)(size_t)(LAS unsigned char*)lds_raw; asm volatile("" : "+s"(ldsb));
        c.lds = (LAS unsigned char*)(size_t)ldsb; c.tid = tid; c.lane = tid & 63; c.wave = __builtin_amdgcn_readfirstlane(tid >> 6);
        c.G = gridDim.x; c.gw = bid * NWAVES + c.wave; c.ngw = c.G * NWAVES;
        c.wlds = c.lds + c.wave * WAVE_LDS;
        unsigned char* ws = (unsigned char*)ldptr(c.lds, 29); c.ws = ws;
        float* outp = (float*)ldptr(c.lds, 28);
        if (ph == 0) {
#ifndef NO_P0
            p0_prologue(c);
#endif
        } else {
            const int l = (ph - 1) / 11, s = (ph - 1) % 11;
            if (s == 0 || s == 8) {
                const int which = s == 8; Gemm g{(const bf16_t*)(ws + WS_A), (const bf16_t*)(ws + WS_WGU + (size_t)(l * 2 + which) * SZ_WGU), M, NGU, DM};
                StaticOrder S; S.init(M, NGU, c.G, bid); EpiSwiGLU E{(bf16_t*)(ws + WS_HID)};
                gemm_phase<EpiSwiGLU, StaticOrder, true, true>(c.lds, g, S, E, tid);
            } else if (s == 1 || s == 9 || s == 3 || s == 6) {
                const bf16_t* A; const bf16_t* Bt; bf16_t* O; int N, K;
                if (s == 3) { A = (const bf16_t*)(ws + WS_A); Bt = (const bf16_t*)(ws + WS_WIN + (size_t)l * SZ_WIN); O = (bf16_t*)(ws + WS_HID); N = INP; K = DM; }
                else if (s == 6) { A = (const bf16_t*)(ws + WS_A); Bt = (const bf16_t*)(ws + WS_WOUT + (size_t)l * SZ_WOUT); O = (bf16_t*)(ws + WS_F); N = DM; K = DM; }
                else { A = (const bf16_t*)(ws + WS_HID); Bt = (const bf16_t*)(ws + WS_WDN + (size_t)(l * 2 + (s == 9)) * SZ_WDN); O = (bf16_t*)(ws + WS_F); N = DM; K = FF; }
                Gemm g{A, Bt, M, N, K};
                StaticOrder S; S.init(M, N, c.G, bid); EpiStore E{O, N};
                gemm_phase<EpiStore, StaticOrder, true, true>(c.lds, g, S, E, tid);
            } else if (s == 4) {
#ifndef NO_PREP
                phase_prep(c, l);
#endif
            } else if (s == 5) {
#ifndef NO_ATTN
                phase_attn(c);
#endif
            } else {
                const float* hin = (s == 2 && l == 0) ? INP_F(0) : outp;
                const float* gpost = INP_F(s == 2 ? 3 : (s == 7 ? 8 : 24)) + l * DM;
                const float* gnext = s == 2 ? INP_F(7) + l * DM : (s == 7 ? INP_F(23) + l * DM : ((l + 1 < DEPTH) ? INP_F(2) + (l + 1) * DM : nullptr));
                rowpass(c, hin, outp, (const bf16_t*)(ws + WS_F), gpost, s == 7 ? 1.0f : 0.5f, gnext, (bf16_t*)(ws + WS_A));
            }
        }
        if (ph + 1 < ph_hi) { cg::this_grid().sync(); }
    }
}

extern "C" void kernel_launch(void* const* d_in, const int* in_sizes, int n_in, void* d_out, int out_size, void* d_ws, size_t ws_size, hipStream_t stream) {
    static int grid = 0;
    if (grid == 0) {
        if (n_in != 28 || out_size != M * DM || ws_size < WS_END) { fprintf(stderr, "kernel_launch: unexpected shapes (n_in %d out %d ws %zu need %zu)\n", n_in, out_size, ws_size, (size_t)WS_END); grid = -1; return; }
        int dev = 0, cus = 0, per_cu = 0;
        hipGetDevice(&dev); hipDeviceGetAttribute(&cus, hipDeviceAttributeMultiprocessorCount, dev);
        if (hipFuncSetAttribute((const void*)fwd_kernel, hipFuncAttributeMaxDynamicSharedMemorySize, LDS_BYTES) != hipSuccess) { fprintf(stderr, "kernel_launch: hipFuncSetAttribute failed\n"); grid = -1; return; }
        if (hipOccupancyMaxActiveBlocksPerMultiprocessor(&per_cu, (const void*)fwd_kernel, NTHREADS, LDS_BYTES) != hipSuccess || per_cu < 1) { fprintf(stderr, "kernel_launch: occupancy query says %d\n", per_cu); per_cu = 1; }
        (void)hipGetLastError();
        grid = cus * per_cu;
        fprintf(stderr, "kernel_launch: grid %d (cus %d x %d)\n", grid, cus, per_cu);
    }
    if (grid < 0) return;
    Args a{};
    for (int i = 0; i < 28; ++i) a.in[i] = d_in[i];
    a.out = (float*)d_out; a.ws = (unsigned char*)d_ws;
#ifndef REP_ATTN
#define REP_ATTN 1
#endif
#ifndef REP_FIN
#define REP_FIN 1
#endif
#ifndef REP_PREP
#define REP_PREP 0
#endif
    a.rep_attn = REP_ATTN; a.rep_fin = REP_FIN; a.rep_prep = REP_PREP; a.rep_pad = 0;
#if N_LAUNCH_MODE == 1
    a.ph_lo = 0; a.ph_hi = N_PHASES;
    void* kargs[] = {&a};
    hipError_t e = hipLaunchCooperativeKernel((const void*)fwd_kernel, dim3(grid), dim3(NTHREADS), kargs, LDS_BYTES, stream);
    if (e != hipSuccess) fprintf(stderr, "cooperative launch failed: %s (grid %d)\n", hipGetErrorString(e), grid);
#else
    for (int ph = 0; ph < N_PHASES; ++ph) {
        a.ph_lo = ph; a.ph_hi = ph + 1;
        hipLaunchKernelGGL(fwd_kernel, dim3(grid), dim3(NTHREADS), LDS_BYTES, stream, a);
    }
#endif
}
```

```cpp
#include <hip/hip_runtime.h>
#include <hip/hip_cooperative_groups.h>
#include <cstdio>
#include <cstdint>
namespace cg = cooperative_groups;

#define LAS __attribute__((address_space(3)))
typedef unsigned short bf16_t;
typedef short bf16x8 __attribute__((ext_vector_type(8)));
typedef float f32x4 __attribute__((ext_vector_type(4)));
typedef float f32x2 __attribute__((ext_vector_type(2)));
typedef unsigned u32x4 __attribute__((ext_vector_type(4)));
typedef unsigned u32x2 __attribute__((ext_vector_type(2)));

#ifndef N_LAUNCH_MODE
#define N_LAUNCH_MODE 1
#endif

constexpr int BATCH = 2, SEQ = 16384, DM = 1024, M = BATCH * SEQ, FF = 2816, NGU = 2 * FF, DEPTH = 2;
constexpr int INC = 2072, INP = 2304;
constexpr int C_XP = 0, C_XL = 256, C_GL = 512, C_Q = 768, C_KC = 1280, C_VC = 1408, C_KS = 1536, C_VS = 1664, C_KW = 1792, C_VW = 1920, C_G = 2048;
constexpr float EPS = 1e-6f;
constexpr float QSCALE = 0.125f * 1.4426950408889634f;
constexpr int NWAVES = 8, NTHREADS = 512;
constexpr int LRU_CHUNK = 128, LRU_NCH = SEQ / LRU_CHUNK;

constexpr size_t SZ_WGU = (size_t)NGU * DM * 2, SZ_WDN = (size_t)DM * FF * 2, SZ_WIN = (size_t)INP * DM * 2, SZ_WOUT = (size_t)DM * DM * 2;
constexpr size_t WS_WGU = 0;
constexpr size_t WS_WDN = WS_WGU + 4 * SZ_WGU;
constexpr size_t WS_WIN = WS_WDN + 4 * SZ_WDN;
constexpr size_t WS_WOUT = WS_WIN + 2 * SZ_WIN;
constexpr size_t WS_WPOOL = WS_WOUT + 2 * SZ_WOUT;
constexpr size_t WS_WLRU = WS_WPOOL + 2 * 4 * 4096 * 2;
constexpr size_t WS_WCMP = WS_WLRU + 2 * 2 * 4 * 4096 * 2;
constexpr size_t WS_COS = WS_WCMP + 2 * 2 * 64 * 2048 * 2;
constexpr size_t WS_SIN = WS_COS + (size_t)M * 32 * 4;
constexpr size_t WS_A = WS_SIN + (size_t)M * 32 * 4;
constexpr size_t WS_HID = WS_A + (size_t)M * DM * 2;
constexpr size_t WS_QR = WS_HID + (size_t)M * INP * 2;
constexpr size_t WS_F = WS_HID + (size_t)M * FF * 2;
constexpr size_t WS_KS = WS_F + (size_t)M * DM * 2;
constexpr size_t WS_KW = WS_KS + (size_t)4 * SEQ * 64 * 2;
constexpr size_t WS_VST = WS_KW + (size_t)4 * SEQ * 64 * 2;
constexpr size_t WS_VWT = WS_VST + (size_t)4 * SEQ * 64 * 2;
constexpr size_t WS_KCMP = WS_VWT + (size_t)4 * SEQ * 64 * 2;
constexpr size_t WS_VCMPT = WS_KCMP + (size_t)4 * 1024 * 64 * 2;
constexpr size_t WS_CARA = WS_VCMPT + (size_t)4 * 1024 * 64 * 2;
constexpr size_t WS_CARH = WS_CARA + (size_t)BATCH * LRU_NCH * 256 * 4;
constexpr size_t WS_END = WS_CARH + (size_t)BATCH * LRU_NCH * 256 * 4;
static_assert(WS_QR + (size_t)M * 512 * 2 == WS_F, "Qr fills the tail of the hidden buffer");
static_assert(WS_END <= (size_t)512 * 1024 * 1024, "workspace map");
static_assert(2 * 32768 + 8 * 9216 <= 147456 - 256, "attention LDS map");

constexpr int LDS_BYTES = 147456;
constexpr int WAVE_LDS = 17408;

__device__ __forceinline__ unsigned cvt_pk_bf16(float lo, float hi) { unsigned r; asm volatile("v_cvt_pk_bf16_f32 %0, %1, %2" : "=v"(r) : "v"(lo), "v"(hi)); return r; }
__device__ __forceinline__ float bflo(unsigned w) { return __uint_as_float(w << 16); }
__device__ __forceinline__ float bfhi(unsigned w) { return __uint_as_float(w & 0xffff0000u); }
__device__ __forceinline__ float bf1(unsigned short u) { return __uint_as_float((unsigned)u << 16); }
__device__ __forceinline__ float fexp2(float x) { return __builtin_amdgcn_exp2f(x); }
__device__ __forceinline__ float sigmoidf_(float x) { return 1.0f / (1.0f + __expf(-x)); }
__device__ __forceinline__ float wave_sum(float v) {
#pragma unroll
    for (int o = 1; o < 64; o <<= 1) v += __shfl_xor(v, o);
    return v;
}
#define LDS_WAIT() asm volatile("s_waitcnt lgkmcnt(0)" ::: "memory")
#define CFENCE() asm volatile("" ::: "memory")

namespace pg8 {
constexpr int BM = 256, BK = 64, HALF = 128, HTB = HALF * BK * 2, STAGE_BYTES = 8 * HTB, NXCD = 8, WGM = 8;
__host__ __device__ __forceinline__ int lds_byte(int r, int c) { const int st = (r >> 4) * 2 + (c >> 5), rr = r & 15, cc = c & 31, ob = rr * 64 + cc * 2; return st * 1024 + (ob ^ (((ob >> 9) & 1) << 5)); }
__host__ __device__ __forceinline__ void stage_rc(int b, int& R, int& C) { const int st = b / 1024, sb = b % 1024, swz = sb ^ (((sb >> 9) & 1) << 5); R = (st >> 1) * 16 + swz / 64; C = (st & 1) * 32 + (swz % 64) / 2; }
__host__ __device__ __forceinline__ int perm32(int rho) { const int n = rho >> 4, i = rho & 15; return 8 * (i >> 2) + 4 * n + (i & 3); }
struct Unit { int pm, pn; };
struct Gemm { const bf16_t* A; const bf16_t* Bt; int M, N, K; };
struct StaticOrder {
    int nM, nN, nwg, G, c;
    __device__ void init(int M_, int N_, int G_, int c_) { nM = M_ / BM; nN = N_ / BM; nwg = nM * nN; G = G_; c = c_; }
    __device__ bool next(int i, Unit& u) const {
        const long L = (long)i * G + c; if (L >= nwg) return false;
        int wgid = (int)L; { const int q = nwg / NXCD, r = nwg % NXCD, xcd = wgid % NXCD, off = wgid / NXCD; wgid = (xcd < r ? xcd * (q + 1) : r * (q + 1) + (xcd - r) * q) + off; }
        const int nig = WGM * nN, gid = wgid / nig, fm = gid * WGM, gsz = (nM - fm) < WGM ? (nM - fm) : WGM;
        u.pm = fm + ((wgid % nig) % gsz); u.pn = (wgid % nig) / gsz; return true;
    }
    __device__ __forceinline__ void a_ready(const Unit&) const {}
    __device__ __forceinline__ void done(const Unit&) const {}
};
struct EpiStore {
    static constexpr bool PERM = true, AFTER_DRAIN = false;
    bf16_t* O; int ldc;
    __device__ __forceinline__ void operator()(const f32x4 (&acc)[2][2][4][2], const Unit& u, int wr, int wc, int fr, int fq) const {
        const int row0 = u.pm * BM + wr * 64 + fr, col0 = u.pn * BM + wc * 32 + 8 * fq;
#pragma unroll
        for (int ai = 0; ai < 2; ++ai)
#pragma unroll
            for (int m = 0; m < 4; ++m) { bf16_t* rowp = O + (size_t)(row0 + ai * HALF + m * 16) * ldc + col0;
#pragma unroll
                for (int bj = 0; bj < 2; ++bj) { const f32x4 v0 = acc[ai][bj][m][0], v1 = acc[ai][bj][m][1];
                    u32x4 w; w.x = cvt_pk_bf16(v0[0], v0[1]); w.y = cvt_pk_bf16(v0[2], v0[3]); w.z = cvt_pk_bf16(v1[0], v1[1]); w.w = cvt_pk_bf16(v1[2], v1[3]);
                    *(u32x4*)(rowp + bj * HALF) = w; } }
    }
};
struct EpiSwiGLU {
    static constexpr bool PERM = true, AFTER_DRAIN = false;
    bf16_t* O;
    __device__ __forceinline__ void operator()(const f32x4 (&acc)[2][2][4][2], const Unit& u, int wr, int wc, int fr, int fq) const {
        const int row0 = u.pm * BM + wr * 64 + fr, col0 = u.pn * HALF + wc * 32 + 8 * fq;
#pragma unroll
        for (int ai = 0; ai < 2; ++ai)
#pragma unroll
            for (int m = 0; m < 4; ++m) { bf16_t* rowp = O + (size_t)(row0 + ai * HALF + m * 16) * FF + col0;
                float r[8];
#pragma unroll
                for (int n = 0; n < 2; ++n)
#pragma unroll
                    for (int j = 0; j < 4; ++j) { const float g = acc[ai][0][m][n][j], up = acc[ai][1][m][n][j];
                        r[n * 4 + j] = g * __builtin_amdgcn_rcpf(1.0f + fexp2(-1.4426950408889634f * g)) * up; }
                u32x4 w; w.x = cvt_pk_bf16(r[0], r[1]); w.y = cvt_pk_bf16(r[2], r[3]); w.z = cvt_pk_bf16(r[4], r[5]); w.w = cvt_pk_bf16(r[6], r[7]);
                *(u32x4*)rowp = w; }
    }
};

template <class Epi, class Sched, bool ALIGN_EPI = false, bool SP2 = false>
__device__ __forceinline__ void gemm_phase(LAS unsigned char* lds, const Gemm g, const Sched& S, const Epi& E, const int tid) {
    const int wid = __builtin_amdgcn_readfirstlane(tid >> 6), lane = tid & 63, wr = wid >> 2, wc = wid & 3, fr = lane & 15, fq = lane >> 4;
    const int K = g.K, nt = K / BK;
    unsigned voffA[2], voffB[2];
#pragma unroll
    for (int i = 0; i < 2; ++i) { int R, C; stage_rc(tid * 16 + i * 8192, R, C); const int Rb = Epi::PERM ? ((R & ~31) + perm32(R & 31)) : R;
        voffA[i] = (unsigned)(R * K + C) * 2u; voffB[i] = (unsigned)(Rb * K + C) * 2u; }
    const size_t kstep = (size_t)(BK * 2);
    const size_t hstep = (size_t)HALF * K * 2;
    const size_t tstep = 2 * hstep;
    const unsigned ldsw = (unsigned)wid * 1024u;
    const int aoff = lds_byte(wr * 64 + fr, fq * 8), boff = lds_byte(wc * 32 + fr, fq * 8);
#define PG8_SA(b, h) (((b) * 2 + (h)) * HTB)
#define PG8_SB(b, h) ((4 + (b) * 2 + (h)) * HTB)
#define PG8_STAGE(bufoff, gbase, voff) do { _Pragma("unroll") for (int _i = 0; _i < 2; ++_i) \
        __builtin_amdgcn_global_load_lds((const unsigned*)((const char*)(gbase) + (voff)[_i]), (LAS unsigned*)(lds + (bufoff) + ldsw + _i * 8192), 16, 0, 0); } while (0)
#define PG8_LDA(dst, b, h) do { _Pragma("unroll") for (int m = 0; m < 4; ++m) _Pragma("unroll") for (int k = 0; k < 2; ++k) dst[m][k] = *(const LAS bf16x8*)(lds + PG8_SA(b, h) + aoff + m * 2048 + k * 1024); } while (0)
#define PG8_LDB(dst, b, h) do { _Pragma("unroll") for (int n = 0; n < 2; ++n) _Pragma("unroll") for (int k = 0; k < 2; ++k) dst[n][k] = *(const LAS bf16x8*)(lds + PG8_SB(b, h) + boff + n * 2048 + k * 1024); } while (0)
#define PG8_MMA(ai, bj, At, Bt) do { __builtin_amdgcn_s_setprio(1); _Pragma("unroll") for (int m = 0; m < 4; ++m) _Pragma("unroll") for (int n = 0; n < 2; ++n) _Pragma("unroll") for (int k = 0; k < 2; ++k) \
        acc[ai][bj][m][n] = __builtin_amdgcn_mfma_f32_16x16x32_bf16(Bt[n][k], At[m][k], acc[ai][bj][m][n], 0, 0, 0); __builtin_amdgcn_s_setprio(0); } while (0)
#define PG8_WAIT_V(n) asm volatile("s_waitcnt vmcnt(" #n ")" ::: "memory")
#define PG8_WAIT_L(n) asm volatile("s_waitcnt lgkmcnt(" #n ")" ::: "memory")
#define PG8_BAR __builtin_amdgcn_s_barrier()
#define PG8_SCHED __builtin_amdgcn_sched_barrier(0)
    Unit cur, nxt; int ui = 0;
    if (!S.next(0, cur)) return;
    f32x4 acc[2][2][4][2];
#pragma unroll
    for (int a = 0; a < 2; ++a)
#pragma unroll
        for (int b = 0; b < 2; ++b)
#pragma unroll
            for (int m = 0; m < 4; ++m)
#pragma unroll
                for (int n = 0; n < 2; ++n) acc[a][b][m][n] = (f32x4){0.f, 0.f, 0.f, 0.f};
    bf16x8 At[4][2], B0[2][2], B1[2][2];
    const char* cA = (const char*)g.A + (size_t)cur.pm * tstep; const char* cB = (const char*)g.Bt + (size_t)cur.pn * tstep;
    S.a_ready(cur);
    if constexpr (SP2) {
        PG8_STAGE(PG8_SB(0, 0), cB, voffB); PG8_STAGE(PG8_SB(0, 1), cB + hstep, voffB); PG8_STAGE(PG8_SA(0, 0), cA, voffA); PG8_STAGE(PG8_SA(0, 1), cA + hstep, voffA);
        if (wr == 1) PG8_BAR;
        PG8_WAIT_V(2); PG8_BAR;
        PG8_STAGE(PG8_SB(1, 0), cB + kstep, voffB); PG8_STAGE(PG8_SA(1, 0), cA + kstep, voffA); PG8_STAGE(PG8_SB(1, 1), cB + hstep + kstep, voffB);
        PG8_WAIT_V(6); PG8_BAR;
    } else {
        PG8_STAGE(PG8_SB(0, 0), cB, voffB); PG8_STAGE(PG8_SA(0, 0), cA, voffA); PG8_STAGE(PG8_SB(0, 1), cB + hstep, voffB); PG8_STAGE(PG8_SA(0, 1), cA + hstep, voffA);
        if (wr == 1) PG8_BAR;
        PG8_WAIT_V(4); PG8_BAR;
        PG8_STAGE(PG8_SB(1, 0), cB + kstep, voffB); PG8_STAGE(PG8_SA(1, 0), cA + kstep, voffA); PG8_STAGE(PG8_SB(1, 1), cB + hstep + kstep, voffB);
        PG8_WAIT_V(6); PG8_BAR;
    }
    for (;;) {
        const bool has_next = S.next(ui + 1, nxt);
        const char* nA = has_next ? (const char*)g.A + (size_t)nxt.pm * tstep : cA; const char* nB = has_next ? (const char*)g.Bt + (size_t)nxt.pn * tstep : cB;
        for (int t = 0; t < nt; t += 2) {
            const bool last = (t == nt - 2);
            const char* a1 = cA + (size_t)(t + 1) * kstep;
            const char* a2 = last ? nA : cA + (size_t)(t + 2) * kstep; const char* b2 = last ? nB : cB + (size_t)(t + 2) * kstep;
            const char* a3 = a2 + kstep; const char* b3 = b2 + kstep;
            if (last && has_next) S.a_ready(nxt);
            if constexpr (SP2) {
            PG8_LDB(B0, 0, 0); PG8_LDB(B1, 0, 1); PG8_SCHED; PG8_LDA(At, 0, 0); PG8_STAGE(PG8_SA(1, 1), a1 + hstep, voffA);
            PG8_WAIT_V(8); PG8_WAIT_L(0); PG8_BAR; PG8_MMA(0, 0, At, B0); PG8_MMA(0, 1, At, B1); PG8_BAR; PG8_SCHED;
            PG8_LDA(At, 0, 1); PG8_STAGE(PG8_SB(0, 0), b2, voffB); PG8_STAGE(PG8_SB(0, 1), b2 + hstep, voffB); PG8_STAGE(PG8_SA(0, 0), a2, voffA);
            PG8_WAIT_V(8); PG8_WAIT_L(0); PG8_BAR; PG8_MMA(1, 0, At, B0); PG8_MMA(1, 1, At, B1); PG8_BAR; PG8_SCHED;
            PG8_LDB(B0, 1, 0); PG8_LDB(B1, 1, 1); PG8_SCHED; PG8_LDA(At, 1, 0); PG8_STAGE(PG8_SA(0, 1), a2 + hstep, voffA);
            PG8_WAIT_V(8); PG8_WAIT_L(0); PG8_BAR; PG8_MMA(0, 0, At, B0); PG8_MMA(0, 1, At, B1); PG8_BAR; PG8_SCHED;
            PG8_LDA(At, 1, 1); PG8_STAGE(PG8_SB(1, 0), b3, voffB); PG8_STAGE(PG8_SB(1, 1), b3 + hstep, voffB); PG8_STAGE(PG8_SA(1, 0), a3, voffA);
            PG8_WAIT_V(8); PG8_WAIT_L(0); PG8_BAR; PG8_MMA(1, 0, At, B0); PG8_MMA(1, 1, At, B1); PG8_BAR; PG8_SCHED;
            } else {
            PG8_LDB(B0, 0, 0); PG8_SCHED; PG8_LDA(At, 0, 0); PG8_STAGE(PG8_SA(1, 1), a1 + hstep, voffA);
            PG8_WAIT_L(8); PG8_BAR; PG8_WAIT_L(0); PG8_MMA(0, 0, At, B0); PG8_BAR; PG8_SCHED;
            PG8_LDB(B1, 0, 1); PG8_STAGE(PG8_SB(0, 0), b2, voffB);
            PG8_BAR; PG8_WAIT_L(0); PG8_MMA(0, 1, At, B1); PG8_BAR;
            PG8_LDA(At, 0, 1); PG8_STAGE(PG8_SA(0, 0), a2, voffA);
            PG8_BAR; PG8_WAIT_L(0); PG8_MMA(1, 0, At, B0); PG8_BAR; PG8_SCHED;
            PG8_STAGE(PG8_SB(0, 1), b2 + hstep, voffB);
            PG8_WAIT_V(6); PG8_BAR; PG8_MMA(1, 1, At, B1); PG8_BAR;
            PG8_LDB(B0, 1, 0); PG8_SCHED; PG8_LDA(At, 1, 0); PG8_STAGE(PG8_SA(0, 1), a2 + hstep, voffA);
            PG8_WAIT_L(8); PG8_BAR; PG8_WAIT_L(0); PG8_MMA(0, 0, At, B0); PG8_BAR; PG8_SCHED;
            PG8_LDB(B1, 1, 1); PG8_STAGE(PG8_SB(1, 0), b3, voffB);
            PG8_BAR; PG8_WAIT_L(0); PG8_MMA(0, 1, At, B1); PG8_BAR;
            PG8_LDA(At, 1, 1); PG8_STAGE(PG8_SA(1, 0), a3, voffA);
            PG8_BAR; PG8_WAIT_L(0); PG8_MMA(1, 0, At, B0); PG8_BAR; PG8_SCHED;
            PG8_STAGE(PG8_SB(1, 1), b3 + hstep, voffB);
            PG8_WAIT_V(6); PG8_BAR; PG8_MMA(1, 1, At, B1); PG8_BAR;
            }
        }
        if constexpr (ALIGN_EPI) { if (wr == 0) PG8_BAR; }
        if constexpr (!Epi::AFTER_DRAIN) { E(acc, cur, wr, wc, fr, fq); S.done(cur); }
        if (!has_next) break;
#pragma unroll
        for (int a = 0; a < 2; ++a)
#pragma unroll
            for (int b = 0; b < 2; ++b)
#pragma unroll
                for (int m = 0; m < 4; ++m)
#pragma unroll
                    for (int n = 0; n < 2; ++n) acc[a][b][m][n] = (f32x4){0.f, 0.f, 0.f, 0.f};
        cur = nxt; cA = nA; cB = nB; ++ui;
        if constexpr (ALIGN_EPI) { if (wr == 1) PG8_BAR; }
    }
    PG8_WAIT_V(0);
    if constexpr (!ALIGN_EPI) { if (wr == 0) PG8_BAR; }
    PG8_BAR;
#undef PG8_SA
#undef PG8_SB
#undef PG8_STAGE
#undef PG8_LDA
#undef PG8_LDB
#undef PG8_MMA
#undef PG8_WAIT_V
#undef PG8_WAIT_L
#undef PG8_BAR
#undef PG8_SCHED
}
}

struct Args { const void* in[28]; float* out; unsigned char* ws; int ph_lo, ph_hi; int rep_attn, rep_fin, rep_prep, rep_pad; };

struct Ctx {
    LAS unsigned char* lds; LAS unsigned char* wlds;
    int tid, lane, wave, gw, ngw, G;
    unsigned char* ws;
};
constexpr int PTAB_OFF = 147456 - 256;
__device__ __forceinline__ const void* ldptr(LAS unsigned char* lds, int i) {
    volatile LAS unsigned* t = (volatile LAS unsigned*)(lds + PTAB_OFF) + 2 * i;
    const unsigned lo = __builtin_amdgcn_readfirstlane(t[0]), hi = __builtin_amdgcn_readfirstlane(t[1]);
    return (const void*)(const __attribute__((address_space(1))) unsigned char*)(((unsigned long long)hi << 32) | lo);
}
#define INP_F(i) ((const float*)ldptr(c.lds, (i)))

#define MFMA16(a, b, c) __builtin_amdgcn_mfma_f32_16x16x32_bf16((a), (b), (c), 0, 0, 0)

__device__ __forceinline__ void tr_item(const float* W, int K, int N, int nblk, bf16_t* WT, int mode, LAS float* scr, int item, int lane) {
    const int kb = item / nblk, nb = item % nblk, k0 = 64 * kb, n0 = 32 * nb;
    const int nn = n0 + (lane & 31);
#pragma unroll 8
    for (int i = 0; i < 32; ++i) { const int kk = 2 * i + (lane >> 5); scr[kk * 33 + (lane & 31)] = (nn < N) ? W[(size_t)(k0 + kk) * N + nn] : 0.f; }
    LDS_WAIT();
    const int row_off = mode == 0 ? 0 : ((n0 >> 7) * 128 + (mode == 2 ? 128 : 0));
    const int c = lane & 7;
#pragma unroll
    for (int j = 0; j < 4; ++j) { const int n = (lane >> 3) + 8 * j; const LAS float* s = scr + (8 * c) * 33 + n;
        u32x4 o; o.x = cvt_pk_bf16(s[0 * 33], s[1 * 33]); o.y = cvt_pk_bf16(s[2 * 33], s[3 * 33]); o.z = cvt_pk_bf16(s[4 * 33], s[5 * 33]); o.w = cvt_pk_bf16(s[6 * 33], s[7 * 33]);
        *(u32x4*)(WT + (size_t)(row_off + n0 + n) * K + k0 + 8 * c) = o; }
    LDS_WAIT();
}

__device__ __forceinline__ void norm_row_to_bf16(const float* xrow, const float* g, bf16_t* orow, int lane) {
    const f32x4* xr = (const f32x4*)xrow + lane; const f32x4* gr = (const f32x4*)g + lane;
    f32x4 v[4]; float s = 0.f;
#pragma unroll
    for (int j = 0; j < 4; ++j) { v[j] = xr[64 * j]; s += (v[j].x * v[j].x + v[j].y * v[j].y) + (v[j].z * v[j].z + v[j].w * v[j].w); }
    const float rs = 1.0f / sqrtf(wave_sum(s) * (1.f / DM) + EPS);
    u32x2* o8 = (u32x2*)orow + lane;
#pragma unroll
    for (int j = 0; j < 4; ++j) { const f32x4 gg = gr[64 * j]; u32x2 w; w.x = cvt_pk_bf16(v[j].x * rs * gg.x, v[j].y * rs * gg.y); w.y = cvt_pk_bf16(v[j].z * rs * gg.z, v[j].w * rs * gg.w); o8[64 * j] = w; }
}

constexpr int TR_BIG = 1408, TR_PER_LAYER = 6 * 1408 + 1152 + 512 + 8 + 16 + 128, TR_TOTAL = DEPTH * TR_PER_LAYER;

__device__ __forceinline__ void p0_prologue(const Ctx& c) {
    LAS float* scr = (LAS float*)c.wlds;
    unsigned char* ws = c.ws;
    for (int it = c.gw; it < TR_TOTAL; it += c.ngw) {
        const int l = it / TR_PER_LAYER; int r = it % TR_PER_LAYER;
        const float* src; bf16_t* dst; int K, N, nblk, mode = 0;
        if (r < 4 * TR_BIG) { const int q = r / TR_BIG; r -= q * TR_BIG; const int which = q >> 1, isup = q & 1;
            src = INP_F(which ? (isup ? 26 : 25) : (isup ? 5 : 4)) + (size_t)l * DM * FF; dst = (bf16_t*)(ws + WS_WGU + (size_t)(l * 2 + which) * SZ_WGU); K = DM; N = FF; nblk = FF / 32; mode = 1 + isup; }
        else if (r < 6 * TR_BIG) { r -= 4 * TR_BIG; const int which = r / TR_BIG; r -= which * TR_BIG;
            src = INP_F(which ? 27 : 6) + (size_t)l * DM * FF; dst = (bf16_t*)(ws + WS_WDN + (size_t)(l * 2 + which) * SZ_WDN); K = FF; N = DM; nblk = DM / 32; }
        else if (r < 6 * TR_BIG + 1152) { r -= 6 * TR_BIG; src = INP_F(9) + (size_t)l * DM * INC; dst = (bf16_t*)(ws + WS_WIN + (size_t)l * SZ_WIN); K = DM; N = INC; nblk = INP / 32; }
        else if (r < 6 * TR_BIG + 1152 + 512) { r -= 6 * TR_BIG + 1152; src = INP_F(10) + (size_t)l * DM * DM; dst = (bf16_t*)(ws + WS_WOUT + (size_t)l * SZ_WOUT); K = DM; N = DM; nblk = DM / 32; }
        else if (r < 6 * TR_BIG + 1152 + 512 + 8) { r -= 6 * TR_BIG + 1152 + 512; const int g = r >> 1; r &= 1;
            src = INP_F(11) + (size_t)(l * 4 + g) * 4096; dst = (bf16_t*)(ws + WS_WPOOL) + (size_t)(l * 4 + g) * 4096; K = 64; N = 64; nblk = 2; }
        else if (r < 6 * TR_BIG + 1152 + 512 + 8 + 16) { r -= 6 * TR_BIG + 1152 + 512 + 8; const int q = r >> 1; r &= 1; const int ri = q >> 2, h = q & 3;
            src = INP_F(ri ? 17 : 15) + (size_t)(l * 4 + h) * 4096; dst = (bf16_t*)(ws + WS_WLRU) + (size_t)((l * 2 + ri) * 4 + h) * 4096; K = 64; N = 64; nblk = 2; }
        else { r -= 6 * TR_BIG + 1152 + 512 + 8 + 16; const int kv = r >> 6; r &= 63;
            src = INP_F(kv ? 21 : 20) + (size_t)l * 2048 * 64; dst = (bf16_t*)(ws + WS_WCMP) + (size_t)(l * 2 + kv) * 64 * 2048; K = 2048; N = 64; nblk = 2; }
        tr_item(src, K, N, nblk, dst, mode, scr, r, c.lane);
    }
    {
        const int* pos = (const int*)ldptr(c.lds, 1); float* ct = (float*)(ws + WS_COS); float* st = (float*)(ws + WS_SIN);
        for (int e = c.gw * 64 + c.lane; e < M * 32; e += c.ngw * 64) {
            const int m = e >> 5, i = e & 31;
            const float inv = powf(10000.0f, -(float)(2 * i) / 64.0f);
            const float ang = (float)pos[m] * inv;
            const double ad = (double)ang; const double k = rint(ad * 0.15915494309189535); const float rr = (float)(ad - k * 6.283185307179586);
            ct[e] = cosf(rr); st[e] = sinf(rr);
        }
    }
    const float* x0 = INP_F(0); const float* g0 = INP_F(2);
    for (int m = c.gw; m < M; m += c.ngw) norm_row_to_bf16(x0 + (size_t)m * DM, g0, (bf16_t*)(ws + WS_A) + (size_t)m * DM, c.lane);
}

__device__ __forceinline__ void rowpass(const Ctx& c, const float* hin, float* hout, const bf16_t* f, const float* gpost, float coef, const float* gnext, bf16_t* aout) {
    const int lane = c.lane;
    for (int m = c.gw; m < M; m += c.ngw) {
        const u32x2* fr = (const u32x2*)(f + (size_t)m * DM) + lane;
        const f32x4* hr = (const f32x4*)(hin + (size_t)m * DM) + lane;
        f32x4 fv[4], hv[4]; float s = 0.f;
#pragma unroll
        for (int j = 0; j < 4; ++j) { const u32x2 w = fr[64 * j]; fv[j] = (f32x4){bflo(w.x), bfhi(w.x), bflo(w.y), bfhi(w.y)}; hv[j] = hr[64 * j];
            s += (fv[j].x * fv[j].x + fv[j].y * fv[j].y) + (fv[j].z * fv[j].z + fv[j].w * fv[j].w); }
        const float rs = coef / sqrtf(wave_sum(s) * (1.f / DM) + EPS);
        float s2 = 0.f;
#pragma unroll
        for (int j = 0; j < 4; ++j) { const f32x4 gg = ((const f32x4*)gpost + lane)[64 * j]; hv[j] = hv[j] + fv[j] * rs * gg;
            s2 += (hv[j].x * hv[j].x + hv[j].y * hv[j].y) + (hv[j].z * hv[j].z + hv[j].w * hv[j].w); }
        f32x4* ho = (f32x4*)(hout + (size_t)m * DM) + lane;
#pragma unroll
        for (int j = 0; j < 4; ++j) ho[64 * j] = hv[j];
        if (gnext) {
            const float rs2 = 1.0f / sqrtf(wave_sum(s2) * (1.f / DM) + EPS);
            u32x2* o8 = (u32x2*)(aout + (size_t)m * DM) + lane;
#pragma unroll
            for (int j = 0; j < 4; ++j) { const f32x4 gg = ((const f32x4*)gnext + lane)[64 * j]; u32x2 w; w.x = cvt_pk_bf16(hv[j].x * rs2 * gg.x, hv[j].y * rs2 * gg.y); w.y = cvt_pk_bf16(hv[j].z * rs2 * gg.z, hv[j].w * rs2 * gg.w); o8[64 * j] = w; }
        }
    }
}

__device__ __forceinline__ void unpack8(const bf16x8 v, float* f) {
    const u32x4 w = __builtin_bit_cast(u32x4, v);
    f[0] = bflo(w.x); f[1] = bfhi(w.x); f[2] = bflo(w.y); f[3] = bfhi(w.y); f[4] = bflo(w.z); f[5] = bfhi(w.z); f[6] = bflo(w.w); f[7] = bfhi(w.w);
}
__device__ __forceinline__ bf16x8 pack8(const float* f) {
    u32x4 w; w.x = cvt_pk_bf16(f[0], f[1]); w.y = cvt_pk_bf16(f[2], f[3]); w.z = cvt_pk_bf16(f[4], f[5]); w.w = cvt_pk_bf16(f[6], f[7]);
    return __builtin_bit_cast(bf16x8, w);
}

__device__ __forceinline__ void rope_unit(const Ctx& c, int tile) {
    const bf16_t* proj = (const bf16_t*)(c.ws + WS_HID); bf16_t* Qr = (bf16_t*)(c.ws + WS_QR);
    const float* ct = (const float*)(c.ws + WS_COS); const float* st = (const float*)(c.ws + WS_SIN);
    const int lane = c.lane, i0 = (lane & 7) * 4;
    for (int tt = 0; tt < 16; ++tt) {
        const int tg = tile * 16 + tt; const int b = tg / SEQ, t = tg % SEQ;
        const f32x4 cs = *(const f32x4*)(ct + (size_t)tg * 32 + i0), sn = *(const f32x4*)(st + (size_t)tg * 32 + i0);
        {
            const int head = lane >> 3; const bf16_t* src = proj + (size_t)tg * INP + C_Q + head * 64 + i0;
            const u32x2 a = *(const u32x2*)src, bb = *(const u32x2*)(src + 32);
            const f32x4 x1 = (f32x4){bflo(a.x), bfhi(a.x), bflo(a.y), bfhi(a.y)}, x2 = (f32x4){bflo(bb.x), bfhi(bb.x), bflo(bb.y), bfhi(bb.y)};
            const f32x4 o1 = (x1 * cs - x2 * sn) * QSCALE, o2 = (x2 * cs + x1 * sn) * QSCALE;
            bf16_t* dst = Qr + (size_t)tg * 512 + head * 64 + i0;
            u32x2 w; w.x = cvt_pk_bf16(o1.x, o1.y); w.y = cvt_pk_bf16(o1.z, o1.w); *(u32x2*)dst = w;
            w.x = cvt_pk_bf16(o2.x, o2.y); w.y = cvt_pk_bf16(o2.z, o2.w); *(u32x2*)(dst + 32) = w;
        }
        if (lane < 32) {
            const int arr = lane >> 4, kvh = (lane >> 3) & 1; const bf16_t* src = proj + (size_t)tg * INP + (arr ? C_KW : C_KS) + kvh * 64 + i0;
            const u32x2 a = *(const u32x2*)src, bb = *(const u32x2*)(src + 32);
            const f32x4 x1 = (f32x4){bflo(a.x), bfhi(a.x), bflo(a.y), bfhi(a.y)}, x2 = (f32x4){bflo(bb.x), bfhi(bb.x), bflo(bb.y), bfhi(bb.y)};
            const f32x4 o1 = x1 * cs - x2 * sn, o2 = x2 * cs + x1 * sn;
            bf16_t* dst = (bf16_t*)(c.ws + (arr ? WS_KW : WS_KS)) + ((size_t)(b * 2 + kvh) * SEQ + t) * 64 + i0;
            u32x2 w; w.x = cvt_pk_bf16(o1.x, o1.y); w.y = cvt_pk_bf16(o1.z, o1.w); *(u32x2*)dst = w;
            w.x = cvt_pk_bf16(o2.x, o2.y); w.y = cvt_pk_bf16(o2.z, o2.w); *(u32x2*)(dst + 32) = w;
        }
    }
}
__device__ __forceinline__ void vt_unit(const Ctx& c, int u) {
    const int tile = u & 255, bk = (u >> 8) & 3, arr = u >> 10; const int b = bk >> 1, kvh = bk & 1, t0 = tile * 64;
    const bf16_t* src = (const bf16_t*)(c.ws + WS_HID) + (size_t)(b * SEQ + t0) * INP + (arr ? C_VW : C_VS) + kvh * 64 + c.lane;
    bf16_t* dst = (bf16_t*)(c.ws + (arr ? WS_VWT : WS_VST)) + (((size_t)bk * 256 + tile) * 64 + c.lane) * 64;
#pragma unroll
    for (int q = 0; q < 8; ++q) {
        unsigned w[4];
#pragma unroll
        for (int e = 0; e < 4; ++e) { const unsigned lo = src[(size_t)(q * 8 + 2 * e) * INP], hi = src[(size_t)(q * 8 + 2 * e + 1) * INP]; w[e] = lo | (hi << 16); }
        *(u32x4*)(dst + q * 8) = (u32x4){w[0], w[1], w[2], w[3]};
    }
}
__device__ __forceinline__ void pool_unit(const Ctx& c, int u, int layer, const float* pool_scale) {
    const int gp = u & 3, tile = u >> 2; const int lane = c.lane, r16 = lane & 15, g = lane >> 4;
    const int tg = tile * 16 + r16, b = tg / SEQ, t = tg % SEQ; const int w = 2 << gp;
    const bf16_t* proj = (const bf16_t*)(c.ws + WS_HID);
    const bf16_t* WpT = (const bf16_t*)(c.ws + WS_WPOOL) + (size_t)(layer * 4 + gp) * 4096;
    bf16x8 Df[2];
    const int cnt = (t + 1 < w) ? t + 1 : w; const float icnt = 1.0f / (float)cnt;
#pragma unroll
    for (int ks = 0; ks < 2; ++ks) {
        const bf16_t* p = proj + (size_t)(b * SEQ + t) * INP + C_XP + gp * 64 + ks * 32 + g * 8;
        float sum[8], x0[8];
        unpack8(*(const bf16x8*)p, x0);
#pragma unroll
        for (int e = 0; e < 8; ++e) sum[e] = x0[e];
        for (int s = 1; s < cnt; ++s) { float xv[8]; unpack8(*(const bf16x8*)(p - (size_t)s * INP), xv);
#pragma unroll
            for (int e = 0; e < 8; ++e) sum[e] += xv[e]; }
        float d[8];
#pragma unroll
        for (int e = 0; e < 8; ++e) d[e] = sum[e] * icnt - x0[e];
        Df[ks] = pack8(d);
    }
    bf16_t* out = (bf16_t*)(c.ws + WS_A) + (size_t)tg * DM + gp * 64;
#pragma unroll
    for (int jt = 0; jt < 4; ++jt) {
        f32x4 acc = (f32x4){0.f, 0.f, 0.f, 0.f};
#pragma unroll
        for (int ks = 0; ks < 2; ++ks) { const bf16x8 wf = *(const bf16x8*)(WpT + (size_t)(16 * jt + r16) * 64 + ks * 32 + g * 8); acc = MFMA16(wf, Df[ks], acc); }
        const f32x4 sc = *(const f32x4*)(pool_scale + gp * 64 + 16 * jt + 4 * g);
        u32x2 o; o.x = cvt_pk_bf16(acc[0] * sc[0], acc[1] * sc[1]); o.y = cvt_pk_bf16(acc[2] * sc[2], acc[3] * sc[3]);
        *(u32x2*)(out + 16 * jt + 4 * g) = o;
    }
}
__device__ __forceinline__ void lru_unit(const Ctx& c, int u, int layer, const float* conv_w, const float* conv_b, const float* b_r, const float* b_i, const float* lam) {
    const int hh = u & 3, ch = (u >> 2) % LRU_NCH, b = (u >> 2) / LRU_NCH;
    const int lane = c.lane, r16 = lane & 15, g = lane >> 4;
    const bf16_t* proj = (const bf16_t*)(c.ws + WS_HID);
    const bf16_t* WrT = (const bf16_t*)(c.ws + WS_WLRU) + (size_t)((layer * 2 + 0) * 4 + hh) * 4096;
    const bf16_t* WiT = (const bf16_t*)(c.ws + WS_WLRU) + (size_t)((layer * 2 + 1) * 4 + hh) * 4096;
    float* HL = (float*)(c.ws + WS_F); float* CA = HL + (size_t)M * 256;
    float n8sp[4][4], hcar[4][4], acar[4][4];
#pragma unroll
    for (int jt = 0; jt < 4; ++jt)
#pragma unroll
        for (int jj = 0; jj < 4; ++jj) { const float L = lam[hh * 64 + 16 * jt + 4 * g + jj]; n8sp[jt][jj] = -8.0f * log1pf(__expf(-L)); hcar[jt][jj] = 0.f; acar[jt][jj] = 1.f; }
    for (int tile = 0; tile < LRU_CHUNK / 16; ++tile) {
        const int t = ch * LRU_CHUNK + tile * 16 + r16; const size_t tg = (size_t)b * SEQ + t;
        bf16x8 Xf[2];
#pragma unroll
        for (int ks = 0; ks < 2; ++ks) {
            const int c0 = hh * 64 + ks * 32 + g * 8; float acc8[8];
            { const f32x4 b0 = *(const f32x4*)(conv_b + c0), b1 = *(const f32x4*)(conv_b + c0 + 4); acc8[0] = b0[0]; acc8[1] = b0[1]; acc8[2] = b0[2]; acc8[3] = b0[3]; acc8[4] = b1[0]; acc8[5] = b1[1]; acc8[6] = b1[2]; acc8[7] = b1[3]; }
#pragma unroll
            for (int k = 0; k < 4; ++k) { const int tt = t - 3 + k;
                if (tt >= 0) { float xv[8]; unpack8(*(const bf16x8*)(proj + ((size_t)b * SEQ + tt) * INP + C_XL + c0), xv);
                    const f32x4 w0 = *(const f32x4*)(conv_w + k * 256 + c0), w1 = *(const f32x4*)(conv_w + k * 256 + c0 + 4);
                    acc8[0] += w0[0] * xv[0]; acc8[1] += w0[1] * xv[1]; acc8[2] += w0[2] * xv[2]; acc8[3] += w0[3] * xv[3];
                    acc8[4] += w1[0] * xv[4]; acc8[5] += w1[1] * xv[5]; acc8[6] += w1[2] * xv[6]; acc8[7] += w1[3] * xv[7]; } }
            Xf[ks] = pack8(acc8);
        }
#pragma unroll
        for (int jt = 0; jt < 4; ++jt) {
            f32x4 aR = (f32x4){0.f, 0.f, 0.f, 0.f}, aI = (f32x4){0.f, 0.f, 0.f, 0.f};
#pragma unroll
            for (int ks = 0; ks < 2; ++ks) { const size_t wo = (size_t)(16 * jt + r16) * 64 + ks * 32 + g * 8;
                aR = MFMA16(*(const bf16x8*)(WrT + wo), Xf[ks], aR); aI = MFMA16(*(const bf16x8*)(WiT + wo), Xf[ks], aI); }
            const int c4 = hh * 64 + 16 * jt + 4 * g;
            f32x4 xc = *(const f32x4*)(conv_b + c4);
#pragma unroll
            for (int k = 0; k < 4; ++k) { const int tt = t - 3 + k;
                if (tt >= 0) { const u32x2 xw = *(const u32x2*)(proj + ((size_t)b * SEQ + tt) * INP + C_XL + c4); const f32x4 w4 = *(const f32x4*)(conv_w + k * 256 + c4);
                    xc[0] += w4[0] * bflo(xw.x); xc[1] += w4[1] * bfhi(xw.x); xc[2] += w4[2] * bflo(xw.y); xc[3] += w4[3] * bfhi(xw.y); } }
            const f32x4 br4 = *(const f32x4*)(b_r + c4), bi4 = *(const f32x4*)(b_i + c4);
            f32x4 hv, cv;
#pragma unroll
            for (int jj = 0; jj < 4; ++jj) {
                const float r = sigmoidf_(aR[jj] + br4[jj]), ii = sigmoidf_(aI[jj] + bi4[jj]);
                const float la = n8sp[jt][jj] * r; float av = __expf(la); float bv = sqrtf(fmaxf(-expm1f(2.0f * la), 0.f)) * (ii * xc[jj]);
#pragma unroll
                for (int d = 1; d < 16; d <<= 1) { const float ap = __shfl_up(av, d, 16), bp = __shfl_up(bv, d, 16); if (r16 >= d) { bv = av * bp + bv; av = av * ap; } }
                const float h = av * hcar[jt][jj] + bv, ca = av * acar[jt][jj];
                hv[jj] = h; cv[jj] = ca;
                hcar[jt][jj] = __shfl(h, 15, 16); acar[jt][jj] = __shfl(ca, 15, 16);
            }
            *(f32x4*)(HL + tg * 256 + c4) = hv; *(f32x4*)(CA + tg * 256 + c4) = cv;
        }
    }
    if (r16 == 15) {
        float* carA = (float*)(c.ws + WS_CARA) + (size_t)(b * LRU_NCH + ch) * 256; float* carH = (float*)(c.ws + WS_CARH) + (size_t)(b * LRU_NCH + ch) * 256;
#pragma unroll
        for (int jt = 0; jt < 4; ++jt) { const int c4 = hh * 64 + 16 * jt + 4 * g;
            *(f32x4*)(carA + c4) = (f32x4){acar[jt][0], acar[jt][1], acar[jt][2], acar[jt][3]}; *(f32x4*)(carH + c4) = (f32x4){hcar[jt][0], hcar[jt][1], hcar[jt][2], hcar[jt][3]}; }
    }
}
__device__ __forceinline__ void cmp_unit(const Ctx& c, int u, int layer, const float* pe) {
    const int nt_ = u & 63, bk = (u >> 6) & 3, kv = u >> 8; const int b = bk >> 1, kvh = bk & 1;
    const int lane = c.lane, r16 = lane & 15, g = lane >> 4;
    const bf16_t* proj = (const bf16_t*)(c.ws + WS_HID);
    const bf16_t* WT = (const bf16_t*)(c.ws + WS_WCMP) + (size_t)(layer * 2 + kv) * 64 * 2048;
    const float* ct = (const float*)(c.ws + WS_COS); const float* st = (const float*)(c.ws + WS_SIN);
    const int n = nt_ * 16 + r16; const int colb = (kv ? C_VC : C_KC) + kvh * 64;
    f32x4 acc[4];
#pragma unroll
    for (int e = 0; e < 4; ++e) acc[e] = (f32x4){0.f, 0.f, 0.f, 0.f};
    for (int l = 0; l < 32; ++l) {
        int t = 16 * n + l; if (t > SEQ - 1) t = SEQ - 1;
        const size_t tg = (size_t)b * SEQ + t;
        float x1[8], x2[8];
        unpack8(*(const bf16x8*)(proj + tg * INP + colb + g * 8), x1); unpack8(*(const bf16x8*)(proj + tg * INP + colb + 32 + g * 8), x2);
        float o1[8], o2[8];
        if (kv == 0) {
            const f32x4 c0 = *(const f32x4*)(ct + tg * 32 + g * 8), c1 = *(const f32x4*)(ct + tg * 32 + g * 8 + 4), s0 = *(const f32x4*)(st + tg * 32 + g * 8), s1 = *(const f32x4*)(st + tg * 32 + g * 8 + 4);
#pragma unroll
            for (int e = 0; e < 8; ++e) { const float cc = e < 4 ? c0[e & 3] : c1[e & 3], ss = e < 4 ? s0[e & 3] : s1[e & 3]; o1[e] = x1[e] * cc - x2[e] * ss; o2[e] = x2[e] * cc + x1[e] * ss; }
        } else {
#pragma unroll
            for (int e = 0; e < 8; ++e) { o1[e] = x1[e]; o2[e] = x2[e]; }
        }
        { const f32x4 p0 = *(const f32x4*)(pe + l * 64 + g * 8), p1 = *(const f32x4*)(pe + l * 64 + g * 8 + 4), p2 = *(const f32x4*)(pe + l * 64 + 32 + g * 8), p3 = *(const f32x4*)(pe + l * 64 + 32 + g * 8 + 4);
#pragma unroll
            for (int e = 0; e < 4; ++e) { o1[e] += p0[e]; o1[4 + e] += p1[e]; o2[e] += p2[e]; o2[4 + e] += p3[e]; } }
        const bf16x8 X0 = pack8(o1), X1 = pack8(o2);
#pragma unroll
        for (int et = 0; et < 4; ++et) {
            const bf16_t* wp = WT + (size_t)(16 * et + r16) * 2048 + l * 64 + g * 8;
            const bf16x8 W0 = *(const bf16x8*)wp, W1 = *(const bf16x8*)(wp + 32);
            if (kv == 0) { acc[et] = MFMA16(W0, X0, acc[et]); acc[et] = MFMA16(W1, X1, acc[et]); }
            else         { acc[et] = MFMA16(X0, W0, acc[et]); acc[et] = MFMA16(X1, W1, acc[et]); }
        }
    }
    if (kv == 0) {
        bf16_t* dst = (bf16_t*)(c.ws + WS_KCMP) + ((size_t)bk * 1024 + n) * 64;
        const bool z = (n >= 1023);
#pragma unroll
        for (int et = 0; et < 4; ++et) { u32x2 o; o.x = cvt_pk_bf16(acc[et][0], acc[et][1]); o.y = cvt_pk_bf16(acc[et][2], acc[et][3]); if (z) { o.x = 0u; o.y = 0u; } *(u32x2*)(dst + 16 * et + 4 * g) = o; }
    } else {
        bf16_t* dst = (bf16_t*)(c.ws + WS_VCMPT) + (size_t)bk * 64 * 1024;
        const int nb = nt_ * 16 + 4 * g;
#pragma unroll
        for (int et = 0; et < 4; ++et) { float v3 = acc[et][3]; if (nb + 3 >= 1023) v3 = 0.f; u32x2 o; o.x = cvt_pk_bf16(acc[et][0], acc[et][1]); o.y = cvt_pk_bf16(acc[et][2], v3); *(u32x2*)(dst + ((size_t)(nb >> 6) * 64 + 16 * et + r16) * 64 + (nb & 63)) = o; }
    }
}

constexpr int NU_LRU = BATCH * LRU_NCH * 4, NU_CMP = 512, NU_POOL = (M / 16) * 4, NU_ROPE = M / 16, NU_VT = 2048;
__device__ __forceinline__ void phase_prep(const Ctx& c, int layer) {
    const float* pool_scale = INP_F(12) + layer * 256;
    const float* conv_w = INP_F(13) + layer * 1024; const float* conv_b = INP_F(14) + layer * 256;
    const float* b_r = INP_F(16) + layer * 256; const float* b_i = INP_F(18) + layer * 256; const float* lam = INP_F(19) + layer * 256;
    const float* pe = INP_F(22) + layer * 2048;
    for (int u = c.gw; u < NU_LRU; u += c.ngw) lru_unit(c, u, layer, conv_w, conv_b, b_r, b_i, lam);
    for (int u = c.gw; u < NU_CMP; u += c.ngw) cmp_unit(c, u, layer, pe);
    for (int u = c.gw; u < NU_VT; u += c.ngw) vt_unit(c, u);
    for (int u = c.gw; u < NU_ROPE; u += c.ngw) rope_unit(c, u);
    for (int u = c.gw; u < NU_POOL; u += c.ngw) pool_unit(c, u, layer, pool_scale);
}

constexpr int NCG = 2, QPW = 4 * NCG;
struct AttnRegs { f32x4 O[4][NCG]; float m[NCG], l[NCG]; };

__device__ __forceinline__ void attn_reset(AttnRegs& R) {
#pragma unroll
    for (int md = 0; md < 4; ++md)
#pragma unroll
        for (int cg_ = 0; cg_ < NCG; ++cg_) R.O[md][cg_] = (f32x4){0.f, 0.f, 0.f, 0.f};
#pragma unroll
    for (int cg_ = 0; cg_ < NCG; ++cg_) { R.m[cg_] = -1e30f; R.l[cg_] = 0.f; }
}

constexpr int ATT_SLOT = 32768, ATT_WBASE = 2 * ATT_SLOT, ATT_WLDS = 9216;
#define ATT_BAR() do { asm volatile("s_waitcnt lgkmcnt(0)" ::: "memory"); __builtin_amdgcn_s_barrier(); asm volatile("" ::: "memory"); } while (0)

template <int CTRL> __device__ __forceinline__ int dpp_i(int v) { return __builtin_amdgcn_update_dpp(v, v, CTRL, 0xF, 0xF, false); }
template <int CTRL> __device__ __forceinline__ float dpp_f(float v) { return __int_as_float(dpp_i<CTRL>(__float_as_int(v))); }
__device__ __forceinline__ int row16_sum(int v) { v += dpp_i<0xB1>(v); v += dpp_i<0x4E>(v); v += dpp_i<0x141>(v); v += dpp_i<0x140>(v); return v; }
__device__ __forceinline__ float rowmax4(float x) {
    auto r = __builtin_amdgcn_permlane16_swap(__float_as_uint(x), __float_as_uint(x), false, false);
    const float a = fmaxf(__uint_as_float(r[0]), __uint_as_float(r[1]));
    auto q = __builtin_amdgcn_permlane32_swap(__float_as_uint(a), __float_as_uint(a), false, false);
    return fmaxf(__uint_as_float(q[0]), __uint_as_float(q[1]));
}
__device__ __forceinline__ float rowsum4(float x) {
    auto r = __builtin_amdgcn_permlane16_swap(__float_as_uint(x), __float_as_uint(x), false, false);
    const float a = __uint_as_float(r[0]) + __uint_as_float(r[1]);
    auto q = __builtin_amdgcn_permlane32_swap(__float_as_uint(a), __float_as_uint(a), false, false);
    return __uint_as_float(q[0]) + __uint_as_float(q[1]);
}

template <int MODE, bool MASKED>
__device__ __forceinline__ void attn_tile64(AttnRegs& R, const bf16x8 (&Qf)[NCG][2], LAS unsigned char* slot, int kb0, unsigned act, int tq_base, const unsigned (&selw)[NCG], int bit,
                                            int lane, LAS float* imp, int qi, int hg) {
    const int r16 = lane & 15, g = lane >> 4;
    const int fK = (r16 >> 2) | (((r16 >> 1) & 1) << 2), fV = (r16 >> 1) & 7;
    const int krow = 8 * (r16 >> 2) + (r16 & 3);
    LAS unsigned char* kp0 = slot + krow * 128 + ((g ^ fK) << 4);
    LAS unsigned char* kp1 = slot + krow * 128 + (((4 + g) ^ fK) << 4);
    LAS unsigned char* vp0 = slot + 8192 + r16 * 128 + ((g ^ fV) << 4);
    LAS unsigned char* vp1 = slot + 8192 + r16 * 128 + (((4 + g) ^ fV) << 4);
#pragma unroll
    for (int cg_ = 0; cg_ < NCG; ++cg_) {
        if (!(act & (1u << cg_))) continue;
        float s[16];
#pragma unroll
        for (int half = 0; half < 2; ++half) {
            const bf16x8 k00 = *(const LAS bf16x8*)(kp0 + half * 4096), k01 = *(const LAS bf16x8*)(kp1 + half * 4096);
            const bf16x8 k10 = *(const LAS bf16x8*)(kp0 + half * 4096 + 512), k11 = *(const LAS bf16x8*)(kp1 + half * 4096 + 512);
            f32x4 s0 = (f32x4){0.f, 0.f, 0.f, 0.f}, s1 = (f32x4){0.f, 0.f, 0.f, 0.f};
            s0 = MFMA16(k00, Qf[cg_][0], s0); s1 = MFMA16(k10, Qf[cg_][0], s1);
            s0 = MFMA16(k01, Qf[cg_][1], s0); s1 = MFMA16(k11, Qf[cg_][1], s1);
#pragma unroll
            for (int j = 0; j < 4; ++j) { s[half * 8 + j] = s0[j]; s[half * 8 + 4 + j] = s1[j]; }
        }
        const int tq = tq_base + 4 * cg_;
        if (MASKED) {
#pragma unroll
            for (int i = 0; i < 16; ++i) { const int key = kb0 + 32 * (i >> 3) + 8 * g + (i & 7); bool ok;
                if (MODE == 0) ok = (key <= tq) && (tq - key < 512);
                else if (MODE == 1) ok = (key <= tq);
                else ok = (16 * key + 31 <= tq);
                s[i] = ok ? s[i] : -INFINITY; }
        }
        const bool lane_on = (MODE == 1) ? (((selw[cg_] >> bit) & 1u) != 0u) : true;
        float p[16];
        if (MODE == 2) {
            const float mm = R.m[cg_], il = R.l[cg_];
#pragma unroll
            for (int i = 0; i < 16; ++i) p[i] = fexp2(s[i] - mm) * il;
#pragma unroll
            for (int half = 0; half < 2; ++half) {
                float ps[8];
#pragma unroll
                for (int i = 0; i < 8; ++i) { float v = p[half * 8 + i]; v += dpp_f<0xB1>(v); v += dpp_f<0x4E>(v); ps[i] = v; }
                if (hg == 0) {
                    const int jb = (kb0 + 32 * half + 8 * g) >> 2; LAS float* ip = imp + (4 * cg_ + qi) * 256 + jb;
                    __hip_atomic_fetch_add(ip, (ps[0] + ps[1]) + (ps[2] + ps[3]), __ATOMIC_RELAXED, __HIP_MEMORY_SCOPE_WORKGROUP);
                    if (jb + 1 < 256) __hip_atomic_fetch_add(ip + 1, ps[3] + (ps[4] + ps[5]) + (ps[6] + ps[7]), __ATOMIC_RELAXED, __HIP_MEMORY_SCOPE_WORKGROUP);
                    if (jb + 2 < 256) __hip_atomic_fetch_add(ip + 2, ps[7], __ATOMIC_RELAXED, __HIP_MEMORY_SCOPE_WORKGROUP);
                }
            }
        } else {
            float mx = fmaxf(fmaxf(fmaxf(s[0], s[1]), s[2]), fmaxf(fmaxf(s[3], s[4]), s[5])); mx = fmaxf(fmaxf(mx, s[6]), s[7]);
            float my = fmaxf(fmaxf(fmaxf(s[8], s[9]), s[10]), fmaxf(fmaxf(s[11], s[12]), s[13])); my = fmaxf(fmaxf(my, s[14]), s[15]);
            mx = fmaxf(mx, my);
            if (MODE == 1) mx = lane_on ? mx : -INFINITY;
            mx = rowmax4(mx);
            const float mold = R.m[cg_], mnew = fmaxf(mold, mx);
            if (__builtin_amdgcn_ballot_w64(mnew > mold) != 0ull) {
                const float alpha = fexp2(mold - mnew); R.m[cg_] = mnew; R.l[cg_] *= alpha;
                if (MODE != 3) {
#pragma unroll
                    for (int md = 0; md < 4; ++md) R.O[md][cg_] = R.O[md][cg_] * alpha;
                }
            }
            const float msub = ((MODE == 1) && !lane_on) ? INFINITY : mnew;
            float sum0 = 0.f, sum1 = 0.f;
#pragma unroll
            for (int i = 0; i < 8; ++i) { p[i] = fexp2(s[i] - msub); sum0 += p[i]; p[8 + i] = fexp2(s[8 + i] - msub); sum1 += p[8 + i]; }
            R.l[cg_] += sum0 + sum1;
        }
        if (MODE != 3) {
            const bf16x8 P0 = pack8(p), P1 = pack8(p + 8);
#pragma unroll
            for (int md = 0; md < 4; ++md) { const bf16x8 v0 = *(const LAS bf16x8*)(vp0 + md * 2048), v1 = *(const LAS bf16x8*)(vp1 + md * 2048);
                R.O[md][cg_] = MFMA16(v0, P0, R.O[md][cg_]); R.O[md][cg_] = MFMA16(v1, P1, R.O[md][cg_]); }
        }
    }
}

template <int MODE>
__device__ __forceinline__ void attn_stream(AttnRegs& R, const bf16x8 (&Qf)[NCG][2], LAS unsigned char* ring, const bf16_t* Kg, const bf16_t* Vg, int ldv, int t0, int nt, int tq_base,
                                            LAS unsigned* msk, LAS unsigned* uni, LAS float* imp, int tid, int lane, int qi, int hg) {
    constexpr bool HASV = (MODE != 3);
    const int tq_min_ = __builtin_amdgcn_readfirstlane(tq_base - qi), qb_ = tq_min_ >> 6;
    const int row = tid >> 3, cpos = tid & 7;
    const int cK = cpos ^ (((row >> 3) & 3) | (((row >> 1) & 1) << 2)), cV = cpos ^ ((row >> 1) & 7);
    const unsigned offk = (unsigned)(row * 64 + cK * 8) * 2u, offv = (unsigned)(row * 64 + cV * 8) * 2u;
    typedef const __attribute__((address_space(1))) char gcchar;
    gcchar* gk = (gcchar*)Kg + (size_t)t0 * 8192; gcchar* gv = (gcchar*)Vg + (size_t)t0 * 8192;
    const u32x4 z4 = (u32x4){0u, 0u, 0u, 0u};
    u32x4 ka0 = z4, va0 = z4, ka1 = z4, va1 = z4, kb0 = z4, vb0 = z4, kb1 = z4, vb1 = z4;
    const int ng = (nt + 1) >> 1;
#define ATT_LOADG(G, K0, V0, K1, V1) do { int T0_ = 2 * (G), T1_ = T0_ + 1; T0_ = T0_ < nt ? T0_ : nt - 1; T1_ = T1_ < nt ? T1_ : nt - 1;     \
        K0 = *(const __attribute__((address_space(1))) u32x4*)(gk + (size_t)T0_ * 8192 + offk); if (HASV) V0 = *(const __attribute__((address_space(1))) u32x4*)(gv + (size_t)T0_ * 8192 + offv); \
        K1 = *(const __attribute__((address_space(1))) u32x4*)(gk + (size_t)T1_ * 8192 + offk); if (HASV) V1 = *(const __attribute__((address_space(1))) u32x4*)(gv + (size_t)T1_ * 8192 + offv); } while (0)
#define ATT_STOREG(G, K0, V0, K1, V1) do { LAS unsigned char* ns_ = ring + ((G) & 1) * ATT_SLOT + tid * 16; \
        *(LAS u32x4*)ns_ = K0; if (HASV) *(LAS u32x4*)(ns_ + 8192) = V0; \
        *(LAS u32x4*)(ns_ + 16384) = K1; if (HASV) *(LAS u32x4*)(ns_ + 24576) = V1; } while (0)
    ATT_LOADG(0, ka0, va0, ka1, va1);
    ATT_STOREG(0, ka0, va0, ka1, va1);
    ATT_LOADG(1, ka0, va0, ka1, va1);
    ATT_BAR();
    unsigned selw[NCG];
#pragma unroll
    for (int cg_ = 0; cg_ < NCG; ++cg_) selw[cg_] = 0u;
#define ATT_STEP(I, PK0, PV0, PK1, PV1, WK0, WV0, WK1, WV1) do { \
        ATT_LOADG((I) + 2, PK0, PV0, PK1, PV1); \
        _Pragma("unroll 1") for (int sub_ = 0; sub_ < 2; ++sub_) { \
            if (2 * (I) + sub_ >= nt) break; \
            LAS unsigned char* slot = ring + ((I) & 1) * ATT_SLOT + sub_ * 16384; \
            const int tile = t0 + 2 * (I) + sub_; \
            unsigned act = (1u << NCG) - 1u; int bit = 0; \
            if (MODE == 1) { const int w = tile >> 5; bit = tile & 31; act = 0u; \
                _Pragma("unroll") for (int cg_ = 0; cg_ < NCG; ++cg_) { act |= ((__builtin_amdgcn_readfirstlane(uni[8 + cg_ * 8 + w]) >> bit) & 1u) << cg_; selw[cg_] = msk[(4 * cg_ + qi) * 8 + w]; } } \
            bool masked_; \
            if (MODE == 0) masked_ = (tile == qb_) || (tile == qb_ - 8); \
            else if (MODE == 1) masked_ = (tile == qb_); \
            else masked_ = (16 * (64 * tile + 63) + 31 > tq_min_); \
            (void)masked_; \
            attn_tile64<MODE, true>(R, Qf, slot, tile * 64, act, tq_base, selw, bit, lane, imp, qi, hg); \
        } \
        ATT_STOREG((I) + 1, WK0, WV0, WK1, WV1); \
        ATT_BAR(); } while (0)
    for (int i = 0; i < ng; i += 2) {
        ATT_STEP(i, kb0, vb0, kb1, vb1, ka0, va0, ka1, va1);
        if (i + 1 >= ng) break;
        ATT_STEP(i + 1, ka0, va0, ka1, va1, kb0, vb0, kb1, vb1);
    }
#undef ATT_STEP
#undef ATT_LOADG
#undef ATT_STOREG
}

template <int MODE, bool NORM>
__device__ __forceinline__ void attn_flush(AttnRegs& R, LAS float* ofin, const bf16_t* gp  , bf16_t* outp, int lane) {
#pragma unroll
    for (int cg_ = 0; cg_ < NCG; ++cg_) {
        float sc = sigmoidf_(bf1(gp[(size_t)(4 * cg_) * INP]));
        if (NORM) { const float L = rowsum4(R.l[cg_]); sc = L > 0.f ? sc / L : 0.f; }
#pragma unroll
        for (int md = 0; md < 4; ++md) {
            f32x4 v = R.O[md][cg_] * sc;
            LAS f32x4* slot = (LAS f32x4*)ofin + (md * NCG + cg_) * 64 + lane;
            if (MODE != 0) v = v + *slot;
            if (MODE != 2) *slot = v;
            else { u32x2 o; o.x = cvt_pk_bf16(v[0], v[1]); o.y = cvt_pk_bf16(v[2], v[3]); *(u32x2*)(outp + (size_t)(4 * cg_) * DM + 16 * md) = o; }
        }
    }
}

__device__ __forceinline__ void attn_unit(const Ctx& c, int bk, int qb) {
    int lane_ = c.lane, tid_ = c.tid; asm volatile("" : "+v"(lane_), "+v"(tid_));
    const int lane = lane_, r16 = lane & 15, g = lane >> 4, qi = r16 >> 2, hg = r16 & 3;
    const int b = bk >> 1, kvh = bk & 1;
    const int tq0 = qb * 64 + c.wave * QPW, cur = qb, head = kvh * 4 + hg;
    LAS unsigned char* ring = c.lds;
    LAS unsigned char* wl = c.lds + ATT_WBASE + c.wave * ATT_WLDS;
    unsigned long long wsi_ = (unsigned long long)c.ws; asm volatile("" : "+s"(wsi_)); unsigned char* wsu = (unsigned char*)(__attribute__((address_space(1))) unsigned char*)wsi_;
    LAS float* imp = (LAS float*)wl;
    LAS unsigned* msk = (LAS unsigned*)(wl + 8192);
    LAS unsigned* uni = (LAS unsigned*)(wl + 8192 + 256);
    const bf16_t* proj = (const bf16_t*)(wsu + WS_HID);
    const bf16_t* Qr = (const bf16_t*)(wsu + WS_QR);
    bf16x8 Qf[NCG][2];
#pragma unroll
    for (int cg_ = 0; cg_ < NCG; ++cg_) { const size_t tg = (size_t)b * SEQ + tq0 + 4 * cg_ + qi; const bf16_t* qp = Qr + tg * 512 + head * 64 + g * 8; Qf[cg_][0] = *(const bf16x8*)qp; Qf[cg_][1] = *(const bf16x8*)(qp + 32); }
    const bf16_t* gp = proj + ((size_t)b * SEQ + tq0 + qi) * INP + C_G + head * 3;
    bf16_t* outp = (bf16_t*)(wsu + WS_A) + ((size_t)b * SEQ + tq0 + qi) * DM + 512 + head * 64 + 4 * g;
    AttnRegs R;
    {
#pragma unroll
    for (int i = 0; i < QPW; ++i) ((LAS f32x4*)imp)[i * 64 + lane] = (f32x4){0.f, 0.f, 0.f, 0.f};
    CFENCE();
    {
        const bf16_t* Kc = (const bf16_t*)(wsu + WS_KCMP) + (size_t)bk * 1024 * 64; const bf16_t* Vc = (const bf16_t*)(wsu + WS_VCMPT) + (size_t)bk * 64 * 1024;
        const int ncount = 4 * qb + 3; const int nt = (ncount + 63) >> 6;
        attn_reset(R);
        attn_stream<3>(R, Qf, ring, Kc, Vc, 1024, 0, nt, tq0 + qi, msk, uni, imp, tid_, lane, qi, hg);
#pragma unroll
        for (int cg_ = 0; cg_ < NCG; ++cg_) { const float L = rowsum4(R.l[cg_]); R.l[cg_] = L > 0.f ? 1.0f / L : 0.f; }
        attn_stream<2>(R, Qf, ring, Kc, Vc, 1024, 0, nt, tq0 + qi, msk, uni, imp, tid_, lane, qi, hg);
    }
    LDS_WAIT(); CFENCE();
    }
    {
    if (cur < 16) {
        if (lane < QPW) {
#pragma unroll
            for (int w = 0; w < 8; ++w) { const int lo = 32 * w; unsigned v = 0u; if (cur >= lo) { const int nb = cur - lo + 1; v = nb >= 32 ? 0xFFFFFFFFu : ((1u << nb) - 1u); } msk[lane * 8 + w] = v; }
        }
    } else {
        LAS unsigned short* m16 = (LAS unsigned short*)msk;
        for (int rr = 0; rr < NCG; ++rr) {
            const int qq = 4 * rr + g; int v[16];
#pragma unroll
            for (int i = 0; i < 16; ++i) { const int j = i * 16 + r16; const bool cand = (j <= cur) && (j != 0) && (j != cur) && (j != cur - 1); v[i] = cand ? (int)__float_as_uint(imp[qq * 256 + j]) : -1; }
            int T = 0;
            for (int bitp = 30; bitp >= 0; --bitp) { const int cd = T | (1 << bitp); int cnt = 0;
#pragma unroll
                for (int i = 0; i < 16; ++i) cnt += (v[i] >= cd) ? 1 : 0;
                cnt = row16_sum(cnt);
                if (cnt >= 13) T = cd; }
            int gt = 0;
#pragma unroll
            for (int i = 0; i < 16; ++i) gt += (v[i] > T) ? 1 : 0;
            gt = row16_sum(gt);
            const int need = 13 - gt; int running = 0;
#pragma unroll
            for (int i = 0; i < 16; ++i) { const int j = i * 16 + r16; const bool eq = (v[i] == T);
                const unsigned long long bal = __ballot(eq); const unsigned be = (unsigned)(bal >> (16 * g)) & 0xFFFFu;
                const int rank = running + __popc(be & ((1u << r16) - 1u)); running += __popc(be);
                const bool forced = (j <= cur) && ((j == 0) || (j == cur) || (j == cur - 1));
                const bool sel = (v[i] > T) || (eq && rank < need) || forced;
                const unsigned long long bs = __ballot(sel);
                if (r16 == 0) m16[qq * 16 + i] = (unsigned short)((bs >> (16 * g)) & 0xFFFFu); }
        }
    }
    LDS_WAIT(); CFENCE();
    }
    if (lane < 8) { unsigned u = 0u;
#pragma unroll
        for (int q = 0; q < QPW; ++q) u |= msk[q * 8 + lane];
        uni[lane] = u; }
    if (lane < 8 * NCG) { const int cg_ = lane >> 3, w = lane & 7; unsigned u = 0u;
#pragma unroll
        for (int q = 0; q < 4; ++q) u |= msk[(4 * cg_ + q) * 8 + w];
        uni[8 + lane] = u; }
    LDS_WAIT(); CFENCE();
    attn_flush<0, false>(R, imp, gp + 0, outp, lane);
    {
        const bf16_t* Ks = (const bf16_t*)(wsu + WS_KS) + (size_t)bk * SEQ * 64; const bf16_t* Vs = (const bf16_t*)(wsu + WS_VST) + (size_t)bk * 64 * SEQ;
        {
        attn_reset(R);
        attn_stream<1>(R, Qf, ring, Ks, Vs, SEQ, 0, cur + 1, tq0 + qi, msk, uni, imp, tid_, lane, qi, hg);
        }
        attn_flush<1, true>(R, imp, gp + 1, outp, lane);
    }
    {
        const bf16_t* Kw = (const bf16_t*)(wsu + WS_KW) + (size_t)bk * SEQ * 64; const bf16_t* Vw = (const bf16_t*)(wsu + WS_VWT) + (size_t)bk * 64 * SEQ;
        int t0 = qb - 8; if (t0 < 0) t0 = 0;
        {
        attn_reset(R);
        attn_stream<0>(R, Qf, ring, Kw, Vw, SEQ, t0, qb - t0 + 1, tq0 + qi, msk, uni, imp, tid_, lane, qi, hg);
        }
        attn_flush<2, true>(R, imp, gp + 2, outp, lane);
    }
    LDS_WAIT(); CFENCE();
}

__device__ __forceinline__ void lru_fin_unit(const Ctx& c, int u) {
    const int hh = u & 3, ch = (u >> 2) % LRU_NCH, b = (u >> 2) / LRU_NCH; const int chn = hh * 64 + c.lane;
    const float* carA = (const float*)(c.ws + WS_CARA) + (size_t)b * LRU_NCH * 256 + chn; const float* carH = (const float*)(c.ws + WS_CARH) + (size_t)b * LRU_NCH * 256 + chn;
    float h = 0.f;
    for (int k = 0; k < ch; ++k) h = carA[k * 256] * h + carH[k * 256];
    const float* HL = (const float*)(c.ws + WS_F); const float* CA = HL + (size_t)M * 256;
    const bf16_t* proj = (const bf16_t*)(c.ws + WS_HID); bf16_t* out = (bf16_t*)(c.ws + WS_A);
    const size_t tg0 = (size_t)b * SEQ + ch * LRU_CHUNK;
#pragma unroll 4
    for (int t = 0; t < LRU_CHUNK; ++t) { const size_t tg = tg0 + t;
        const float hv = HL[tg * 256 + chn] + CA[tg * 256 + chn] * h; const float x = bf1(proj[tg * INP + C_GL + chn]);
        const float u3 = 0.7978845608028654f * (x + 0.044715f * x * x * x); const float th = 1.0f - 2.0f / (1.0f + __expf(2.0f * u3));
        const float y = hv * (0.5f * x * (1.0f + th));
        out[tg * DM + 256 + chn] = (bf16_t)(cvt_pk_bf16(y, 0.f) & 0xffffu); }
}

constexpr int NU_ATT = (SEQ / QPW) * 4;
__device__ __forceinline__ void phase_attn_units(const Ctx& c) {
    for (int p2 = (c.gw / NWAVES) * 2; p2 < 1024; p2 += c.G * 2) { const int p = p2 >> 1;
        for (int r = 0; r < 2; ++r) { const int bk = p & 3, ql = p >> 2; attn_unit(c, bk, r ? 255 - ql : ql); } }
    __syncthreads();
}
__device__ __forceinline__ void phase_attn_fin(const Ctx& c) {
    for (int u = c.gw; u < NU_LRU; u += c.ngw) lru_fin_unit(c, u);
}
__device__ __forceinline__ void phase_attn(const Ctx& c) {
    phase_attn_units(c);
    phase_attn_fin(c);
}

constexpr int N_PHASES = 1 + 11 * DEPTH;
__global__ void __launch_bounds__(NTHREADS, 2) fwd_kernel(Args args) {
    extern __shared__ __attribute__((aligned(16))) unsigned char lds_raw[];
    {
        LAS unsigned long long* tab = (LAS unsigned long long*)((LAS unsigned char*)lds_raw + PTAB_OFF);
        if (threadIdx.x < 28) tab[threadIdx.x] = (unsigned long long)args.in[threadIdx.x];
        if (threadIdx.x == 28) tab[28] = (unsigned long long)args.out;
        if (threadIdx.x == 29) tab[29] = (unsigned long long)args.ws;
        if (threadIdx.x == 30) tab[30] = (unsigned long long)(unsigned)args.rep_attn | ((unsigned long long)(unsigned)args.rep_fin << 32);
        if (threadIdx.x == 31) tab[31] = (unsigned long long)(unsigned)args.rep_prep;
        __syncthreads();
    }
    const int ph_lo = args.ph_lo, ph_hi = args.ph_hi;
    const int wave_s = __builtin_amdgcn_readfirstlane(threadIdx.x >> 6);
    using namespace pg8;
    for (int ph = ph_lo; ph < ph_hi; ++ph) {
        Ctx c;
        int tid = threadIdx.x; asm volatile("" : "+v"(tid));
        int bid = blockIdx.x; asm volatile("" : "+s"(bid));
        unsigned ldsb = (unsigned)(size_t)(LAS unsigned char*)lds_raw; asm volatile("" : "+s"(ldsb));
        c.lds = (LAS unsigned char*)(size_t)ldsb; c.tid = tid; c.lane = tid & 63; c.wave = __builtin_amdgcn_readfirstlane(tid >> 6);
        c.G = gridDim.x; c.gw = bid * NWAVES + c.wave; c.ngw = c.G * NWAVES;
        c.wlds = c.lds + c.wave * WAVE_LDS;
        unsigned char* ws = (unsigned char*)ldptr(c.lds, 29); c.ws = ws;
        float* outp = (float*)ldptr(c.lds, 28);
        if (ph == 0) {
#ifndef NO_P0
            p0_prologue(c);
#endif
        } else {
            const int l = (ph - 1) / 11, s = (ph - 1) % 11;
            if (s == 0 || s == 8) {
                const int which = s == 8; Gemm g{(const bf16_t*)(ws + WS_A), (const bf16_t*)(ws + WS_WGU + (size_t)(l * 2 + which) * SZ_WGU), M, NGU, DM};
                StaticOrder S; S.init(M, NGU, c.G, bid); EpiSwiGLU E{(bf16_t*)(ws + WS_HID)};
                gemm_phase<EpiSwiGLU, StaticOrder, true, true>(c.lds, g, S, E, tid);
            } else if (s == 1 || s == 9 || s == 3 || s == 6) {
                const bf16_t* A; const bf16_t* Bt; bf16_t* O; int N, K;
                if (s == 3) { A = (const bf16_t*)(ws + WS_A); Bt = (const bf16_t*)(ws + WS_WIN + (size_t)l * SZ_WIN); O = (bf16_t*)(ws + WS_HID); N = INP; K = DM; }
                else if (s == 6) { A = (const bf16_t*)(ws + WS_A); Bt = (const bf16_t*)(ws + WS_WOUT + (size_t)l * SZ_WOUT); O = (bf16_t*)(ws + WS_F); N = DM; K = DM; }
                else { A = (const bf16_t*)(ws + WS_HID); Bt = (const bf16_t*)(ws + WS_WDN + (size_t)(l * 2 + (s == 9)) * SZ_WDN); O = (bf16_t*)(ws + WS_F); N = DM; K = FF; }
                Gemm g{A, Bt, M, N, K};
                StaticOrder S; S.init(M, N, c.G, bid); EpiStore E{O, N};
                gemm_phase<EpiStore, StaticOrder, true, true>(c.lds, g, S, E, tid);
            } else if (s == 4) {
#ifndef NO_PREP
                phase_prep(c, l);
#endif
            } else if (s == 5) {
#ifndef NO_ATTN
                phase_attn(c);
#endif
            } else {
                const float* hin = (s == 2 && l == 0) ? INP_F(0) : outp;
                const float* gpost = INP_F(s == 2 ? 3 : (s == 7 ? 8 : 24)) + l * DM;
                const float* gnext = s == 2 ? INP_F(7) + l * DM : (s == 7 ? INP_F(23) + l * DM : ((l + 1 < DEPTH) ? INP_F(2) + (l + 1) * DM : nullptr));
                rowpass(c, hin, outp, (const bf16_t*)(ws + WS_F), gpost, s == 7 ? 1.0f : 0.5f, gnext, (bf16_t*)(ws + WS_A));
            }
        }
        if (ph + 1 < ph_hi) { cg::this_grid().sync(); }
    }
}

extern "C" void kernel_launch(void* const* d_in, const int* in_sizes, int n_in, void* d_out, int out_size, void* d_ws, size_t ws_size, hipStream_t stream) {
    static int grid = 0;
    if (grid == 0) {
        if (n_in != 28 || out_size != M * DM || ws_size < WS_END) { fprintf(stderr, "kernel_launch: unexpected shapes (n_in %d out %d ws %zu need %zu)\n", n_in, out_size, ws_size, (size_t)WS_END); grid = -1; return; }
        int dev = 0, cus = 0, per_cu = 0;
        hipGetDevice(&dev); hipDeviceGetAttribute(&cus, hipDeviceAttributeMultiprocessorCount, dev);
        if (hipFuncSetAttribute((const void*)fwd_kernel, hipFuncAttributeMaxDynamicSharedMemorySize, LDS_BYTES) != hipSuccess) { fprintf(stderr, "kernel_launch: hipFuncSetAttribute failed\n"); grid = -1; return; }
        if (hipOccupancyMaxActiveBlocksPerMultiprocessor(&per_cu, (const void*)fwd_kernel, NTHREADS, LDS_BYTES) != hipSuccess || per_cu < 1) { fprintf(stderr, "kernel_launch: occupancy query says %d\n", per_cu); per_cu = 1; }
        (void)hipGetLastError();
        grid = cus * per_cu;
        fprintf(stderr, "kernel_launch: grid %d (cus %d x %d)\n", grid, cus, per_cu);
    }
    if (grid < 0) return;
    Args a{};
    for (int i = 0; i < 28; ++i) a.in[i] = d_in[i];
    a.out = (float*)d_out; a.ws = (unsigned char*)d_ws;
#ifndef REP_ATTN
#define REP_ATTN 1
#endif
#ifndef REP_FIN
#define REP_FIN 1
#endif
#ifndef REP_PREP
#define REP_PREP 0
#endif
    a.rep_attn = REP_ATTN; a.rep_fin = REP_FIN; a.rep_prep = REP_PREP; a.rep_pad = 0;
#if N_LAUNCH_MODE == 1
    a.ph_lo = 0; a.ph_hi = N_PHASES;
    void* kargs[] = {&a};
    hipError_t e = hipLaunchCooperativeKernel((const void*)fwd_kernel, dim3(grid), dim3(NTHREADS), kargs, LDS_BYTES, stream);
    if (e != hipSuccess) fprintf(stderr, "cooperative launch failed: %s (grid %d)\n", hipGetErrorString(e), grid);
#else
    for (int ph = 0; ph < N_PHASES; ++ph) {
        a.ph_lo = ph; a.ph_hi = ph + 1;
        hipLaunchKernelGGL(fwd_kernel, dim3(grid), dim3(NTHREADS), LDS_BYTES, stream, a);
    }
#endif
}
```

```cpp
#include <hip/hip_runtime.h>
#include <hip/hip_cooperative_groups.h>
#include <cstdio>
#include <cstdint>
namespace cg = cooperative_groups;

#define LAS __attribute__((address_space(3)))
typedef unsigned short bf16_t;
typedef short bf16x8 __attribute__((ext_vector_type(8)));
typedef float f32x4 __attribute__((ext_vector_type(4)));
typedef float f32x2 __attribute__((ext_vector_type(2)));
typedef unsigned u32x4 __attribute__((ext_vector_type(4)));
typedef unsigned u32x2 __attribute__((ext_vector_type(2)));

#ifndef N_LAUNCH_MODE
#define N_LAUNCH_MODE 1
#endif

constexpr int BATCH = 2, SEQ = 16384, DM = 1024, M = BATCH * SEQ, FF = 2816, NGU = 2 * FF, DEPTH = 2;
constexpr int INC = 2072, INP = 2304;
constexpr int C_XP = 0, C_XL = 256, C_GL = 512, C_Q = 768, C_KC = 1280, C_VC = 1408, C_KS = 1536, C_VS = 1664, C_KW = 1792, C_VW = 1920, C_G = 2048;
constexpr float EPS = 1e-6f;
constexpr float QSCALE = 0.125f * 1.4426950408889634f;
constexpr int NWAVES = 8, NTHREADS = 512;
constexpr int LRU_CHUNK = 128, LRU_NCH = SEQ / LRU_CHUNK;

constexpr size_t SZ_WGU = (size_t)NGU * DM * 2, SZ_WDN = (size_t)DM * FF * 2, SZ_WIN = (size_t)INP * DM * 2, SZ_WOUT = (size_t)DM * DM * 2;
constexpr size_t WS_WGU = 0;
constexpr size_t WS_WDN = WS_WGU + 4 * SZ_WGU;
constexpr size_t WS_WIN = WS_WDN + 4 * SZ_WDN;
constexpr size_t WS_WOUT = WS_WIN + 2 * SZ_WIN;
constexpr size_t WS_WPOOL = WS_WOUT + 2 * SZ_WOUT;
constexpr size_t WS_WLRU = WS_WPOOL + 2 * 4 * 4096 * 2;
constexpr size_t WS_WCMP = WS_WLRU + 2 * 2 * 4 * 4096 * 2;
constexpr size_t WS_COS = WS_WCMP + 2 * 2 * 64 * 2048 * 2;
constexpr size_t WS_SIN = WS_COS + (size_t)M * 32 * 4;
constexpr size_t WS_A = WS_SIN + (size_t)M * 32 * 4;
constexpr size_t WS_HID = WS_A + (size_t)M * DM * 2;
constexpr size_t WS_QR = WS_HID + (size_t)M * INP * 2;
constexpr size_t WS_F = WS_HID + (size_t)M * FF * 2;
constexpr size_t WS_KS = WS_F + (size_t)M * DM * 2;
constexpr size_t WS_KW = WS_KS + (size_t)4 * SEQ * 64 * 2;
constexpr size_t WS_VST = WS_KW + (size_t)4 * SEQ * 64 * 2;
constexpr size_t WS_VWT = WS_VST + (size_t)4 * SEQ * 64 * 2;
constexpr size_t WS_KCMP = WS_VWT + (size_t)4 * SEQ * 64 * 2;
constexpr size_t WS_VCMPT = WS_KCMP + (size_t)4 * 1024 * 64 * 2;
constexpr size_t WS_CARA = WS_VCMPT + (size_t)4 * 1024 * 64 * 2;
constexpr size_t WS_CARH = WS_CARA + (size_t)BATCH * LRU_NCH * 256 * 4;
constexpr size_t WS_CTL = WS_CARH + (size_t)BATCH * LRU_NCH * 256 * 4;
constexpr size_t CTL_BYTES = 65536;
constexpr size_t WS_END = WS_CTL + CTL_BYTES;
static_assert(WS_QR + (size_t)M * 512 * 2 == WS_F, "Qr fills the tail of the hidden buffer");
static_assert(WS_END <= (size_t)512 * 1024 * 1024, "workspace map");
static_assert(2 * 32768 + 8 * 9216 <= 147456 - 256, "attention LDS map");

constexpr int LDS_BYTES = 147456;
constexpr int WAVE_LDS = 17408;

__device__ __forceinline__ unsigned cvt_pk_bf16(float lo, float hi) { unsigned r; asm volatile("v_cvt_pk_bf16_f32 %0, %1, %2" : "=v"(r) : "v"(lo), "v"(hi)); return r; }
__device__ __forceinline__ float bflo(unsigned w) { return __uint_as_float(w << 16); }
__device__ __forceinline__ float bfhi(unsigned w) { return __uint_as_float(w & 0xffff0000u); }
__device__ __forceinline__ float bf1(unsigned short u) { return __uint_as_float((unsigned)u << 16); }
__device__ __forceinline__ float fexp2(float x) { return __builtin_amdgcn_exp2f(x); }
__device__ __forceinline__ float sigmoidf_(float x) { return 1.0f / (1.0f + __expf(-x)); }
__device__ __forceinline__ float wave_sum(float v) {
#pragma unroll
    for (int o = 1; o < 64; o <<= 1) v += __shfl_xor(v, o);
    return v;
}
#define LDS_WAIT() asm volatile("s_waitcnt lgkmcnt(0)" ::: "memory")
#define CFENCE() asm volatile("" ::: "memory")

namespace pg8 {
constexpr int BM = 256, BK = 64, HALF = 128, HTB = HALF * BK * 2, STAGE_BYTES = 8 * HTB, NXCD = 8, WGM = 8;
__host__ __device__ __forceinline__ int lds_byte(int r, int c) { const int st = (r >> 4) * 2 + (c >> 5), rr = r & 15, cc = c & 31, ob = rr * 64 + cc * 2; return st * 1024 + (ob ^ (((ob >> 9) & 1) << 5)); }
__host__ __device__ __forceinline__ void stage_rc(int b, int& R, int& C) { const int st = b / 1024, sb = b % 1024, swz = sb ^ (((sb >> 9) & 1) << 5); R = (st >> 1) * 16 + swz / 64; C = (st & 1) * 32 + (swz % 64) / 2; }
__host__ __device__ __forceinline__ int perm32(int rho) { const int n = rho >> 4, i = rho & 15; return 8 * (i >> 2) + 4 * n + (i & 3); }
struct Unit { int pm, pn; };
struct Gemm { const bf16_t* A; const bf16_t* Bt; int M, N, K; };
struct StaticOrder {
    int nM, nN, nwg, G, c;
    __device__ void init(int M_, int N_, int G_, int c_) { nM = M_ / BM; nN = N_ / BM; nwg = nM * nN; G = G_; c = c_; }
    __device__ bool next(int i, Unit& u) const {
        const long L = (long)i * G + c; if (L >= nwg) return false;
        int wgid = (int)L; { const int q = nwg / NXCD, r = nwg % NXCD, xcd = wgid % NXCD, off = wgid / NXCD; wgid = (xcd < r ? xcd * (q + 1) : r * (q + 1) + (xcd - r) * q) + off; }
        const int nig = WGM * nN, gid = wgid / nig, fm = gid * WGM, gsz = (nM - fm) < WGM ? (nM - fm) : WGM;
        u.pm = fm + ((wgid % nig) % gsz); u.pn = (wgid % nig) / gsz; return true;
    }
    __device__ __forceinline__ void a_ready(const Unit&) const {}
    __device__ __forceinline__ void done(const Unit&) const {}
};
struct EpiStore {
    static constexpr bool PERM = true, AFTER_DRAIN = false;
    bf16_t* O; int ldc;
    __device__ __forceinline__ void operator()(const f32x4 (&acc)[2][2][4][2], const Unit& u, int wr, int wc, int fr, int fq) const {
        const int row0 = u.pm * BM + wr * 64 + fr, col0 = u.pn * BM + wc * 32 + 8 * fq;
#pragma unroll
        for (int ai = 0; ai < 2; ++ai)
#pragma unroll
            for (int m = 0; m < 4; ++m) { bf16_t* rowp = O + (size_t)(row0 + ai * HALF + m * 16) * ldc + col0;
#pragma unroll
                for (int bj = 0; bj < 2; ++bj) { const f32x4 v0 = acc[ai][bj][m][0], v1 = acc[ai][bj][m][1];
                    u32x4 w; w.x = cvt_pk_bf16(v0[0], v0[1]); w.y = cvt_pk_bf16(v0[2], v0[3]); w.z = cvt_pk_bf16(v1[0], v1[1]); w.w = cvt_pk_bf16(v1[2], v1[3]);
                    *(u32x4*)(rowp + bj * HALF) = w; } }
    }
};
struct EpiSwiGLU {
    static constexpr bool PERM = true, AFTER_DRAIN = false;
    bf16_t* O;
    __device__ __forceinline__ void operator()(const f32x4 (&acc)[2][2][4][2], const Unit& u, int wr, int wc, int fr, int fq) const {
        const int row0 = u.pm * BM + wr * 64 + fr, col0 = u.pn * HALF + wc * 32 + 8 * fq;
#pragma unroll
        for (int ai = 0; ai < 2; ++ai)
#pragma unroll
            for (int m = 0; m < 4; ++m) { bf16_t* rowp = O + (size_t)(row0 + ai * HALF + m * 16) * FF + col0;
                float r[8];
#pragma unroll
                for (int n = 0; n < 2; ++n)
#pragma unroll
                    for (int j = 0; j < 4; ++j) { const float g = acc[ai][0][m][n][j], up = acc[ai][1][m][n][j];
                        r[n * 4 + j] = g * __builtin_amdgcn_rcpf(1.0f + fexp2(-1.4426950408889634f * g)) * up; }
                u32x4 w; w.x = cvt_pk_bf16(r[0], r[1]); w.y = cvt_pk_bf16(r[2], r[3]); w.z = cvt_pk_bf16(r[4], r[5]); w.w = cvt_pk_bf16(r[6], r[7]);
                *(u32x4*)rowp = w; }
    }
};

template <class Epi, class Sched, bool ALIGN_EPI = false, bool SP2 = false>
__device__ __forceinline__ void gemm_phase(LAS unsigned char* lds, const Gemm g, const Sched& S, const Epi& E, const int tid) {
    const int wid = __builtin_amdgcn_readfirstlane(tid >> 6), lane = tid & 63, wr = wid >> 2, wc = wid & 3, fr = lane & 15, fq = lane >> 4;
    const int K = g.K, nt = K / BK;
    unsigned voffA[2], voffB[2];
#pragma unroll
    for (int i = 0; i < 2; ++i) { int R, C; stage_rc(tid * 16 + i * 8192, R, C); const int Rb = Epi::PERM ? ((R & ~31) + perm32(R & 31)) : R;
        voffA[i] = (unsigned)(R * K + C) * 2u; voffB[i] = (unsigned)(Rb * K + C) * 2u; }
    const size_t kstep = (size_t)(BK * 2);
    const size_t hstep = (size_t)HALF * K * 2;
    const size_t tstep = 2 * hstep;
    const unsigned ldsw = (unsigned)wid * 1024u;
    const int aoff = lds_byte(wr * 64 + fr, fq * 8), boff = lds_byte(wc * 32 + fr, fq * 8);
#define PG8_SA(b, h) (((b) * 2 + (h)) * HTB)
#define PG8_SB(b, h) ((4 + (b) * 2 + (h)) * HTB)
#define PG8_STAGE(bufoff, gbase, voff) do { _Pragma("unroll") for (int _i = 0; _i < 2; ++_i) \
        __builtin_amdgcn_global_load_lds((const unsigned*)((const char*)(gbase) + (voff)[_i]), (LAS unsigned*)(lds + (bufoff) + ldsw + _i * 8192), 16, 0, 0); } while (0)
#define PG8_LDA(dst, b, h) do { _Pragma("unroll") for (int m = 0; m < 4; ++m) _Pragma("unroll") for (int k = 0; k < 2; ++k) dst[m][k] = *(const LAS bf16x8*)(lds + PG8_SA(b, h) + aoff + m * 2048 + k * 1024); } while (0)
#define PG8_LDB(dst, b, h) do { _Pragma("unroll") for (int n = 0; n < 2; ++n) _Pragma("unroll") for (int k = 0; k < 2; ++k) dst[n][k] = *(const LAS bf16x8*)(lds + PG8_SB(b, h) + boff + n * 2048 + k * 1024); } while (0)
#define PG8_MMA(ai, bj, At, Bt) do { __builtin_amdgcn_s_setprio(1); _Pragma("unroll") for (int m = 0; m < 4; ++m) _Pragma("unroll") for (int n = 0; n < 2; ++n) _Pragma("unroll") for (int k = 0; k < 2; ++k) \
        acc[ai][bj][m][n] = __builtin_amdgcn_mfma_f32_16x16x32_bf16(Bt[n][k], At[m][k], acc[ai][bj][m][n], 0, 0, 0); __builtin_amdgcn_s_setprio(0); } while (0)
#define PG8_WAIT_V(n) asm volatile("s_waitcnt vmcnt(" #n ")" ::: "memory")
#define PG8_WAIT_L(n) asm volatile("s_waitcnt lgkmcnt(" #n ")" ::: "memory")
#define PG8_BAR __builtin_amdgcn_s_barrier()
#define PG8_SCHED __builtin_amdgcn_sched_barrier(0)
    Unit cur, nxt; int ui = 0;
    if (!S.next(0, cur)) return;
    f32x4 acc[2][2][4][2];
#pragma unroll
    for (int a = 0; a < 2; ++a)
#pragma unroll
        for (int b = 0; b < 2; ++b)
#pragma unroll
            for (int m = 0; m < 4; ++m)
#pragma unroll
                for (int n = 0; n < 2; ++n) acc[a][b][m][n] = (f32x4){0.f, 0.f, 0.f, 0.f};
    bf16x8 At[4][2], B0[2][2], B1[2][2];
    const char* cA = (const char*)g.A + (size_t)cur.pm * tstep; const char* cB = (const char*)g.Bt + (size_t)cur.pn * tstep;
    S.a_ready(cur);
    if constexpr (SP2) {
        PG8_STAGE(PG8_SB(0, 0), cB, voffB); PG8_STAGE(PG8_SB(0, 1), cB + hstep, voffB); PG8_STAGE(PG8_SA(0, 0), cA, voffA); PG8_STAGE(PG8_SA(0, 1), cA + hstep, voffA);
        if (wr == 1) PG8_BAR;
        PG8_WAIT_V(2); PG8_BAR;
        PG8_STAGE(PG8_SB(1, 0), cB + kstep, voffB); PG8_STAGE(PG8_SA(1, 0), cA + kstep, voffA); PG8_STAGE(PG8_SB(1, 1), cB + hstep + kstep, voffB);
        PG8_WAIT_V(6); PG8_BAR;
    } else {
        PG8_STAGE(PG8_SB(0, 0), cB, voffB); PG8_STAGE(PG8_SA(0, 0), cA, voffA); PG8_STAGE(PG8_SB(0, 1), cB + hstep, voffB); PG8_STAGE(PG8_SA(0, 1), cA + hstep, voffA);
        if (wr == 1) PG8_BAR;
        PG8_WAIT_V(4); PG8_BAR;
        PG8_STAGE(PG8_SB(1, 0), cB + kstep, voffB); PG8_STAGE(PG8_SA(1, 0), cA + kstep, voffA); PG8_STAGE(PG8_SB(1, 1), cB + hstep + kstep, voffB);
        PG8_WAIT_V(6); PG8_BAR;
    }
    for (;;) {
        const bool has_next = S.next(ui + 1, nxt);
        const char* nA = has_next ? (const char*)g.A + (size_t)nxt.pm * tstep : cA; const char* nB = has_next ? (const char*)g.Bt + (size_t)nxt.pn * tstep : cB;
        for (int t = 0; t < nt; t += 2) {
            const bool last = (t == nt - 2);
            const char* a1 = cA + (size_t)(t + 1) * kstep;
            const char* a2 = last ? nA : cA + (size_t)(t + 2) * kstep; const char* b2 = last ? nB : cB + (size_t)(t + 2) * kstep;
            const char* a3 = a2 + kstep; const char* b3 = b2 + kstep;
            if (last && has_next) S.a_ready(nxt);
            if constexpr (SP2) {
            PG8_LDB(B0, 0, 0); PG8_LDB(B1, 0, 1); PG8_SCHED; PG8_LDA(At, 0, 0); PG8_STAGE(PG8_SA(1, 1), a1 + hstep, voffA);
            PG8_WAIT_V(8); PG8_WAIT_L(0); PG8_BAR; PG8_MMA(0, 0, At, B0); PG8_MMA(0, 1, At, B1); PG8_BAR; PG8_SCHED;
            PG8_LDA(At, 0, 1); PG8_STAGE(PG8_SB(0, 0), b2, voffB); PG8_STAGE(PG8_SB(0, 1), b2 + hstep, voffB); PG8_STAGE(PG8_SA(0, 0), a2, voffA);
            PG8_WAIT_V(8); PG8_WAIT_L(0); PG8_BAR; PG8_MMA(1, 0, At, B0); PG8_MMA(1, 1, At, B1); PG8_BAR; PG8_SCHED;
            PG8_LDB(B0, 1, 0); PG8_LDB(B1, 1, 1); PG8_SCHED; PG8_LDA(At, 1, 0); PG8_STAGE(PG8_SA(0, 1), a2 + hstep, voffA);
            PG8_WAIT_V(8); PG8_WAIT_L(0); PG8_BAR; PG8_MMA(0, 0, At, B0); PG8_MMA(0, 1, At, B1); PG8_BAR; PG8_SCHED;
            PG8_LDA(At, 1, 1); PG8_STAGE(PG8_SB(1, 0), b3, voffB); PG8_STAGE(PG8_SB(1, 1), b3 + hstep, voffB); PG8_STAGE(PG8_SA(1, 0), a3, voffA);
            PG8_WAIT_V(8); PG8_WAIT_L(0); PG8_BAR; PG8_MMA(1, 0, At, B0); PG8_MMA(1, 1, At, B1); PG8_BAR; PG8_SCHED;
            } else {
            PG8_LDB(B0, 0, 0); PG8_SCHED; PG8_LDA(At, 0, 0); PG8_STAGE(PG8_SA(1, 1), a1 + hstep, voffA);
            PG8_WAIT_L(8); PG8_BAR; PG8_WAIT_L(0); PG8_MMA(0, 0, At, B0); PG8_BAR; PG8_SCHED;
            PG8_LDB(B1, 0, 1); PG8_STAGE(PG8_SB(0, 0), b2, voffB);
            PG8_BAR; PG8_WAIT_L(0); PG8_MMA(0, 1, At, B1); PG8_BAR;
            PG8_LDA(At, 0, 1); PG8_STAGE(PG8_SA(0, 0), a2, voffA);
            PG8_BAR; PG8_WAIT_L(0); PG8_MMA(1, 0, At, B0); PG8_BAR; PG8_SCHED;
            PG8_STAGE(PG8_SB(0, 1), b2 + hstep, voffB);
            PG8_WAIT_V(6); PG8_BAR; PG8_MMA(1, 1, At, B1); PG8_BAR;
            PG8_LDB(B0, 1, 0); PG8_SCHED; PG8_LDA(At, 1, 0); PG8_STAGE(PG8_SA(0, 1), a2 + hstep, voffA);
            PG8_WAIT_L(8); PG8_BAR; PG8_WAIT_L(0); PG8_MMA(0, 0, At, B0); PG8_BAR; PG8_SCHED;
            PG8_LDB(B1, 1, 1); PG8_STAGE(PG8_SB(1, 0), b3, voffB);
            PG8_BAR; PG8_WAIT_L(0); PG8_MMA(0, 1, At, B1); PG8_BAR;
            PG8_LDA(At, 1, 1); PG8_STAGE(PG8_SA(1, 0), a3, voffA);
            PG8_BAR; PG8_WAIT_L(0); PG8_MMA(1, 0, At, B0); PG8_BAR; PG8_SCHED;
            PG8_STAGE(PG8_SB(1, 1), b3 + hstep, voffB);
            PG8_WAIT_V(6); PG8_BAR; PG8_MMA(1, 1, At, B1); PG8_BAR;
            }
        }
        if constexpr (ALIGN_EPI) { if (wr == 0) PG8_BAR; }
        if constexpr (!Epi::AFTER_DRAIN) { E(acc, cur, wr, wc, fr, fq); S.done(cur); }
        if (!has_next) break;
#pragma unroll
        for (int a = 0; a < 2; ++a)
#pragma unroll
            for (int b = 0; b < 2; ++b)
#pragma unroll
                for (int m = 0; m < 4; ++m)
#pragma unroll
                    for (int n = 0; n < 2; ++n) acc[a][b][m][n] = (f32x4){0.f, 0.f, 0.f, 0.f};
        cur = nxt; cA = nA; cB = nB; ++ui;
        if constexpr (ALIGN_EPI) { if (wr == 1) PG8_BAR; }
    }
    PG8_WAIT_V(0);
    if constexpr (!ALIGN_EPI) { if (wr == 0) PG8_BAR; }
    PG8_BAR;
#undef PG8_SA
#undef PG8_SB
#undef PG8_STAGE
#undef PG8_LDA
#undef PG8_LDB
#undef PG8_MMA
#undef PG8_WAIT_V
#undef PG8_WAIT_L
#undef PG8_BAR
#undef PG8_SCHED
}
}

#define XB_TMO      128
#define XB_XCNT(j)  (256  + 64 * (j))
#define XB_XSUB(j)  (1280 + 64 * (j))
#define XB_XGEN(j)  (2304 + 64 * (j))
#define XB_TOP      3328
#define XB_TOPGEN   3392
#define XCD_BAR_WORDS 3456
#define XB_SPIN_CAP (1u << 18)
__device__ __forceinline__ unsigned xb_ld(unsigned* p)              { return __hip_atomic_load(p, __ATOMIC_RELAXED, __HIP_MEMORY_SCOPE_AGENT); }
__device__ __forceinline__ unsigned xb_add(unsigned* p, unsigned v) { return __hip_atomic_fetch_add(p, v, __ATOMIC_RELAXED, __HIP_MEMORY_SCOPE_AGENT); }
__device__ __forceinline__ unsigned xb_xcc_id() { return (unsigned)__builtin_amdgcn_s_getreg((3 << 11) | 20) & 0xFu; }
#define XB_SPIN(cond, bar) do { unsigned _sp = 0; while (cond) { __builtin_amdgcn_s_sleep(1); \
    if ((++_sp & 255u) == 0u) { if (xb_ld(&(bar)[XB_TMO])) break; if (_sp > XB_SPIN_CAP) { atomicAdd(&(bar)[XB_TMO], 1u); break; } } } } while (0)
__device__ __forceinline__ void xcd_barrier_complete(unsigned* bar, unsigned x, unsigned& nloc, unsigned& nx) {
    const unsigned G = gridDim.x * gridDim.y * gridDim.z;
    unsigned sum, cnt, mine, sp = 0u;
    for (;;) {
        sum = 0u; cnt = 0u; mine = 0u;
#pragma unroll
        for (unsigned j = 0; j < 16; ++j) { const unsigned c = xb_ld(&bar[XB_XCNT(j)]); sum += c; cnt += (c > 0u) ? 1u : 0u; mine = (j == x) ? c : mine; }
        if (sum == G) break;
        __builtin_amdgcn_s_sleep(1);
        if ((++sp & 255u) == 0u) { if (xb_ld(&bar[XB_TMO])) break; if (sp > XB_SPIN_CAP) { atomicAdd(&bar[XB_TMO], 1u); break; } }
    }
    nloc = mine > 0u ? mine : 1u; nx = cnt > 0u ? cnt : 1u;
}
__device__ __forceinline__ void xcd_barrier(unsigned* bar, unsigned x, volatile LAS unsigned* st) {
    asm volatile("s_waitcnt vmcnt(0)" ::: "memory");
    __syncthreads();
    if (threadIdx.x == 0) {
        __builtin_amdgcn_s_waitcnt(0);
        unsigned nloc = st[0], nx = st[1];
        if (nloc == 0u) { xcd_barrier_complete(bar, x, nloc, nx); st[0] = nloc; st[1] = nx; }
        const unsigned old = xb_add(&bar[XB_XSUB(x)], 1u);
        const unsigned gen = old / nloc;
        if (old + 1u == (gen + 1u) * nloc) {
            __builtin_amdgcn_fence(__ATOMIC_RELEASE, "agent");
            asm volatile("s_waitcnt vmcnt(0)" ::: "memory");
            const unsigned og = xb_add(&bar[XB_TOP], 1u);
            const unsigned tg = og / nx;
            if (og + 1u == (tg + 1u) * nx) xb_add(&bar[XB_TOPGEN], 1u);
            else XB_SPIN(xb_ld(&bar[XB_TOPGEN]) == tg, bar);
            __builtin_amdgcn_fence(__ATOMIC_ACQUIRE, "agent");
            xb_add(&bar[XB_XGEN(x)], 1u);
            asm volatile("s_waitcnt vmcnt(0)" ::: "memory");
        } else {
            XB_SPIN(xb_ld(&bar[XB_XGEN(x)]) == gen, bar);
            __builtin_amdgcn_fence(__ATOMIC_ACQUIRE, "agent");
            asm volatile("s_waitcnt vmcnt(0)" ::: "memory");
        }
    }
    __syncthreads();
}

struct Args { const void* in[28]; float* out; unsigned char* ws; int ph_lo, ph_hi; int rep_attn, rep_fin, rep_prep, rep_pad; };

struct Ctx {
    LAS unsigned char* lds; LAS unsigned char* wlds;
    int tid, lane, wave, gw, ngw, G;
    unsigned char* ws;
};
constexpr int PTAB_OFF = 147456 - 256;
__device__ __forceinline__ const void* ldptr(LAS unsigned char* lds, int i) {
    volatile LAS unsigned* t = (volatile LAS unsigned*)(lds + PTAB_OFF) + 2 * i;
    const unsigned lo = __builtin_amdgcn_readfirstlane(t[0]), hi = __builtin_amdgcn_readfirstlane(t[1]);
    return (const void*)(const __attribute__((address_space(1))) unsigned char*)(((unsigned long long)hi << 32) | lo);
}
#define INP_F(i) ((const float*)ldptr(c.lds, (i)))

#define MFMA16(a, b, c) __builtin_amdgcn_mfma_f32_16x16x32_bf16((a), (b), (c), 0, 0, 0)

__device__ __forceinline__ void tr_item(const float* W, int K, int N, int nblk, bf16_t* WT, int mode, LAS float* scr, int item, int lane) {
    const int kb = item / nblk, nb = item % nblk, k0 = 64 * kb, n0 = 32 * nb;
    const int nn = n0 + (lane & 31);
#pragma unroll 8
    for (int i = 0; i < 32; ++i) { const int kk = 2 * i + (lane >> 5); scr[kk * 33 + (lane & 31)] = (nn < N) ? W[(size_t)(k0 + kk) * N + nn] : 0.f; }
    LDS_WAIT();
    const int row_off = mode == 0 ? 0 : ((n0 >> 7) * 128 + (mode == 2 ? 128 : 0));
    const int c = lane & 7;
#pragma unroll
    for (int j = 0; j < 4; ++j) { const int n = (lane >> 3) + 8 * j; const LAS float* s = scr + (8 * c) * 33 + n;
        u32x4 o; o.x = cvt_pk_bf16(s[0 * 33], s[1 * 33]); o.y = cvt_pk_bf16(s[2 * 33], s[3 * 33]); o.z = cvt_pk_bf16(s[4 * 33], s[5 * 33]); o.w = cvt_pk_bf16(s[6 * 33], s[7 * 33]);
        *(u32x4*)(WT + (size_t)(row_off + n0 + n) * K + k0 + 8 * c) = o; }
    LDS_WAIT();
}

__device__ __forceinline__ void norm_row_to_bf16(const float* xrow, const float* g, bf16_t* orow, int lane) {
    const f32x4* xr = (const f32x4*)xrow + lane; const f32x4* gr = (const f32x4*)g + lane;
    f32x4 v[4]; float s = 0.f;
#pragma unroll
    for (int j = 0; j < 4; ++j) { v[j] = xr[64 * j]; s += (v[j].x * v[j].x + v[j].y * v[j].y) + (v[j].z * v[j].z + v[j].w * v[j].w); }
    const float rs = 1.0f / sqrtf(wave_sum(s) * (1.f / DM) + EPS);
    u32x2* o8 = (u32x2*)orow + lane;
#pragma unroll
    for (int j = 0; j < 4; ++j) { const f32x4 gg = gr[64 * j]; u32x2 w; w.x = cvt_pk_bf16(v[j].x * rs * gg.x, v[j].y * rs * gg.y); w.y = cvt_pk_bf16(v[j].z * rs * gg.z, v[j].w * rs * gg.w); o8[64 * j] = w; }
}

constexpr int TR_BIG = 1408, TR_PER_LAYER = 6 * 1408 + 1152 + 512 + 8 + 16 + 128, TR_TOTAL = DEPTH * TR_PER_LAYER;

__device__ __forceinline__ void p0_prologue(const Ctx& c) {
    LAS float* scr = (LAS float*)c.wlds;
    unsigned char* ws = c.ws;
    for (int it = c.gw; it < TR_TOTAL; it += c.ngw) {
        const int l = it / TR_PER_LAYER; int r = it % TR_PER_LAYER;
        const float* src; bf16_t* dst; int K, N, nblk, mode = 0;
        if (r < 4 * TR_BIG) { const int q = r / TR_BIG; r -= q * TR_BIG; const int which = q >> 1, isup = q & 1;
            src = INP_F(which ? (isup ? 26 : 25) : (isup ? 5 : 4)) + (size_t)l * DM * FF; dst = (bf16_t*)(ws + WS_WGU + (size_t)(l * 2 + which) * SZ_WGU); K = DM; N = FF; nblk = FF / 32; mode = 1 + isup; }
        else if (r < 6 * TR_BIG) { r -= 4 * TR_BIG; const int which = r / TR_BIG; r -= which * TR_BIG;
            src = INP_F(which ? 27 : 6) + (size_t)l * DM * FF; dst = (bf16_t*)(ws + WS_WDN + (size_t)(l * 2 + which) * SZ_WDN); K = FF; N = DM; nblk = DM / 32; }
        else if (r < 6 * TR_BIG + 1152) { r -= 6 * TR_BIG; src = INP_F(9) + (size_t)l * DM * INC; dst = (bf16_t*)(ws + WS_WIN + (size_t)l * SZ_WIN); K = DM; N = INC; nblk = INP / 32; }
        else if (r < 6 * TR_BIG + 1152 + 512) { r -= 6 * TR_BIG + 1152; src = INP_F(10) + (size_t)l * DM * DM; dst = (bf16_t*)(ws + WS_WOUT + (size_t)l * SZ_WOUT); K = DM; N = DM; nblk = DM / 32; }
        else if (r < 6 * TR_BIG + 1152 + 512 + 8) { r -= 6 * TR_BIG + 1152 + 512; const int g = r >> 1; r &= 1;
            src = INP_F(11) + (size_t)(l * 4 + g) * 4096; dst = (bf16_t*)(ws + WS_WPOOL) + (size_t)(l * 4 + g) * 4096; K = 64; N = 64; nblk = 2; }
        else if (r < 6 * TR_BIG + 1152 + 512 + 8 + 16) { r -= 6 * TR_BIG + 1152 + 512 + 8; const int q = r >> 1; r &= 1; const int ri = q >> 2, h = q & 3;
            src = INP_F(ri ? 17 : 15) + (size_t)(l * 4 + h) * 4096; dst = (bf16_t*)(ws + WS_WLRU) + (size_t)((l * 2 + ri) * 4 + h) * 4096; K = 64; N = 64; nblk = 2; }
        else { r -= 6 * TR_BIG + 1152 + 512 + 8 + 16; const int kv = r >> 6; r &= 63;
            src = INP_F(kv ? 21 : 20) + (size_t)l * 2048 * 64; dst = (bf16_t*)(ws + WS_WCMP) + (size_t)(l * 2 + kv) * 64 * 2048; K = 2048; N = 64; nblk = 2; }
        tr_item(src, K, N, nblk, dst, mode, scr, r, c.lane);
    }
    {
        const int* pos = (const int*)ldptr(c.lds, 1); float* ct = (float*)(ws + WS_COS); float* st = (float*)(ws + WS_SIN);
        for (int e = c.gw * 64 + c.lane; e < M * 32; e += c.ngw * 64) {
            const int m = e >> 5, i = e & 31;
            const float inv = powf(10000.0f, -(float)(2 * i) / 64.0f);
            const float ang = (float)pos[m] * inv;
            const double ad = (double)ang; const double k = rint(ad * 0.15915494309189535); const float rr = (float)(ad - k * 6.283185307179586);
            ct[e] = cosf(rr); st[e] = sinf(rr);
        }
    }
    const float* x0 = INP_F(0); const float* g0 = INP_F(2);
    for (int m = c.gw; m < M; m += c.ngw) norm_row_to_bf16(x0 + (size_t)m * DM, g0, (bf16_t*)(ws + WS_A) + (size_t)m * DM, c.lane);
}

__device__ __forceinline__ void rowpass(const Ctx& c, const float* hin, float* hout, const bf16_t* f, const float* gpost, float coef, const float* gnext, bf16_t* aout) {
    const int lane = c.lane;
    for (int m = c.gw; m < M; m += c.ngw) {
        const u32x2* fr = (const u32x2*)(f + (size_t)m * DM) + lane;
        const f32x4* hr = (const f32x4*)(hin + (size_t)m * DM) + lane;
        f32x4 fv[4], hv[4]; float s = 0.f;
#pragma unroll
        for (int j = 0; j < 4; ++j) { const u32x2 w = fr[64 * j]; fv[j] = (f32x4){bflo(w.x), bfhi(w.x), bflo(w.y), bfhi(w.y)}; hv[j] = hr[64 * j];
            s += (fv[j].x * fv[j].x + fv[j].y * fv[j].y) + (fv[j].z * fv[j].z + fv[j].w * fv[j].w); }
        const float rs = coef / sqrtf(wave_sum(s) * (1.f / DM) + EPS);
        float s2 = 0.f;
#pragma unroll
        for (int j = 0; j < 4; ++j) { const f32x4 gg = ((const f32x4*)gpost + lane)[64 * j]; hv[j] = hv[j] + fv[j] * rs * gg;
            s2 += (hv[j].x * hv[j].x + hv[j].y * hv[j].y) + (hv[j].z * hv[j].z + hv[j].w * hv[j].w); }
        f32x4* ho = (f32x4*)(hout + (size_t)m * DM) + lane;
#pragma unroll
        for (int j = 0; j < 4; ++j) ho[64 * j] = hv[j];
        if (gnext) {
            const float rs2 = 1.0f / sqrtf(wave_sum(s2) * (1.f / DM) + EPS);
            u32x2* o8 = (u32x2*)(aout + (size_t)m * DM) + lane;
#pragma unroll
            for (int j = 0; j < 4; ++j) { const f32x4 gg = ((const f32x4*)gnext + lane)[64 * j]; u32x2 w; w.x = cvt_pk_bf16(hv[j].x * rs2 * gg.x, hv[j].y * rs2 * gg.y); w.y = cvt_pk_bf16(hv[j].z * rs2 * gg.z, hv[j].w * rs2 * gg.w); o8[64 * j] = w; }
        }
    }
}

__device__ __forceinline__ void unpack8(const bf16x8 v, float* f) {
    const u32x4 w = __builtin_bit_cast(u32x4, v);
    f[0] = bflo(w.x); f[1] = bfhi(w.x); f[2] = bflo(w.y); f[3] = bfhi(w.y); f[4] = bflo(w.z); f[5] = bfhi(w.z); f[6] = bflo(w.w); f[7] = bfhi(w.w);
}
__device__ __forceinline__ bf16x8 pack8(const float* f) {
    u32x4 w; w.x = cvt_pk_bf16(f[0], f[1]); w.y = cvt_pk_bf16(f[2], f[3]); w.z = cvt_pk_bf16(f[4], f[5]); w.w = cvt_pk_bf16(f[6], f[7]);
    return __builtin_bit_cast(bf16x8, w);
}

__device__ __forceinline__ void rope_unit(const Ctx& c, int tile) {
    const bf16_t* proj = (const bf16_t*)(c.ws + WS_HID); bf16_t* Qr = (bf16_t*)(c.ws + WS_QR);
    const float* ct = (const float*)(c.ws + WS_COS); const float* st = (const float*)(c.ws + WS_SIN);
    const int lane = c.lane, i0 = (lane & 7) * 4;
    for (int tt = 0; tt < 16; ++tt) {
        const int tg = tile * 16 + tt; const int b = tg / SEQ, t = tg % SEQ;
        const f32x4 cs = *(const f32x4*)(ct + (size_t)tg * 32 + i0), sn = *(const f32x4*)(st + (size_t)tg * 32 + i0);
        {
            const int head = lane >> 3; const bf16_t* src = proj + (size_t)tg * INP + C_Q + head * 64 + i0;
            const u32x2 a = *(const u32x2*)src, bb = *(const u32x2*)(src + 32);
            const f32x4 x1 = (f32x4){bflo(a.x), bfhi(a.x), bflo(a.y), bfhi(a.y)}, x2 = (f32x4){bflo(bb.x), bfhi(bb.x), bflo(bb.y), bfhi(bb.y)};
            const f32x4 o1 = (x1 * cs - x2 * sn) * QSCALE, o2 = (x2 * cs + x1 * sn) * QSCALE;
            bf16_t* dst = Qr + (size_t)tg * 512 + head * 64 + i0;
            u32x2 w; w.x = cvt_pk_bf16(o1.x, o1.y); w.y = cvt_pk_bf16(o1.z, o1.w); *(u32x2*)dst = w;
            w.x = cvt_pk_bf16(o2.x, o2.y); w.y = cvt_pk_bf16(o2.z, o2.w); *(u32x2*)(dst + 32) = w;
        }
        if (lane < 32) {
            const int arr = lane >> 4, kvh = (lane >> 3) & 1; const bf16_t* src = proj + (size_t)tg * INP + (arr ? C_KW : C_KS) + kvh * 64 + i0;
            const u32x2 a = *(const u32x2*)src, bb = *(const u32x2*)(src + 32);
            const f32x4 x1 = (f32x4){bflo(a.x), bfhi(a.x), bflo(a.y), bfhi(a.y)}, x2 = (f32x4){bflo(bb.x), bfhi(bb.x), bflo(bb.y), bfhi(bb.y)};
            const f32x4 o1 = x1 * cs - x2 * sn, o2 = x2 * cs + x1 * sn;
            bf16_t* dst = (bf16_t*)(c.ws + (arr ? WS_KW : WS_KS)) + ((size_t)(b * 2 + kvh) * SEQ + t) * 64 + i0;
            u32x2 w; w.x = cvt_pk_bf16(o1.x, o1.y); w.y = cvt_pk_bf16(o1.z, o1.w); *(u32x2*)dst = w;
            w.x = cvt_pk_bf16(o2.x, o2.y); w.y = cvt_pk_bf16(o2.z, o2.w); *(u32x2*)(dst + 32) = w;
        }
    }
}
__device__ __forceinline__ void vt_unit(const Ctx& c, int u) {
    const int tile = u & 255, bk = (u >> 8) & 3, arr = u >> 10; const int b = bk >> 1, kvh = bk & 1, t0 = tile * 64;
    const bf16_t* src = (const bf16_t*)(c.ws + WS_HID) + (size_t)(b * SEQ + t0) * INP + (arr ? C_VW : C_VS) + kvh * 64 + c.lane;
    bf16_t* dst = (bf16_t*)(c.ws + (arr ? WS_VWT : WS_VST)) + (((size_t)bk * 256 + tile) * 64 + c.lane) * 64;
#pragma unroll
    for (int q = 0; q < 8; ++q) {
        unsigned w[4];
#pragma unroll
        for (int e = 0; e < 4; ++e) { const unsigned lo = src[(size_t)(q * 8 + 2 * e) * INP], hi = src[(size_t)(q * 8 + 2 * e + 1) * INP]; w[e] = lo | (hi << 16); }
        *(u32x4*)(dst + q * 8) = (u32x4){w[0], w[1], w[2], w[3]};
    }
}
__device__ __forceinline__ void pool_unit(const Ctx& c, int u, int layer, const float* pool_scale) {
    const int gp = u & 3, tile = u >> 2; const int lane = c.lane, r16 = lane & 15, g = lane >> 4;
    const int tg = tile * 16 + r16, b = tg / SEQ, t = tg % SEQ; const int w = 2 << gp;
    const bf16_t* proj = (const bf16_t*)(c.ws + WS_HID);
    const bf16_t* WpT = (const bf16_t*)(c.ws + WS_WPOOL) + (size_t)(layer * 4 + gp) * 4096;
    bf16x8 Df[2];
    const int cnt = (t + 1 < w) ? t + 1 : w; const float icnt = 1.0f / (float)cnt;
#pragma unroll
    for (int ks = 0; ks < 2; ++ks) {
        const bf16_t* p = proj + (size_t)(b * SEQ + t) * INP + C_XP + gp * 64 + ks * 32 + g * 8;
        float sum[8], x0[8];
        unpack8(*(const bf16x8*)p, x0);
#pragma unroll
        for (int e = 0; e < 8; ++e) sum[e] = x0[e];
        for (int s = 1; s < cnt; ++s) { float xv[8]; unpack8(*(const bf16x8*)(p - (size_t)s * INP), xv);
#pragma unroll
            for (int e = 0; e < 8; ++e) sum[e] += xv[e]; }
        float d[8];
#pragma unroll
        for (int e = 0; e < 8; ++e) d[e] = sum[e] * icnt - x0[e];
        Df[ks] = pack8(d);
    }
    bf16_t* out = (bf16_t*)(c.ws + WS_A) + (size_t)tg * DM + gp * 64;
#pragma unroll
    for (int jt = 0; jt < 4; ++jt) {
        f32x4 acc = (f32x4){0.f, 0.f, 0.f, 0.f};
#pragma unroll
        for (int ks = 0; ks < 2; ++ks) { const bf16x8 wf = *(const bf16x8*)(WpT + (size_t)(16 * jt + r16) * 64 + ks * 32 + g * 8); acc = MFMA16(wf, Df[ks], acc); }
        const f32x4 sc = *(const f32x4*)(pool_scale + gp * 64 + 16 * jt + 4 * g);
        u32x2 o; o.x = cvt_pk_bf16(acc[0] * sc[0], acc[1] * sc[1]); o.y = cvt_pk_bf16(acc[2] * sc[2], acc[3] * sc[3]);
        *(u32x2*)(out + 16 * jt + 4 * g) = o;
    }
}
__device__ __forceinline__ void lru_unit(const Ctx& c, int u, int layer, const float* conv_w, const float* conv_b, const float* b_r, const float* b_i, const float* lam) {
    const int hh = u & 3, ch = (u >> 2) % LRU_NCH, b = (u >> 2) / LRU_NCH;
    const int lane = c.lane, r16 = lane & 15, g = lane >> 4;
    const bf16_t* proj = (const bf16_t*)(c.ws + WS_HID);
    const bf16_t* WrT = (const bf16_t*)(c.ws + WS_WLRU) + (size_t)((layer * 2 + 0) * 4 + hh) * 4096;
    const bf16_t* WiT = (const bf16_t*)(c.ws + WS_WLRU) + (size_t)((layer * 2 + 1) * 4 + hh) * 4096;
    float* HL = (float*)(c.ws + WS_F); float* CA = HL + (size_t)M * 256;
    float n8sp[4][4], hcar[4][4], acar[4][4];
#pragma unroll
    for (int jt = 0; jt < 4; ++jt)
#pragma unroll
        for (int jj = 0; jj < 4; ++jj) { const float L = lam[hh * 64 + 16 * jt + 4 * g + jj]; n8sp[jt][jj] = -8.0f * log1pf(__expf(-L)); hcar[jt][jj] = 0.f; acar[jt][jj] = 1.f; }
    for (int tile = 0; tile < LRU_CHUNK / 16; ++tile) {
        const int t = ch * LRU_CHUNK + tile * 16 + r16; const size_t tg = (size_t)b * SEQ + t;
        bf16x8 Xf[2];
#pragma unroll
        for (int ks = 0; ks < 2; ++ks) {
            const int c0 = hh * 64 + ks * 32 + g * 8; float acc8[8];
            { const f32x4 b0 = *(const f32x4*)(conv_b + c0), b1 = *(const f32x4*)(conv_b + c0 + 4); acc8[0] = b0[0]; acc8[1] = b0[1]; acc8[2] = b0[2]; acc8[3] = b0[3]; acc8[4] = b1[0]; acc8[5] = b1[1]; acc8[6] = b1[2]; acc8[7] = b1[3]; }
#pragma unroll
            for (int k = 0; k < 4; ++k) { const int tt = t - 3 + k;
                if (tt >= 0) { float xv[8]; unpack8(*(const bf16x8*)(proj + ((size_t)b * SEQ + tt) * INP + C_XL + c0), xv);
                    const f32x4 w0 = *(const f32x4*)(conv_w + k * 256 + c0), w1 = *(const f32x4*)(conv_w + k * 256 + c0 + 4);
                    acc8[0] += w0[0] * xv[0]; acc8[1] += w0[1] * xv[1]; acc8[2] += w0[2] * xv[2]; acc8[3] += w0[3] * xv[3];
                    acc8[4] += w1[0] * xv[4]; acc8[5] += w1[1] * xv[5]; acc8[6] += w1[2] * xv[6]; acc8[7] += w1[3] * xv[7]; } }
            Xf[ks] = pack8(acc8);
        }
#pragma unroll
        for (int jt = 0; jt < 4; ++jt) {
            f32x4 aR = (f32x4){0.f, 0.f, 0.f, 0.f}, aI = (f32x4){0.f, 0.f, 0.f, 0.f};
#pragma unroll
            for (int ks = 0; ks < 2; ++ks) { const size_t wo = (size_t)(16 * jt + r16) * 64 + ks * 32 + g * 8;
                aR = MFMA16(*(const bf16x8*)(WrT + wo), Xf[ks], aR); aI = MFMA16(*(const bf16x8*)(WiT + wo), Xf[ks], aI); }
            const int c4 = hh * 64 + 16 * jt + 4 * g;
            f32x4 xc = *(const f32x4*)(conv_b + c4);
#pragma unroll
            for (int k = 0; k < 4; ++k) { const int tt = t - 3 + k;
                if (tt >= 0) { const u32x2 xw = *(const u32x2*)(proj + ((size_t)b * SEQ + tt) * INP + C_XL + c4); const f32x4 w4 = *(const f32x4*)(conv_w + k * 256 + c4);
                    xc[0] += w4[0] * bflo(xw.x); xc[1] += w4[1] * bfhi(xw.x); xc[2] += w4[2] * bflo(xw.y); xc[3] += w4[3] * bfhi(xw.y); } }
            const f32x4 br4 = *(const f32x4*)(b_r + c4), bi4 = *(const f32x4*)(b_i + c4);
            f32x4 hv, cv;
#pragma unroll
            for (int jj = 0; jj < 4; ++jj) {
                const float r = sigmoidf_(aR[jj] + br4[jj]), ii = sigmoidf_(aI[jj] + bi4[jj]);
                const float la = n8sp[jt][jj] * r; float av = __expf(la); float bv = sqrtf(fmaxf(-expm1f(2.0f * la), 0.f)) * (ii * xc[jj]);
#pragma unroll
                for (int d = 1; d < 16; d <<= 1) { const float ap = __shfl_up(av, d, 16), bp = __shfl_up(bv, d, 16); if (r16 >= d) { bv = av * bp + bv; av = av * ap; } }
                const float h = av * hcar[jt][jj] + bv, ca = av * acar[jt][jj];
                hv[jj] = h; cv[jj] = ca;
                hcar[jt][jj] = __shfl(h, 15, 16); acar[jt][jj] = __shfl(ca, 15, 16);
            }
            *(f32x4*)(HL + tg * 256 + c4) = hv; *(f32x4*)(CA + tg * 256 + c4) = cv;
        }
    }
    if (r16 == 15) {
        float* carA = (float*)(c.ws + WS_CARA) + (size_t)(b * LRU_NCH + ch) * 256; float* carH = (float*)(c.ws + WS_CARH) + (size_t)(b * LRU_NCH + ch) * 256;
#pragma unroll
        for (int jt = 0; jt < 4; ++jt) { const int c4 = hh * 64 + 16 * jt + 4 * g;
            *(f32x4*)(carA + c4) = (f32x4){acar[jt][0], acar[jt][1], acar[jt][2], acar[jt][3]}; *(f32x4*)(carH + c4) = (f32x4){hcar[jt][0], hcar[jt][1], hcar[jt][2], hcar[jt][3]}; }
    }
}
__device__ __forceinline__ void cmp_unit(const Ctx& c, int u, int layer, const float* pe) {
    const int nt_ = u & 63, bk = (u >> 6) & 3, kv = u >> 8; const int b = bk >> 1, kvh = bk & 1;
    const int lane = c.lane, r16 = lane & 15, g = lane >> 4;
    const bf16_t* proj = (const bf16_t*)(c.ws + WS_HID);
    const bf16_t* WT = (const bf16_t*)(c.ws + WS_WCMP) + (size_t)(layer * 2 + kv) * 64 * 2048;
    const float* ct = (const float*)(c.ws + WS_COS); const float* st = (const float*)(c.ws + WS_SIN);
    const int n = nt_ * 16 + r16; const int colb = (kv ? C_VC : C_KC) + kvh * 64;
    f32x4 acc[4];
#pragma unroll
    for (int e = 0; e < 4; ++e) acc[e] = (f32x4){0.f, 0.f, 0.f, 0.f};
    for (int l = 0; l < 32; ++l) {
        int t = 16 * n + l; if (t > SEQ - 1) t = SEQ - 1;
        const size_t tg = (size_t)b * SEQ + t;
        float x1[8], x2[8];
        unpack8(*(const bf16x8*)(proj + tg * INP + colb + g * 8), x1); unpack8(*(const bf16x8*)(proj + tg * INP + colb + 32 + g * 8), x2);
        float o1[8], o2[8];
        if (kv == 0) {
            const f32x4 c0 = *(const f32x4*)(ct + tg * 32 + g * 8), c1 = *(const f32x4*)(ct + tg * 32 + g * 8 + 4), s0 = *(const f32x4*)(st + tg * 32 + g * 8), s1 = *(const f32x4*)(st + tg * 32 + g * 8 + 4);
#pragma unroll
            for (int e = 0; e < 8; ++e) { const float cc = e < 4 ? c0[e & 3] : c1[e & 3], ss = e < 4 ? s0[e & 3] : s1[e & 3]; o1[e] = x1[e] * cc - x2[e] * ss; o2[e] = x2[e] * cc + x1[e] * ss; }
        } else {
#pragma unroll
            for (int e = 0; e < 8; ++e) { o1[e] = x1[e]; o2[e] = x2[e]; }
        }
        { const f32x4 p0 = *(const f32x4*)(pe + l * 64 + g * 8), p1 = *(const f32x4*)(pe + l * 64 + g * 8 + 4), p2 = *(const f32x4*)(pe + l * 64 + 32 + g * 8), p3 = *(const f32x4*)(pe + l * 64 + 32 + g * 8 + 4);
#pragma unroll
            for (int e = 0; e < 4; ++e) { o1[e] += p0[e]; o1[4 + e] += p1[e]; o2[e] += p2[e]; o2[4 + e] += p3[e]; } }
        const bf16x8 X0 = pack8(o1), X1 = pack8(o2);
#pragma unroll
        for (int et = 0; et < 4; ++et) {
            const bf16_t* wp = WT + (size_t)(16 * et + r16) * 2048 + l * 64 + g * 8;
            const bf16x8 W0 = *(const bf16x8*)wp, W1 = *(const bf16x8*)(wp + 32);
            if (kv == 0) { acc[et] = MFMA16(W0, X0, acc[et]); acc[et] = MFMA16(W1, X1, acc[et]); }
            else         { acc[et] = MFMA16(X0, W0, acc[et]); acc[et] = MFMA16(X1, W1, acc[et]); }
        }
    }
    if (kv == 0) {
        bf16_t* dst = (bf16_t*)(c.ws + WS_KCMP) + ((size_t)bk * 1024 + n) * 64;
        const bool z = (n >= 1023);
#pragma unroll
        for (int et = 0; et < 4; ++et) { u32x2 o; o.x = cvt_pk_bf16(acc[et][0], acc[et][1]); o.y = cvt_pk_bf16(acc[et][2], acc[et][3]); if (z) { o.x = 0u; o.y = 0u; } *(u32x2*)(dst + 16 * et + 4 * g) = o; }
    } else {
        bf16_t* dst = (bf16_t*)(c.ws + WS_VCMPT) + (size_t)bk * 64 * 1024;
        const int nb = nt_ * 16 + 4 * g;
#pragma unroll
        for (int et = 0; et < 4; ++et) { float v3 = acc[et][3]; if (nb + 3 >= 1023) v3 = 0.f; u32x2 o; o.x = cvt_pk_bf16(acc[et][0], acc[et][1]); o.y = cvt_pk_bf16(acc[et][2], v3); *(u32x2*)(dst + ((size_t)(nb >> 6) * 64 + 16 * et + r16) * 64 + (nb & 63)) = o; }
    }
}

constexpr int NU_LRU = BATCH * LRU_NCH * 4, NU_CMP = 512, NU_POOL = (M / 16) * 4, NU_ROPE = M / 16, NU_VT = 2048;
__device__ __forceinline__ void phase_prep(const Ctx& c, int layer) {
    const float* pool_scale = INP_F(12) + layer * 256;
    const float* conv_w = INP_F(13) + layer * 1024; const float* conv_b = INP_F(14) + layer * 256;
    const float* b_r = INP_F(16) + layer * 256; const float* b_i = INP_F(18) + layer * 256; const float* lam = INP_F(19) + layer * 256;
    const float* pe = INP_F(22) + layer * 2048;
    for (int u = c.gw; u < NU_LRU; u += c.ngw) lru_unit(c, u, layer, conv_w, conv_b, b_r, b_i, lam);
    for (int u = c.gw; u < NU_CMP; u += c.ngw) cmp_unit(c, u, layer, pe);
    for (int u = c.gw; u < NU_VT; u += c.ngw) vt_unit(c, u);
    for (int u = c.gw; u < NU_ROPE; u += c.ngw) rope_unit(c, u);
    for (int u = c.gw; u < NU_POOL; u += c.ngw) pool_unit(c, u, layer, pool_scale);
}

constexpr int NCG = 2, QPW = 4 * NCG;
struct AttnRegs { f32x4 O[4][NCG]; float m[NCG], l[NCG]; };

__device__ __forceinline__ void attn_reset(AttnRegs& R) {
#pragma unroll
    for (int md = 0; md < 4; ++md)
#pragma unroll
        for (int cg_ = 0; cg_ < NCG; ++cg_) R.O[md][cg_] = (f32x4){0.f, 0.f, 0.f, 0.f};
#pragma unroll
    for (int cg_ = 0; cg_ < NCG; ++cg_) { R.m[cg_] = -1e30f; R.l[cg_] = 0.f; }
}

constexpr int ATT_SLOT = 32768, ATT_WBASE = 2 * ATT_SLOT, ATT_WLDS = 9216;
#define ATT_BAR() do { asm volatile("s_waitcnt lgkmcnt(0)" ::: "memory"); __builtin_amdgcn_s_barrier(); asm volatile("" ::: "memory"); } while (0)

template <int CTRL> __device__ __forceinline__ int dpp_i(int v) { return __builtin_amdgcn_update_dpp(v, v, CTRL, 0xF, 0xF, false); }
template <int CTRL> __device__ __forceinline__ float dpp_f(float v) { return __int_as_float(dpp_i<CTRL>(__float_as_int(v))); }
__device__ __forceinline__ int row16_sum(int v) { v += dpp_i<0xB1>(v); v += dpp_i<0x4E>(v); v += dpp_i<0x141>(v); v += dpp_i<0x140>(v); return v; }
__device__ __forceinline__ float rowmax4(float x) {
    auto r = __builtin_amdgcn_permlane16_swap(__float_as_uint(x), __float_as_uint(x), false, false);
    const float a = fmaxf(__uint_as_float(r[0]), __uint_as_float(r[1]));
    auto q = __builtin_amdgcn_permlane32_swap(__float_as_uint(a), __float_as_uint(a), false, false);
    return fmaxf(__uint_as_float(q[0]), __uint_as_float(q[1]));
}
__device__ __forceinline__ float rowsum4(float x) {
    auto r = __builtin_amdgcn_permlane16_swap(__float_as_uint(x), __float_as_uint(x), false, false);
    const float a = __uint_as_float(r[0]) + __uint_as_float(r[1]);
    auto q = __builtin_amdgcn_permlane32_swap(__float_as_uint(a), __float_as_uint(a), false, false);
    return __uint_as_float(q[0]) + __uint_as_float(q[1]);
}

template <int MODE, bool MASKED>
__device__ __forceinline__ void attn_tile64(AttnRegs& R, const bf16x8 (&Qf)[NCG][2], LAS unsigned char* slot, int kb0, unsigned act, int tq_base, const unsigned (&selw)[NCG], int bit,
                                            int lane, LAS float* imp, int qi, int hg) {
    const int r16 = lane & 15, g = lane >> 4;
    const int fK = (r16 >> 2) | (((r16 >> 1) & 1) << 2), fV = (r16 >> 1) & 7;
    const int krow = 8 * (r16 >> 2) + (r16 & 3);
    LAS unsigned char* kp0 = slot + krow * 128 + ((g ^ fK) << 4);
    LAS unsigned char* kp1 = slot + krow * 128 + (((4 + g) ^ fK) << 4);
    LAS unsigned char* vp0 = slot + 8192 + r16 * 128 + ((g ^ fV) << 4);
    LAS unsigned char* vp1 = slot + 8192 + r16 * 128 + (((4 + g) ^ fV) << 4);
#pragma unroll
    for (int cg_ = 0; cg_ < NCG; ++cg_) {
        if (!(act & (1u << cg_))) continue;
        float s[16];
#pragma unroll
        for (int half = 0; half < 2; ++half) {
            const bf16x8 k00 = *(const LAS bf16x8*)(kp0 + half * 4096), k01 = *(const LAS bf16x8*)(kp1 + half * 4096);
            const bf16x8 k10 = *(const LAS bf16x8*)(kp0 + half * 4096 + 512), k11 = *(const LAS bf16x8*)(kp1 + half * 4096 + 512);
            f32x4 s0 = (f32x4){0.f, 0.f, 0.f, 0.f}, s1 = (f32x4){0.f, 0.f, 0.f, 0.f};
            s0 = MFMA16(k00, Qf[cg_][0], s0); s1 = MFMA16(k10, Qf[cg_][0], s1);
            s0 = MFMA16(k01, Qf[cg_][1], s0); s1 = MFMA16(k11, Qf[cg_][1], s1);
#pragma unroll
            for (int j = 0; j < 4; ++j) { s[half * 8 + j] = s0[j]; s[half * 8 + 4 + j] = s1[j]; }
        }
        const int tq = tq_base + 4 * cg_;
        if (MASKED) {
#pragma unroll
            for (int i = 0; i < 16; ++i) { const int key = kb0 + 32 * (i >> 3) + 8 * g + (i & 7); bool ok;
                if (MODE == 0) ok = (key <= tq) && (tq - key < 512);
                else if (MODE == 1) ok = (key <= tq);
                else ok = (16 * key + 31 <= tq);
                s[i] = ok ? s[i] : -INFINITY; }
        }
        const bool lane_on = (MODE == 1) ? (((selw[cg_] >> bit) & 1u) != 0u) : true;
        float p[16];
        if (MODE == 2) {
            const float mm = R.m[cg_], il = R.l[cg_];
#pragma unroll
            for (int i = 0; i < 16; ++i) p[i] = fexp2(s[i] - mm) * il;
#pragma unroll
            for (int half = 0; half < 2; ++half) {
                float ps[8];
#pragma unroll
                for (int i = 0; i < 8; ++i) { float v = p[half * 8 + i]; v += dpp_f<0xB1>(v); v += dpp_f<0x4E>(v); ps[i] = v; }
                if (hg == 0) {
                    const int jb = (kb0 + 32 * half + 8 * g) >> 2; LAS float* ip = imp + (4 * cg_ + qi) * 256 + jb;
                    __hip_atomic_fetch_add(ip, (ps[0] + ps[1]) + (ps[2] + ps[3]), __ATOMIC_RELAXED, __HIP_MEMORY_SCOPE_WORKGROUP);
                    if (jb + 1 < 256) __hip_atomic_fetch_add(ip + 1, ps[3] + (ps[4] + ps[5]) + (ps[6] + ps[7]), __ATOMIC_RELAXED, __HIP_MEMORY_SCOPE_WORKGROUP);
                    if (jb + 2 < 256) __hip_atomic_fetch_add(ip + 2, ps[7], __ATOMIC_RELAXED, __HIP_MEMORY_SCOPE_WORKGROUP);
                }
            }
        } else {
            float mx = fmaxf(fmaxf(fmaxf(s[0], s[1]), s[2]), fmaxf(fmaxf(s[3], s[4]), s[5])); mx = fmaxf(fmaxf(mx, s[6]), s[7]);
            float my = fmaxf(fmaxf(fmaxf(s[8], s[9]), s[10]), fmaxf(fmaxf(s[11], s[12]), s[13])); my = fmaxf(fmaxf(my, s[14]), s[15]);
            mx = fmaxf(mx, my);
            if (MODE == 1) mx = lane_on ? mx : -INFINITY;
            mx = rowmax4(mx);
            const float mold = R.m[cg_], mnew = fmaxf(mold, mx);
            if (__builtin_amdgcn_ballot_w64(mnew > mold) != 0ull) {
                const float alpha = fexp2(mold - mnew); R.m[cg_] = mnew; R.l[cg_] *= alpha;
                if (MODE != 3) {
#pragma unroll
                    for (int md = 0; md < 4; ++md) R.O[md][cg_] = R.O[md][cg_] * alpha;
                }
            }
            const float msub = ((MODE == 1) && !lane_on) ? INFINITY : mnew;
            float sum0 = 0.f, sum1 = 0.f;
#pragma unroll
            for (int i = 0; i < 8; ++i) { p[i] = fexp2(s[i] - msub); sum0 += p[i]; p[8 + i] = fexp2(s[8 + i] - msub); sum1 += p[8 + i]; }
            R.l[cg_] += sum0 + sum1;
        }
        if (MODE != 3) {
            const bf16x8 P0 = pack8(p), P1 = pack8(p + 8);
#pragma unroll
            for (int md = 0; md < 4; ++md) { const bf16x8 v0 = *(const LAS bf16x8*)(vp0 + md * 2048), v1 = *(const LAS bf16x8*)(vp1 + md * 2048);
                R.O[md][cg_] = MFMA16(v0, P0, R.O[md][cg_]); R.O[md][cg_] = MFMA16(v1, P1, R.O[md][cg_]); }
        }
    }
}

template <int MODE>
__device__ __forceinline__ void attn_stream(AttnRegs& R, const bf16x8 (&Qf)[NCG][2], LAS unsigned char* ring, const bf16_t* Kg, const bf16_t* Vg, int ldv, int t0, int nt, int tq_base,
                                            LAS unsigned* msk, LAS unsigned* uni, LAS float* imp, int tid, int lane, int qi, int hg) {
    constexpr bool HASV = (MODE != 3);
    const int tq_min_ = __builtin_amdgcn_readfirstlane(tq_base - qi), qb_ = tq_min_ >> 6;
    const int row = tid >> 3, cpos = tid & 7;
    const int cK = cpos ^ (((row >> 3) & 3) | (((row >> 1) & 1) << 2)), cV = cpos ^ ((row >> 1) & 7);
    const unsigned offk = (unsigned)(row * 64 + cK * 8) * 2u, offv = (unsigned)(row * 64 + cV * 8) * 2u;
    typedef const __attribute__((address_space(1))) char gcchar;
    gcchar* gk = (gcchar*)Kg + (size_t)t0 * 8192; gcchar* gv = (gcchar*)Vg + (size_t)t0 * 8192;
    const u32x4 z4 = (u32x4){0u, 0u, 0u, 0u};
    u32x4 ka0 = z4, va0 = z4, ka1 = z4, va1 = z4, kb0 = z4, vb0 = z4, kb1 = z4, vb1 = z4;
    const int ng = (nt + 1) >> 1;
#define ATT_LOADG(G, K0, V0, K1, V1) do { int T0_ = 2 * (G), T1_ = T0_ + 1; T0_ = T0_ < nt ? T0_ : nt - 1; T1_ = T1_ < nt ? T1_ : nt - 1;     \
        K0 = *(const __attribute__((address_space(1))) u32x4*)(gk + (size_t)T0_ * 8192 + offk); if (HASV) V0 = *(const __attribute__((address_space(1))) u32x4*)(gv + (size_t)T0_ * 8192 + offv); \
        K1 = *(const __attribute__((address_space(1))) u32x4*)(gk + (size_t)T1_ * 8192 + offk); if (HASV) V1 = *(const __attribute__((address_space(1))) u32x4*)(gv + (size_t)T1_ * 8192 + offv); } while (0)
#define ATT_STOREG(G, K0, V0, K1, V1) do { LAS unsigned char* ns_ = ring + ((G) & 1) * ATT_SLOT + tid * 16; \
        *(LAS u32x4*)ns_ = K0; if (HASV) *(LAS u32x4*)(ns_ + 8192) = V0; \
        *(LAS u32x4*)(ns_ + 16384) = K1; if (HASV) *(LAS u32x4*)(ns_ + 24576) = V1; } while (0)
    ATT_LOADG(0, ka0, va0, ka1, va1);
    ATT_STOREG(0, ka0, va0, ka1, va1);
    ATT_LOADG(1, ka0, va0, ka1, va1);
    ATT_BAR();
    unsigned selw[NCG];
#pragma unroll
    for (int cg_ = 0; cg_ < NCG; ++cg_) selw[cg_] = 0u;
#define ATT_STEP(I, PK0, PV0, PK1, PV1, WK0, WV0, WK1, WV1) do { \
        ATT_LOADG((I) + 2, PK0, PV0, PK1, PV1); \
        _Pragma("unroll 1") for (int sub_ = 0; sub_ < 2; ++sub_) { \
            if (2 * (I) + sub_ >= nt) break; \
            LAS unsigned char* slot = ring + ((I) & 1) * ATT_SLOT + sub_ * 16384; \
            const int tile = t0 + 2 * (I) + sub_; \
            unsigned act = (1u << NCG) - 1u; int bit = 0; \
            if (MODE == 1) { const int w = tile >> 5; bit = tile & 31; act = 0u; \
                _Pragma("unroll") for (int cg_ = 0; cg_ < NCG; ++cg_) { act |= ((__builtin_amdgcn_readfirstlane(uni[8 + cg_ * 8 + w]) >> bit) & 1u) << cg_; selw[cg_] = msk[(4 * cg_ + qi) * 8 + w]; } } \
            bool masked_; \
            if (MODE == 0) masked_ = (tile == qb_) || (tile == qb_ - 8); \
            else if (MODE == 1) masked_ = (tile == qb_); \
            else masked_ = (16 * (64 * tile + 63) + 31 > tq_min_); \
            (void)masked_; \
            attn_tile64<MODE, true>(R, Qf, slot, tile * 64, act, tq_base, selw, bit, lane, imp, qi, hg); \
        } \
        ATT_STOREG((I) + 1, WK0, WV0, WK1, WV1); \
        ATT_BAR(); } while (0)
    for (int i = 0; i < ng; i += 2) {
        ATT_STEP(i, kb0, vb0, kb1, vb1, ka0, va0, ka1, va1);
        if (i + 1 >= ng) break;
        ATT_STEP(i + 1, ka0, va0, ka1, va1, kb0, vb0, kb1, vb1);
    }
#undef ATT_STEP
#undef ATT_LOADG
#undef ATT_STOREG
}

template <int MODE, bool NORM>
__device__ __forceinline__ void attn_flush(AttnRegs& R, LAS float* ofin, const bf16_t* gp  , bf16_t* outp, int lane) {
#pragma unroll
    for (int cg_ = 0; cg_ < NCG; ++cg_) {
        float sc = sigmoidf_(bf1(gp[(size_t)(4 * cg_) * INP]));
        if (NORM) { const float L = rowsum4(R.l[cg_]); sc = L > 0.f ? sc / L : 0.f; }
#pragma unroll
        for (int md = 0; md < 4; ++md) {
            f32x4 v = R.O[md][cg_] * sc;
            LAS f32x4* slot = (LAS f32x4*)ofin + (md * NCG + cg_) * 64 + lane;
            if (MODE != 0) v = v + *slot;
            if (MODE != 2) *slot = v;
            else { u32x2 o; o.x = cvt_pk_bf16(v[0], v[1]); o.y = cvt_pk_bf16(v[2], v[3]); *(u32x2*)(outp + (size_t)(4 * cg_) * DM + 16 * md) = o; }
        }
    }
}

__device__ __forceinline__ void attn_unit(const Ctx& c, int bk, int qb) {
    int lane_ = c.lane, tid_ = c.tid; asm volatile("" : "+v"(lane_), "+v"(tid_));
    const int lane = lane_, r16 = lane & 15, g = lane >> 4, qi = r16 >> 2, hg = r16 & 3;
    const int b = bk >> 1, kvh = bk & 1;
    const int tq0 = qb * 64 + c.wave * QPW, cur = qb, head = kvh * 4 + hg;
    LAS unsigned char* ring = c.lds;
    LAS unsigned char* wl = c.lds + ATT_WBASE + c.wave * ATT_WLDS;
    unsigned long long wsi_ = (unsigned long long)c.ws; asm volatile("" : "+s"(wsi_)); unsigned char* wsu = (unsigned char*)(__attribute__((address_space(1))) unsigned char*)wsi_;
    LAS float* imp = (LAS float*)wl;
    LAS unsigned* msk = (LAS unsigned*)(wl + 8192);
    LAS unsigned* uni = (LAS unsigned*)(wl + 8192 + 256);
    const bf16_t* proj = (const bf16_t*)(wsu + WS_HID);
    const bf16_t* Qr = (const bf16_t*)(wsu + WS_QR);
    bf16x8 Qf[NCG][2];
#pragma unroll
    for (int cg_ = 0; cg_ < NCG; ++cg_) { const size_t tg = (size_t)b * SEQ + tq0 + 4 * cg_ + qi; const bf16_t* qp = Qr + tg * 512 + head * 64 + g * 8; Qf[cg_][0] = *(const bf16x8*)qp; Qf[cg_][1] = *(const bf16x8*)(qp + 32); }
    const bf16_t* gp = proj + ((size_t)b * SEQ + tq0 + qi) * INP + C_G + head * 3;
    bf16_t* outp = (bf16_t*)(wsu + WS_A) + ((size_t)b * SEQ + tq0 + qi) * DM + 512 + head * 64 + 4 * g;
    AttnRegs R;
    {
#pragma unroll
    for (int i = 0; i < QPW; ++i) ((LAS f32x4*)imp)[i * 64 + lane] = (f32x4){0.f, 0.f, 0.f, 0.f};
    CFENCE();
    {
        const bf16_t* Kc = (const bf16_t*)(wsu + WS_KCMP) + (size_t)bk * 1024 * 64; const bf16_t* Vc = (const bf16_t*)(wsu + WS_VCMPT) + (size_t)bk * 64 * 1024;
        const int ncount = 4 * qb + 3; const int nt = (ncount + 63) >> 6;
        attn_reset(R);
        attn_stream<3>(R, Qf, ring, Kc, Vc, 1024, 0, nt, tq0 + qi, msk, uni, imp, tid_, lane, qi, hg);
#pragma unroll
        for (int cg_ = 0; cg_ < NCG; ++cg_) { const float L = rowsum4(R.l[cg_]); R.l[cg_] = L > 0.f ? 1.0f / L : 0.f; }
        attn_stream<2>(R, Qf, ring, Kc, Vc, 1024, 0, nt, tq0 + qi, msk, uni, imp, tid_, lane, qi, hg);
    }
    LDS_WAIT(); CFENCE();
    }
    {
    if (cur < 16) {
        if (lane < QPW) {
#pragma unroll
            for (int w = 0; w < 8; ++w) { const int lo = 32 * w; unsigned v = 0u; if (cur >= lo) { const int nb = cur - lo + 1; v = nb >= 32 ? 0xFFFFFFFFu : ((1u << nb) - 1u); } msk[lane * 8 + w] = v; }
        }
    } else {
        LAS unsigned short* m16 = (LAS unsigned short*)msk;
        for (int rr = 0; rr < NCG; ++rr) {
            const int qq = 4 * rr + g; int v[16];
#pragma unroll
            for (int i = 0; i < 16; ++i) { const int j = i * 16 + r16; const bool cand = (j <= cur) && (j != 0) && (j != cur) && (j != cur - 1); v[i] = cand ? (int)__float_as_uint(imp[qq * 256 + j]) : -1; }
            int T = 0;
            for (int bitp = 30; bitp >= 0; --bitp) { const int cd = T | (1 << bitp); int cnt = 0;
#pragma unroll
                for (int i = 0; i < 16; ++i) cnt += (v[i] >= cd) ? 1 : 0;
                cnt = row16_sum(cnt);
                if (cnt >= 13) T = cd; }
            int gt = 0;
#pragma unroll
            for (int i = 0; i < 16; ++i) gt += (v[i] > T) ? 1 : 0;
            gt = row16_sum(gt);
            const int need = 13 - gt; int running = 0;
#pragma unroll
            for (int i = 0; i < 16; ++i) { const int j = i * 16 + r16; const bool eq = (v[i] == T);
                const unsigned long long bal = __ballot(eq); const unsigned be = (unsigned)(bal >> (16 * g)) & 0xFFFFu;
                const int rank = running + __popc(be & ((1u << r16) - 1u)); running += __popc(be);
                const bool forced = (j <= cur) && ((j == 0) || (j == cur) || (j == cur - 1));
                const bool sel = (v[i] > T) || (eq && rank < need) || forced;
                const unsigned long long bs = __ballot(sel);
                if (r16 == 0) m16[qq * 16 + i] = (unsigned short)((bs >> (16 * g)) & 0xFFFFu); }
        }
    }
    LDS_WAIT(); CFENCE();
    }
    if (lane < 8) { unsigned u = 0u;
#pragma unroll
        for (int q = 0; q < QPW; ++q) u |= msk[q * 8 + lane];
        uni[lane] = u; }
    if (lane < 8 * NCG) { const int cg_ = lane >> 3, w = lane & 7; unsigned u = 0u;
#pragma unroll
        for (int q = 0; q < 4; ++q) u |= msk[(4 * cg_ + q) * 8 + w];
        uni[8 + lane] = u; }
    LDS_WAIT(); CFENCE();
    attn_flush<0, false>(R, imp, gp + 0, outp, lane);
    {
        const bf16_t* Ks = (const bf16_t*)(wsu + WS_KS) + (size_t)bk * SEQ * 64; const bf16_t* Vs = (const bf16_t*)(wsu + WS_VST) + (size_t)bk * 64 * SEQ;
        {
        attn_reset(R);
        attn_stream<1>(R, Qf, ring, Ks, Vs, SEQ, 0, cur + 1, tq0 + qi, msk, uni, imp, tid_, lane, qi, hg);
        }
        attn_flush<1, true>(R, imp, gp + 1, outp, lane);
    }
    {
        const bf16_t* Kw = (const bf16_t*)(wsu + WS_KW) + (size_t)bk * SEQ * 64; const bf16_t* Vw = (const bf16_t*)(wsu + WS_VWT) + (size_t)bk * 64 * SEQ;
        int t0 = qb - 8; if (t0 < 0) t0 = 0;
        {
        attn_reset(R);
        attn_stream<0>(R, Qf, ring, Kw, Vw, SEQ, t0, qb - t0 + 1, tq0 + qi, msk, uni, imp, tid_, lane, qi, hg);
        }
        attn_flush<2, true>(R, imp, gp + 2, outp, lane);
    }
    LDS_WAIT(); CFENCE();
}

__device__ __forceinline__ void lru_fin_unit(const Ctx& c, int u) {
    const int hh = u & 3, ch = (u >> 2) % LRU_NCH, b = (u >> 2) / LRU_NCH; const int chn = hh * 64 + c.lane;
    const float* carA = (const float*)(c.ws + WS_CARA) + (size_t)b * LRU_NCH * 256 + chn; const float* carH = (const float*)(c.ws + WS_CARH) + (size_t)b * LRU_NCH * 256 + chn;
    float h = 0.f;
    for (int k = 0; k < ch; ++k) h = carA[k * 256] * h + carH[k * 256];
    const float* HL = (const float*)(c.ws + WS_F); const float* CA = HL + (size_t)M * 256;
    const bf16_t* proj = (const bf16_t*)(c.ws + WS_HID); bf16_t* out = (bf16_t*)(c.ws + WS_A);
    const size_t tg0 = (size_t)b * SEQ + ch * LRU_CHUNK;
#pragma unroll 4
    for (int t = 0; t < LRU_CHUNK; ++t) { const size_t tg = tg0 + t;
        const float hv = HL[tg * 256 + chn] + CA[tg * 256 + chn] * h; const float x = bf1(proj[tg * INP + C_GL + chn]);
        const float u3 = 0.7978845608028654f * (x + 0.044715f * x * x * x); const float th = 1.0f - 2.0f / (1.0f + __expf(2.0f * u3));
        const float y = hv * (0.5f * x * (1.0f + th));
        out[tg * DM + 256 + chn] = (bf16_t)(cvt_pk_bf16(y, 0.f) & 0xffffu); }
}

constexpr int NU_ATT = (SEQ / QPW) * 4;
__device__ __forceinline__ void phase_attn_units(const Ctx& c) {
    for (int p2 = (c.gw / NWAVES) * 2; p2 < 1024; p2 += c.G * 2) { const int p = p2 >> 1;
        for (int r = 0; r < 2; ++r) { const int bk = p & 3, ql = p >> 2; attn_unit(c, bk, r ? 255 - ql : ql); } }
    __syncthreads();
}
__device__ __forceinline__ void phase_attn_fin(const Ctx& c) {
    for (int u = c.gw; u < NU_LRU; u += c.ngw) lru_fin_unit(c, u);
}
__device__ __forceinline__ void phase_attn(const Ctx& c) {
    phase_attn_units(c);
    phase_attn_fin(c);
}

constexpr int N_PHASES = 1 + 11 * DEPTH;
__global__ void __launch_bounds__(NTHREADS, 2) fwd_kernel(Args args) {
    extern __shared__ __attribute__((aligned(16))) unsigned char lds_raw[];
    {
        LAS unsigned long long* tab = (LAS unsigned long long*)((LAS unsigned char*)lds_raw + PTAB_OFF);
        if (threadIdx.x < 28) tab[threadIdx.x] = (unsigned long long)args.in[threadIdx.x];
        if (threadIdx.x == 28) tab[28] = (unsigned long long)args.out;
        if (threadIdx.x == 29) tab[29] = (unsigned long long)args.ws;

        if (threadIdx.x == 0) (void)xb_add((unsigned*)(args.ws + WS_CTL) + XB_XCNT(xb_xcc_id()), 1u);
        if (threadIdx.x == 30) tab[30] = (unsigned long long)(unsigned)args.rep_attn | ((unsigned long long)(unsigned)args.rep_fin << 32);
        if (threadIdx.x == 31) tab[31] = 0ull;
        __syncthreads();
    }
    const int ph_lo = args.ph_lo, ph_hi = args.ph_hi;
    const int wave_s = __builtin_amdgcn_readfirstlane(threadIdx.x >> 6);
    using namespace pg8;
    for (int ph = ph_lo; ph < ph_hi; ++ph) {
        Ctx c;
        int tid = threadIdx.x; asm volatile("" : "+v"(tid));
        int bid = blockIdx.x; asm volatile("" : "+s"(bid));
        unsigned ldsb = (unsigned)(size_t)(LAS unsigned char*)lds_raw; asm volatile("" : "+s"(ldsb));
        c.lds = (LAS unsigned char*)(size_t)ldsb; c.tid = tid; c.lane = tid & 63; c.wave = __builtin_amdgcn_readfirstlane(tid >> 6);
        c.G = gridDim.x; c.gw = bid * NWAVES + c.wave; c.ngw = c.G * NWAVES;
        c.wlds = c.lds + c.wave * WAVE_LDS;
        unsigned char* ws = (unsigned char*)ldptr(c.lds, 29); c.ws = ws;
        float* outp = (float*)ldptr(c.lds, 28);
        if (ph == 0) {
#ifndef NO_P0
            p0_prologue(c);
#endif
        } else {
            const int l = (ph - 1) / 11, s = (ph - 1) % 11;
            if (s == 0 || s == 8) {
                const int which = s == 8; Gemm g{(const bf16_t*)(ws + WS_A), (const bf16_t*)(ws + WS_WGU + (size_t)(l * 2 + which) * SZ_WGU), M, NGU, DM};
                StaticOrder S; S.init(M, NGU, c.G, bid); EpiSwiGLU E{(bf16_t*)(ws + WS_HID)};
                gemm_phase<EpiSwiGLU, StaticOrder, true, true>(c.lds, g, S, E, tid);
            } else if (s == 1 || s == 9 || s == 3 || s == 6) {
                const bf16_t* A; const bf16_t* Bt; bf16_t* O; int N, K;
                if (s == 3) { A = (const bf16_t*)(ws + WS_A); Bt = (const bf16_t*)(ws + WS_WIN + (size_t)l * SZ_WIN); O = (bf16_t*)(ws + WS_HID); N = INP; K = DM; }
                else if (s == 6) { A = (const bf16_t*)(ws + WS_A); Bt = (const bf16_t*)(ws + WS_WOUT + (size_t)l * SZ_WOUT); O = (bf16_t*)(ws + WS_F); N = DM; K = DM; }
                else { A = (const bf16_t*)(ws + WS_HID); Bt = (const bf16_t*)(ws + WS_WDN + (size_t)(l * 2 + (s == 9)) * SZ_WDN); O = (bf16_t*)(ws + WS_F); N = DM; K = FF; }
                Gemm g{A, Bt, M, N, K};
                StaticOrder S; S.init(M, N, c.G, bid); EpiStore E{O, N};
                gemm_phase<EpiStore, StaticOrder, true, true>(c.lds, g, S, E, tid);
            } else if (s == 4) {
#ifndef NO_PREP
                phase_prep(c, l);
#endif
            } else if (s == 5) {
#ifndef NO_ATTN
                phase_attn(c);
#endif
            } else {
                const float* hin = (s == 2 && l == 0) ? INP_F(0) : outp;
                const float* gpost = INP_F(s == 2 ? 3 : (s == 7 ? 8 : 24)) + l * DM;
                const float* gnext = s == 2 ? INP_F(7) + l * DM : (s == 7 ? INP_F(23) + l * DM : ((l + 1 < DEPTH) ? INP_F(2) + (l + 1) * DM : nullptr));
                rowpass(c, hin, outp, (const bf16_t*)(ws + WS_F), gpost, s == 7 ? 1.0f : 0.5f, gnext, (bf16_t*)(ws + WS_A));
            }
        }
        if (ph + 1 < ph_hi) {
            if (ph == ph_lo) cg::this_grid().sync();
            else xcd_barrier((unsigned*)(ws + WS_CTL), xb_xcc_id(), (volatile LAS unsigned*)(c.lds + PTAB_OFF + 248));
        }
    }
}

extern "C" void kernel_launch(void* const* d_in, const int* in_sizes, int n_in, void* d_out, int out_size, void* d_ws, size_t ws_size, hipStream_t stream) {
    static int grid = 0;
    if (grid == 0) {
        if (n_in != 28 || out_size != M * DM || ws_size < WS_END) { fprintf(stderr, "kernel_launch: unexpected shapes (n_in %d out %d ws %zu need %zu)\n", n_in, out_size, ws_size, (size_t)WS_END); grid = -1; return; }
        int dev = 0, cus = 0, per_cu = 0;
        hipGetDevice(&dev); hipDeviceGetAttribute(&cus, hipDeviceAttributeMultiprocessorCount, dev);
        if (hipFuncSetAttribute((const void*)fwd_kernel, hipFuncAttributeMaxDynamicSharedMemorySize, LDS_BYTES) != hipSuccess) { fprintf(stderr, "kernel_launch: hipFuncSetAttribute failed\n"); grid = -1; return; }
        if (hipOccupancyMaxActiveBlocksPerMultiprocessor(&per_cu, (const void*)fwd_kernel, NTHREADS, LDS_BYTES) != hipSuccess || per_cu < 1) { fprintf(stderr, "kernel_launch: occupancy query says %d\n", per_cu); per_cu = 1; }
        (void)hipGetLastError();
        grid = cus * per_cu;
        fprintf(stderr, "kernel_launch: grid %d (cus %d x %d)\n", grid, cus, per_cu);
    }
    if (grid < 0) return;
    if (hipMemsetAsync((char*)d_ws + WS_CTL, 0, CTL_BYTES, stream) != hipSuccess) { fprintf(stderr, "kernel_launch: memset failed\n"); return; }
    Args a{};
    for (int i = 0; i < 28; ++i) a.in[i] = d_in[i];
    a.out = (float*)d_out; a.ws = (unsigned char*)d_ws;
#ifndef REP_ATTN
#define REP_ATTN 1
#endif
#ifndef REP_FIN
#define REP_FIN 1
#endif
#ifndef REP_PREP
#define REP_PREP 0
#endif
    a.rep_attn = REP_ATTN; a.rep_fin = REP_FIN; a.rep_prep = REP_PREP; a.rep_pad = 0;
#if N_LAUNCH_MODE == 1
    a.ph_lo = 0; a.ph_hi = N_PHASES;
    void* kargs[] = {&a};
    hipError_t e = hipLaunchCooperativeKernel((const void*)fwd_kernel, dim3(grid), dim3(NTHREADS), kargs, LDS_BYTES, stream);
    if (e != hipSuccess) fprintf(stderr, "cooperative launch failed: %s (grid %d)\n", hipGetErrorString(e), grid);
#else
    for (int ph = 0; ph < N_PHASES; ++ph) {
        a.ph_lo = ph; a.ph_hi = ph + 1;
        hipLaunchKernelGGL(fwd_kernel, dim3(grid), dim3(NTHREADS), LDS_BYTES, stream, a);
    }
#endif
}
```

```cpp
#include <hip/hip_runtime.h>
#include <hip/hip_cooperative_groups.h>
#include <cstdio>
#include <cstdint>
namespace cg = cooperative_groups;

#define LAS __attribute__((address_space(3)))
typedef unsigned short bf16_t;
typedef short bf16x8 __attribute__((ext_vector_type(8)));
typedef float f32x4 __attribute__((ext_vector_type(4)));
typedef float f32x2 __attribute__((ext_vector_type(2)));
typedef unsigned u32x4 __attribute__((ext_vector_type(4)));
typedef unsigned u32x2 __attribute__((ext_vector_type(2)));

#ifndef N_LAUNCH_MODE
#define N_LAUNCH_MODE 1
#endif

constexpr int BATCH = 2, SEQ = 16384, DM = 1024, M = BATCH * SEQ, FF = 2816, NGU = 2 * FF, DEPTH = 2;
constexpr int INC = 2072, INP = 2304;
constexpr int C_XP = 0, C_XL = 256, C_GL = 512, C_Q = 768, C_KC = 1280, C_VC = 1408, C_KS = 1536, C_VS = 1664, C_KW = 1792, C_VW = 1920, C_G = 2048;
constexpr float EPS = 1e-6f;
constexpr float QSCALE = 0.125f * 1.4426950408889634f;
constexpr int NWAVES = 8, NTHREADS = 512;
constexpr int LRU_CHUNK = 128, LRU_NCH = SEQ / LRU_CHUNK;

constexpr size_t SZ_WGU = (size_t)NGU * DM * 2, SZ_WDN = (size_t)DM * FF * 2, SZ_WIN = (size_t)INP * DM * 2, SZ_WOUT = (size_t)DM * DM * 2;
constexpr size_t WS_WGU = 0;
constexpr size_t WS_WDN = WS_WGU + 4 * SZ_WGU;
constexpr size_t WS_WIN = WS_WDN + 4 * SZ_WDN;
constexpr size_t WS_WOUT = WS_WIN + 2 * SZ_WIN;
constexpr size_t WS_WPOOL = WS_WOUT + 2 * SZ_WOUT;
constexpr size_t WS_WLRU = WS_WPOOL + 2 * 4 * 4096 * 2;
constexpr size_t WS_WCMP = WS_WLRU + 2 * 2 * 4 * 4096 * 2;
constexpr size_t WS_COS = WS_WCMP + 2 * 2 * 64 * 2048 * 2;
constexpr size_t WS_SIN = WS_COS + (size_t)M * 32 * 4;
constexpr size_t WS_A = WS_SIN + (size_t)M * 32 * 4;
constexpr size_t WS_HID = WS_A + (size_t)M * DM * 2;
constexpr size_t WS_QR = WS_HID + (size_t)M * INP * 2;
constexpr size_t WS_F = WS_HID + (size_t)M * FF * 2;
constexpr size_t WS_KS = WS_F + (size_t)M * DM * 2;
constexpr size_t WS_KW = WS_KS + (size_t)4 * SEQ * 64 * 2;
constexpr size_t WS_VST = WS_KW + (size_t)4 * SEQ * 64 * 2;
constexpr size_t WS_VWT = WS_VST + (size_t)4 * SEQ * 64 * 2;
constexpr size_t WS_KCMP = WS_VWT + (size_t)4 * SEQ * 64 * 2;
constexpr size_t WS_VCMPT = WS_KCMP + (size_t)4 * 1024 * 64 * 2;
constexpr size_t WS_CARA = WS_VCMPT + (size_t)4 * 1024 * 64 * 2;
constexpr size_t WS_CARH = WS_CARA + (size_t)BATCH * LRU_NCH * 256 * 4;
constexpr size_t WS_CTL = WS_CARH + (size_t)BATCH * LRU_NCH * 256 * 4;
constexpr size_t CTL_BYTES = 65536;
constexpr size_t WS_END = WS_CTL + CTL_BYTES;
static_assert(WS_QR + (size_t)M * 512 * 2 == WS_F, "Qr fills the tail of the hidden buffer");
static_assert(WS_END <= (size_t)512 * 1024 * 1024, "workspace map");
static_assert(2 * 32768 + 8 * 9216 <= 147456 - 256, "attention LDS map");

constexpr int LDS_BYTES = 147456;
constexpr int WAVE_LDS = 17408;

__device__ __forceinline__ unsigned cvt_pk_bf16(float lo, float hi) { unsigned r; asm volatile("v_cvt_pk_bf16_f32 %0, %1, %2" : "=v"(r) : "v"(lo), "v"(hi)); return r; }
__device__ __forceinline__ float bflo(unsigned w) { return __uint_as_float(w << 16); }
__device__ __forceinline__ float bfhi(unsigned w) { return __uint_as_float(w & 0xffff0000u); }
__device__ __forceinline__ float bf1(unsigned short u) { return __uint_as_float((unsigned)u << 16); }
__device__ __forceinline__ float fexp2(float x) { return __builtin_amdgcn_exp2f(x); }
__device__ __forceinline__ float sigmoidf_(float x) { return 1.0f / (1.0f + __expf(-x)); }
__device__ __forceinline__ float wave_sum(float v) {
#pragma unroll
    for (int o = 1; o < 64; o <<= 1) v += __shfl_xor(v, o);
    return v;
}
#define LDS_WAIT() asm volatile("s_waitcnt lgkmcnt(0)" ::: "memory")
#define CFENCE() asm volatile("" ::: "memory")

namespace pg8 {
constexpr int BM = 256, BK = 64, HALF = 128, HTB = HALF * BK * 2, STAGE_BYTES = 8 * HTB, NXCD = 8, WGM = 8;
__host__ __device__ __forceinline__ int lds_byte(int r, int c) { const int st = (r >> 4) * 2 + (c >> 5), rr = r & 15, cc = c & 31, ob = rr * 64 + cc * 2; return st * 1024 + (ob ^ (((ob >> 9) & 1) << 5)); }
__host__ __device__ __forceinline__ void stage_rc(int b, int& R, int& C) { const int st = b / 1024, sb = b % 1024, swz = sb ^ (((sb >> 9) & 1) << 5); R = (st >> 1) * 16 + swz / 64; C = (st & 1) * 32 + (swz % 64) / 2; }
__host__ __device__ __forceinline__ int perm32(int rho) { const int n = rho >> 4, i = rho & 15; return 8 * (i >> 2) + 4 * n + (i & 3); }
struct Unit { int pm, pn; };
struct Gemm { const bf16_t* A; const bf16_t* Bt; int M, N, K; };
struct StaticOrder {
    int nM, nN, nwg, G, c;
    __device__ void init(int M_, int N_, int G_, int c_) { nM = M_ / BM; nN = N_ / BM; nwg = nM * nN; G = G_; c = c_; }
    __device__ bool next(int i, Unit& u) const {
        const long L = (long)i * G + c; if (L >= nwg) return false;
        int wgid = (int)L; { const int q = nwg / NXCD, r = nwg % NXCD, xcd = wgid % NXCD, off = wgid / NXCD; wgid = (xcd < r ? xcd * (q + 1) : r * (q + 1) + (xcd - r) * q) + off; }
        const int nig = WGM * nN, gid = wgid / nig, fm = gid * WGM, gsz = (nM - fm) < WGM ? (nM - fm) : WGM;
        u.pm = fm + ((wgid % nig) % gsz); u.pn = (wgid % nig) / gsz; return true;
    }
    __device__ __forceinline__ void a_ready(const Unit&) const {}
    __device__ __forceinline__ void done(const Unit&) const {}
};
struct EpiStore {
    static constexpr bool PERM = true, AFTER_DRAIN = false;
    bf16_t* O; int ldc;
    __device__ __forceinline__ void operator()(const f32x4 (&acc)[2][2][4][2], const Unit& u, int wr, int wc, int fr, int fq) const {
        const int row0 = u.pm * BM + wr * 64 + fr, col0 = u.pn * BM + wc * 32 + 8 * fq;
#pragma unroll
        for (int ai = 0; ai < 2; ++ai)
#pragma unroll
            for (int m = 0; m < 4; ++m) { bf16_t* rowp = O + (size_t)(row0 + ai * HALF + m * 16) * ldc + col0;
#pragma unroll
                for (int bj = 0; bj < 2; ++bj) { const f32x4 v0 = acc[ai][bj][m][0], v1 = acc[ai][bj][m][1];
                    u32x4 w; w.x = cvt_pk_bf16(v0[0], v0[1]); w.y = cvt_pk_bf16(v0[2], v0[3]); w.z = cvt_pk_bf16(v1[0], v1[1]); w.w = cvt_pk_bf16(v1[2], v1[3]);
                    *(u32x4*)(rowp + bj * HALF) = w; } }
    }
};
struct EpiSwiGLU {
    static constexpr bool PERM = true, AFTER_DRAIN = false;
    bf16_t* O;
    __device__ __forceinline__ void operator()(const f32x4 (&acc)[2][2][4][2], const Unit& u, int wr, int wc, int fr, int fq) const {
        const int row0 = u.pm * BM + wr * 64 + fr, col0 = u.pn * HALF + wc * 32 + 8 * fq;
#pragma unroll
        for (int ai = 0; ai < 2; ++ai)
#pragma unroll
            for (int m = 0; m < 4; ++m) { bf16_t* rowp = O + (size_t)(row0 + ai * HALF + m * 16) * FF + col0;
                float r[8];
#pragma unroll
                for (int n = 0; n < 2; ++n)
#pragma unroll
                    for (int j = 0; j < 4; ++j) { const float g = acc[ai][0][m][n][j], up = acc[ai][1][m][n][j];
                        r[n * 4 + j] = g * __builtin_amdgcn_rcpf(1.0f + fexp2(-1.4426950408889634f * g)) * up; }
                u32x4 w; w.x = cvt_pk_bf16(r[0], r[1]); w.y = cvt_pk_bf16(r[2], r[3]); w.z = cvt_pk_bf16(r[4], r[5]); w.w = cvt_pk_bf16(r[6], r[7]);
                *(u32x4*)rowp = w; }
    }
};

template <class Epi, class Sched, bool ALIGN_EPI = false, bool SP2 = false>
__device__ __forceinline__ void gemm_phase(LAS unsigned char* lds, const Gemm g, const Sched& S, const Epi& E, const int tid) {
    const int wid = __builtin_amdgcn_readfirstlane(tid >> 6), lane = tid & 63, wr = wid >> 2, wc = wid & 3, fr = lane & 15, fq = lane >> 4;
    const int K = g.K, nt = K / BK;
    unsigned voffA[2], voffB[2];
#pragma unroll
    for (int i = 0; i < 2; ++i) { int R, C; stage_rc(tid * 16 + i * 8192, R, C); const int Rb = Epi::PERM ? ((R & ~31) + perm32(R & 31)) : R;
        voffA[i] = (unsigned)(R * K + C) * 2u; voffB[i] = (unsigned)(Rb * K + C) * 2u; }
    const size_t kstep = (size_t)(BK * 2);
    const size_t hstep = (size_t)HALF * K * 2;
    const size_t tstep = 2 * hstep;
    const unsigned ldsw = (unsigned)wid * 1024u;
    const int aoff = lds_byte(wr * 64 + fr, fq * 8), boff = lds_byte(wc * 32 + fr, fq * 8);
#define PG8_SA(b, h) (((b) * 2 + (h)) * HTB)
#define PG8_SB(b, h) ((4 + (b) * 2 + (h)) * HTB)
#define PG8_STAGE(bufoff, gbase, voff) do { _Pragma("unroll") for (int _i = 0; _i < 2; ++_i) \
        __builtin_amdgcn_global_load_lds((const unsigned*)((const char*)(gbase) + (voff)[_i]), (LAS unsigned*)(lds + (bufoff) + ldsw + _i * 8192), 16, 0, 0); } while (0)
#define PG8_LDA(dst, b, h) do { _Pragma("unroll") for (int m = 0; m < 4; ++m) _Pragma("unroll") for (int k = 0; k < 2; ++k) dst[m][k] = *(const LAS bf16x8*)(lds + PG8_SA(b, h) + aoff + m * 2048 + k * 1024); } while (0)
#define PG8_LDB(dst, b, h) do { _Pragma("unroll") for (int n = 0; n < 2; ++n) _Pragma("unroll") for (int k = 0; k < 2; ++k) dst[n][k] = *(const LAS bf16x8*)(lds + PG8_SB(b, h) + boff + n * 2048 + k * 1024); } while (0)
#define PG8_MMA(ai, bj, At, Bt) do { __builtin_amdgcn_s_setprio(1); _Pragma("unroll") for (int m = 0; m < 4; ++m) _Pragma("unroll") for (int n = 0; n < 2; ++n) _Pragma("unroll") for (int k = 0; k < 2; ++k) \
        acc[ai][bj][m][n] = __builtin_amdgcn_mfma_f32_16x16x32_bf16(Bt[n][k], At[m][k], acc[ai][bj][m][n], 0, 0, 0); __builtin_amdgcn_s_setprio(0); } while (0)
#define PG8_WAIT_V(n) asm volatile("s_waitcnt vmcnt(" #n ")" ::: "memory")
#define PG8_WAIT_L(n) asm volatile("s_waitcnt lgkmcnt(" #n ")" ::: "memory")
#define PG8_BAR __builtin_amdgcn_s_barrier()
#define PG8_SCHED __builtin_amdgcn_sched_barrier(0)
    Unit cur, nxt; int ui = 0;
    if (!S.next(0, cur)) return;
    f32x4 acc[2][2][4][2];
#pragma unroll
    for (int a = 0; a < 2; ++a)
#pragma unroll
        for (int b = 0; b < 2; ++b)
#pragma unroll
            for (int m = 0; m < 4; ++m)
#pragma unroll
                for (int n = 0; n < 2; ++n) acc[a][b][m][n] = (f32x4){0.f, 0.f, 0.f, 0.f};
    bf16x8 At[4][2], B0[2][2], B1[2][2];
    const char* cA = (const char*)g.A + (size_t)cur.pm * tstep; const char* cB = (const char*)g.Bt + (size_t)cur.pn * tstep;
    S.a_ready(cur);
    if constexpr (SP2) {
        PG8_STAGE(PG8_SB(0, 0), cB, voffB); PG8_STAGE(PG8_SB(0, 1), cB + hstep, voffB); PG8_STAGE(PG8_SA(0, 0), cA, voffA); PG8_STAGE(PG8_SA(0, 1), cA + hstep, voffA);
        if (wr == 1) PG8_BAR;
        PG8_WAIT_V(2); PG8_BAR;
        PG8_STAGE(PG8_SB(1, 0), cB + kstep, voffB); PG8_STAGE(PG8_SA(1, 0), cA + kstep, voffA); PG8_STAGE(PG8_SB(1, 1), cB + hstep + kstep, voffB);
        PG8_WAIT_V(6); PG8_BAR;
    } else {
        PG8_STAGE(PG8_SB(0, 0), cB, voffB); PG8_STAGE(PG8_SA(0, 0), cA, voffA); PG8_STAGE(PG8_SB(0, 1), cB + hstep, voffB); PG8_STAGE(PG8_SA(0, 1), cA + hstep, voffA);
        if (wr == 1) PG8_BAR;
        PG8_WAIT_V(4); PG8_BAR;
        PG8_STAGE(PG8_SB(1, 0), cB + kstep, voffB); PG8_STAGE(PG8_SA(1, 0), cA + kstep, voffA); PG8_STAGE(PG8_SB(1, 1), cB + hstep + kstep, voffB);
        PG8_WAIT_V(6); PG8_BAR;
    }
    for (;;) {
        const bool has_next = S.next(ui + 1, nxt);
        const char* nA = has_next ? (const char*)g.A + (size_t)nxt.pm * tstep : cA; const char* nB = has_next ? (const char*)g.Bt + (size_t)nxt.pn * tstep : cB;
        for (int t = 0; t < nt; t += 2) {
            const bool last = (t == nt - 2);
            const char* a1 = cA + (size_t)(t + 1) * kstep;
            const char* a2 = last ? nA : cA + (size_t)(t + 2) * kstep; const char* b2 = last ? nB : cB + (size_t)(t + 2) * kstep;
            const char* a3 = a2 + kstep; const char* b3 = b2 + kstep;
            if (last && has_next) S.a_ready(nxt);
            if constexpr (SP2) {
            PG8_LDB(B0, 0, 0); PG8_LDB(B1, 0, 1); PG8_SCHED; PG8_LDA(At, 0, 0); PG8_STAGE(PG8_SA(1, 1), a1 + hstep, voffA);
            PG8_WAIT_V(8); PG8_WAIT_L(0); PG8_BAR; PG8_MMA(0, 0, At, B0); PG8_MMA(0, 1, At, B1); PG8_BAR; PG8_SCHED;
            PG8_LDA(At, 0, 1); PG8_STAGE(PG8_SB(0, 0), b2, voffB); PG8_STAGE(PG8_SB(0, 1), b2 + hstep, voffB); PG8_STAGE(PG8_SA(0, 0), a2, voffA);
            PG8_WAIT_V(8); PG8_WAIT_L(0); PG8_BAR; PG8_MMA(1, 0, At, B0); PG8_MMA(1, 1, At, B1); PG8_BAR; PG8_SCHED;
            PG8_LDB(B0, 1, 0); PG8_LDB(B1, 1, 1); PG8_SCHED; PG8_LDA(At, 1, 0); PG8_STAGE(PG8_SA(0, 1), a2 + hstep, voffA);
            PG8_WAIT_V(8); PG8_WAIT_L(0); PG8_BAR; PG8_MMA(0, 0, At, B0); PG8_MMA(0, 1, At, B1); PG8_BAR; PG8_SCHED;
            PG8_LDA(At, 1, 1); PG8_STAGE(PG8_SB(1, 0), b3, voffB); PG8_STAGE(PG8_SB(1, 1), b3 + hstep, voffB); PG8_STAGE(PG8_SA(1, 0), a3, voffA);
            PG8_WAIT_V(8); PG8_WAIT_L(0); PG8_BAR; PG8_MMA(1, 0, At, B0); PG8_MMA(1, 1, At, B1); PG8_BAR; PG8_SCHED;
            } else {
            PG8_LDB(B0, 0, 0); PG8_SCHED; PG8_LDA(At, 0, 0); PG8_STAGE(PG8_SA(1, 1), a1 + hstep, voffA);
            PG8_WAIT_L(8); PG8_BAR; PG8_WAIT_L(0); PG8_MMA(0, 0, At, B0); PG8_BAR; PG8_SCHED;
            PG8_LDB(B1, 0, 1); PG8_STAGE(PG8_SB(0, 0), b2, voffB);
            PG8_BAR; PG8_WAIT_L(0); PG8_MMA(0, 1, At, B1); PG8_BAR;
            PG8_LDA(At, 0, 1); PG8_STAGE(PG8_SA(0, 0), a2, voffA);
            PG8_BAR; PG8_WAIT_L(0); PG8_MMA(1, 0, At, B0); PG8_BAR; PG8_SCHED;
            PG8_STAGE(PG8_SB(0, 1), b2 + hstep, voffB);
            PG8_WAIT_V(6); PG8_BAR; PG8_MMA(1, 1, At, B1); PG8_BAR;
            PG8_LDB(B0, 1, 0); PG8_SCHED; PG8_LDA(At, 1, 0); PG8_STAGE(PG8_SA(0, 1), a2 + hstep, voffA);
            PG8_WAIT_L(8); PG8_BAR; PG8_WAIT_L(0); PG8_MMA(0, 0, At, B0); PG8_BAR; PG8_SCHED;
            PG8_LDB(B1, 1, 1); PG8_STAGE(PG8_SB(1, 0), b3, voffB);
            PG8_BAR; PG8_WAIT_L(0); PG8_MMA(0, 1, At, B1); PG8_BAR;
            PG8_LDA(At, 1, 1); PG8_STAGE(PG8_SA(1, 0), a3, voffA);
            PG8_BAR; PG8_WAIT_L(0); PG8_MMA(1, 0, At, B0); PG8_BAR; PG8_SCHED;
            PG8_STAGE(PG8_SB(1, 1), b3 + hstep, voffB);
            PG8_WAIT_V(6); PG8_BAR; PG8_MMA(1, 1, At, B1); PG8_BAR;
            }
        }
        if constexpr (ALIGN_EPI) { if (wr == 0) PG8_BAR; }
        if constexpr (!Epi::AFTER_DRAIN) { E(acc, cur, wr, wc, fr, fq); S.done(cur); }
        if (!has_next) break;
#pragma unroll
        for (int a = 0; a < 2; ++a)
#pragma unroll
            for (int b = 0; b < 2; ++b)
#pragma unroll
                for (int m = 0; m < 4; ++m)
#pragma unroll
                    for (int n = 0; n < 2; ++n) acc[a][b][m][n] = (f32x4){0.f, 0.f, 0.f, 0.f};
        cur = nxt; cA = nA; cB = nB; ++ui;
        if constexpr (ALIGN_EPI) { if (wr == 1) PG8_BAR; }
    }
    PG8_WAIT_V(0);
    if constexpr (!ALIGN_EPI) { if (wr == 0) PG8_BAR; }
    PG8_BAR;
#undef PG8_SA
#undef PG8_SB
#undef PG8_STAGE
#undef PG8_LDA
#undef PG8_LDB
#undef PG8_MMA
#undef PG8_WAIT_V
#undef PG8_WAIT_L
#undef PG8_BAR
#undef PG8_SCHED
}
}

#define XB_TMO      128
#define XB_XCNT(j)  (256  + 64 * (j))
#define XB_XSUB(j)  (1280 + 64 * (j))
#define XB_XGEN(j)  (2304 + 64 * (j))
#define XB_TOP      3328
#define XB_TOPGEN   3392
#define XCD_BAR_WORDS 3456
#define XB_SPIN_CAP (1u << 18)
__device__ __forceinline__ unsigned xb_ld(unsigned* p)              { return __hip_atomic_load(p, __ATOMIC_RELAXED, __HIP_MEMORY_SCOPE_AGENT); }
__device__ __forceinline__ unsigned xb_add(unsigned* p, unsigned v) { return __hip_atomic_fetch_add(p, v, __ATOMIC_RELAXED, __HIP_MEMORY_SCOPE_AGENT); }
__device__ __forceinline__ unsigned xb_xcc_id() { return (unsigned)__builtin_amdgcn_s_getreg((3 << 11) | 20) & 0xFu; }
#define XB_SPIN(cond, bar) do { unsigned _sp = 0; while (cond) { __builtin_amdgcn_s_sleep(1); \
    if ((++_sp & 255u) == 0u) { if (xb_ld(&(bar)[XB_TMO])) break; if (_sp > XB_SPIN_CAP) { atomicAdd(&(bar)[XB_TMO], 1u); break; } } } } while (0)
__device__ __forceinline__ void xcd_barrier_complete(unsigned* bar, unsigned x, unsigned& nloc, unsigned& nx) {
    const unsigned G = gridDim.x * gridDim.y * gridDim.z;
    unsigned sum, cnt, mine, sp = 0u;
    for (;;) {
        sum = 0u; cnt = 0u; mine = 0u;
#pragma unroll
        for (unsigned j = 0; j < 16; ++j) { const unsigned c = xb_ld(&bar[XB_XCNT(j)]); sum += c; cnt += (c > 0u) ? 1u : 0u; mine = (j == x) ? c : mine; }
        if (sum == G) break;
        __builtin_amdgcn_s_sleep(1);
        if ((++sp & 255u) == 0u) { if (xb_ld(&bar[XB_TMO])) break; if (sp > XB_SPIN_CAP) { atomicAdd(&bar[XB_TMO], 1u); break; } }
    }
    nloc = mine > 0u ? mine : 1u; nx = cnt > 0u ? cnt : 1u;
}
__device__ __forceinline__ void xcd_barrier(unsigned* bar, unsigned x, volatile LAS unsigned* st) {
    asm volatile("s_waitcnt vmcnt(0)" ::: "memory");
    __syncthreads();
    if (threadIdx.x == 0) {
        __builtin_amdgcn_s_waitcnt(0);
        unsigned nloc = st[0], nx = st[1];
        if (nloc == 0u) { xcd_barrier_complete(bar, x, nloc, nx); st[0] = nloc; st[1] = nx; }
        const unsigned old = xb_add(&bar[XB_XSUB(x)], 1u);
        const unsigned gen = old / nloc;
        if (old + 1u == (gen + 1u) * nloc) {
            __builtin_amdgcn_fence(__ATOMIC_RELEASE, "agent");
            asm volatile("s_waitcnt vmcnt(0)" ::: "memory");
            const unsigned og = xb_add(&bar[XB_TOP], 1u);
            const unsigned tg = og / nx;
            if (og + 1u == (tg + 1u) * nx) xb_add(&bar[XB_TOPGEN], 1u);
            else XB_SPIN(xb_ld(&bar[XB_TOPGEN]) == tg, bar);
            __builtin_amdgcn_fence(__ATOMIC_ACQUIRE, "agent");
            xb_add(&bar[XB_XGEN(x)], 1u);
            asm volatile("s_waitcnt vmcnt(0)" ::: "memory");
        } else {
            XB_SPIN(xb_ld(&bar[XB_XGEN(x)]) == gen, bar);
            __builtin_amdgcn_fence(__ATOMIC_ACQUIRE, "agent");
            asm volatile("s_waitcnt vmcnt(0)" ::: "memory");
        }
    }
    __syncthreads();
}

struct Args { const void* in[28]; float* out; unsigned char* ws; int ph_lo, ph_hi; int rep_attn, rep_fin, rep_prep, rep_pad; };

struct Ctx {
    LAS unsigned char* lds; LAS unsigned char* wlds;
    int tid, lane, wave, gw, ngw, G;
    unsigned char* ws;
};
constexpr int PTAB_OFF = 147456 - 256;
__device__ __forceinline__ const void* ldptr(LAS unsigned char* lds, int i) {
    volatile LAS unsigned* t = (volatile LAS unsigned*)(lds + PTAB_OFF) + 2 * i;
    const unsigned lo = __builtin_amdgcn_readfirstlane(t[0]), hi = __builtin_amdgcn_readfirstlane(t[1]);
    return (const void*)(const __attribute__((address_space(1))) unsigned char*)(((unsigned long long)hi << 32) | lo);
}
#define INP_F(i) ((const float*)ldptr(c.lds, (i)))

#define MFMA16(a, b, c) __builtin_amdgcn_mfma_f32_16x16x32_bf16((a), (b), (c), 0, 0, 0)

__device__ __forceinline__ void tr_item(const float* W, int K, int N, int nblk, bf16_t* WT, int mode, LAS float* scr, int item, int lane) {
    const int kb = item / nblk, nb = item % nblk, k0 = 64 * kb, n0 = 32 * nb;
    const int nn = n0 + (lane & 31);
#pragma unroll 8
    for (int i = 0; i < 32; ++i) { const int kk = 2 * i + (lane >> 5); scr[kk * 33 + (lane & 31)] = (nn < N) ? W[(size_t)(k0 + kk) * N + nn] : 0.f; }
    LDS_WAIT();
    const int row_off = mode == 0 ? 0 : ((n0 >> 7) * 128 + (mode == 2 ? 128 : 0));
    const int c = lane & 7;
#pragma unroll
    for (int j = 0; j < 4; ++j) { const int n = (lane >> 3) + 8 * j; const LAS float* s = scr + (8 * c) * 33 + n;
        u32x4 o; o.x = cvt_pk_bf16(s[0 * 33], s[1 * 33]); o.y = cvt_pk_bf16(s[2 * 33], s[3 * 33]); o.z = cvt_pk_bf16(s[4 * 33], s[5 * 33]); o.w = cvt_pk_bf16(s[6 * 33], s[7 * 33]);
        *(u32x4*)(WT + (size_t)(row_off + n0 + n) * K + k0 + 8 * c) = o; }
    LDS_WAIT();
}

__device__ __forceinline__ void norm_row_to_bf16(const float* xrow, const float* g, bf16_t* orow, int lane) {
    const f32x4* xr = (const f32x4*)xrow + lane; const f32x4* gr = (const f32x4*)g + lane;
    f32x4 v[4]; float s = 0.f;
#pragma unroll
    for (int j = 0; j < 4; ++j) { v[j] = xr[64 * j]; s += (v[j].x * v[j].x + v[j].y * v[j].y) + (v[j].z * v[j].z + v[j].w * v[j].w); }
    const float rs = 1.0f / sqrtf(wave_sum(s) * (1.f / DM) + EPS);
    u32x2* o8 = (u32x2*)orow + lane;
#pragma unroll
    for (int j = 0; j < 4; ++j) { const f32x4 gg = gr[64 * j]; u32x2 w; w.x = cvt_pk_bf16(v[j].x * rs * gg.x, v[j].y * rs * gg.y); w.y = cvt_pk_bf16(v[j].z * rs * gg.z, v[j].w * rs * gg.w); o8[64 * j] = w; }
}

constexpr int TR_BIG = 1408, TR_PER_LAYER = 6 * 1408 + 1152 + 512 + 8 + 16 + 128, TR_TOTAL = DEPTH * TR_PER_LAYER;

__device__ __forceinline__ void p0_prologue(const Ctx& c) {
    LAS float* scr = (LAS float*)c.wlds;
    unsigned char* ws = c.ws;
    for (int it = c.gw; it < TR_TOTAL; it += c.ngw) {
        const int l = it / TR_PER_LAYER; int r = it % TR_PER_LAYER;
        const float* src; bf16_t* dst; int K, N, nblk, mode = 0;
        if (r < 4 * TR_BIG) { const int q = r / TR_BIG; r -= q * TR_BIG; const int which = q >> 1, isup = q & 1;
            src = INP_F(which ? (isup ? 26 : 25) : (isup ? 5 : 4)) + (size_t)l * DM * FF; dst = (bf16_t*)(ws + WS_WGU + (size_t)(l * 2 + which) * SZ_WGU); K = DM; N = FF; nblk = FF / 32; mode = 1 + isup; }
        else if (r < 6 * TR_BIG) { r -= 4 * TR_BIG; const int which = r / TR_BIG; r -= which * TR_BIG;
            src = INP_F(which ? 27 : 6) + (size_t)l * DM * FF; dst = (bf16_t*)(ws + WS_WDN + (size_t)(l * 2 + which) * SZ_WDN); K = FF; N = DM; nblk = DM / 32; }
        else if (r < 6 * TR_BIG + 1152) { r -= 6 * TR_BIG; src = INP_F(9) + (size_t)l * DM * INC; dst = (bf16_t*)(ws + WS_WIN + (size_t)l * SZ_WIN); K = DM; N = INC; nblk = INP / 32; }
        else if (r < 6 * TR_BIG + 1152 + 512) { r -= 6 * TR_BIG + 1152; src = INP_F(10) + (size_t)l * DM * DM; dst = (bf16_t*)(ws + WS_WOUT + (size_t)l * SZ_WOUT); K = DM; N = DM; nblk = DM / 32; }
        else if (r < 6 * TR_BIG + 1152 + 512 + 8) { r -= 6 * TR_BIG + 1152 + 512; const int g = r >> 1; r &= 1;
            src = INP_F(11) + (size_t)(l * 4 + g) * 4096; dst = (bf16_t*)(ws + WS_WPOOL) + (size_t)(l * 4 + g) * 4096; K = 64; N = 64; nblk = 2; }
        else if (r < 6 * TR_BIG + 1152 + 512 + 8 + 16) { r -= 6 * TR_BIG + 1152 + 512 + 8; const int q = r >> 1; r &= 1; const int ri = q >> 2, h = q & 3;
            src = INP_F(ri ? 17 : 15) + (size_t)(l * 4 + h) * 4096; dst = (bf16_t*)(ws + WS_WLRU) + (size_t)((l * 2 + ri) * 4 + h) * 4096; K = 64; N = 64; nblk = 2; }
        else { r -= 6 * TR_BIG + 1152 + 512 + 8 + 16; const int kv = r >> 6; r &= 63;
            src = INP_F(kv ? 21 : 20) + (size_t)l * 2048 * 64; dst = (bf16_t*)(ws + WS_WCMP) + (size_t)(l * 2 + kv) * 64 * 2048; K = 2048; N = 64; nblk = 2; }
        tr_item(src, K, N, nblk, dst, mode, scr, r, c.lane);
    }
    {
        const int* pos = (const int*)ldptr(c.lds, 1); float* ct = (float*)(ws + WS_COS); float* st = (float*)(ws + WS_SIN);
        for (int e = c.gw * 64 + c.lane; e < M * 32; e += c.ngw * 64) {
            const int m = e >> 5, i = e & 31;
            const float inv = powf(10000.0f, -(float)(2 * i) / 64.0f);
            const float ang = (float)pos[m] * inv;
            const double ad = (double)ang; const double k = rint(ad * 0.15915494309189535); const float rr = (float)(ad - k * 6.283185307179586);
            ct[e] = cosf(rr); st[e] = sinf(rr);
        }
    }
    const float* x0 = INP_F(0); const float* g0 = INP_F(2);
    for (int m = c.gw; m < M; m += c.ngw) norm_row_to_bf16(x0 + (size_t)m * DM, g0, (bf16_t*)(ws + WS_A) + (size_t)m * DM, c.lane);
}

__device__ __forceinline__ void rowpass(const Ctx& c, const float* hin, float* hout, const bf16_t* f, const float* gpost, float coef, const float* gnext, bf16_t* aout) {
    const int lane = c.lane;
    for (int m = c.gw; m < M; m += c.ngw) {
        const u32x2* fr = (const u32x2*)(f + (size_t)m * DM) + lane;
        const f32x4* hr = (const f32x4*)(hin + (size_t)m * DM) + lane;
        f32x4 fv[4], hv[4]; float s = 0.f;
#pragma unroll
        for (int j = 0; j < 4; ++j) { const u32x2 w = fr[64 * j]; fv[j] = (f32x4){bflo(w.x), bfhi(w.x), bflo(w.y), bfhi(w.y)}; hv[j] = hr[64 * j];
            s += (fv[j].x * fv[j].x + fv[j].y * fv[j].y) + (fv[j].z * fv[j].z + fv[j].w * fv[j].w); }
        const float rs = coef / sqrtf(wave_sum(s) * (1.f / DM) + EPS);
        float s2 = 0.f;
#pragma unroll
        for (int j = 0; j < 4; ++j) { const f32x4 gg = ((const f32x4*)gpost + lane)[64 * j]; hv[j] = hv[j] + fv[j] * rs * gg;
            s2 += (hv[j].x * hv[j].x + hv[j].y * hv[j].y) + (hv[j].z * hv[j].z + hv[j].w * hv[j].w); }
        f32x4* ho = (f32x4*)(hout + (size_t)m * DM) + lane;
#pragma unroll
        for (int j = 0; j < 4; ++j) ho[64 * j] = hv[j];
        if (gnext) {
            const float rs2 = 1.0f / sqrtf(wave_sum(s2) * (1.f / DM) + EPS);
            u32x2* o8 = (u32x2*)(aout + (size_t)m * DM) + lane;
#pragma unroll
            for (int j = 0; j < 4; ++j) { const f32x4 gg = ((const f32x4*)gnext + lane)[64 * j]; u32x2 w; w.x = cvt_pk_bf16(hv[j].x * rs2 * gg.x, hv[j].y * rs2 * gg.y); w.y = cvt_pk_bf16(hv[j].z * rs2 * gg.z, hv[j].w * rs2 * gg.w); o8[64 * j] = w; }
        }
    }
}

__device__ __forceinline__ void unpack8(const bf16x8 v, float* f) {
    const u32x4 w = __builtin_bit_cast(u32x4, v);
    f[0] = bflo(w.x); f[1] = bfhi(w.x); f[2] = bflo(w.y); f[3] = bfhi(w.y); f[4] = bflo(w.z); f[5] = bfhi(w.z); f[6] = bflo(w.w); f[7] = bfhi(w.w);
}
__device__ __forceinline__ bf16x8 pack8(const float* f) {
    u32x4 w; w.x = cvt_pk_bf16(f[0], f[1]); w.y = cvt_pk_bf16(f[2], f[3]); w.z = cvt_pk_bf16(f[4], f[5]); w.w = cvt_pk_bf16(f[6], f[7]);
    return __builtin_bit_cast(bf16x8, w);
}

__device__ __forceinline__ void rope_unit(const Ctx& c, int tile) {
    const bf16_t* proj = (const bf16_t*)(c.ws + WS_HID); bf16_t* Qr = (bf16_t*)(c.ws + WS_QR);
    const float* ct = (const float*)(c.ws + WS_COS); const float* st = (const float*)(c.ws + WS_SIN);
    const int lane = c.lane, i0 = (lane & 7) * 4;
    const int head = lane >> 3;
    const int arr = (lane >> 4) & 1, kvh = (lane >> 3) & 1;
    for (int t4 = 0; t4 < 16; t4 += 4) {
        f32x4 cs[4], sn[4]; u32x2 qa[4], qb[4], ka[4], kb[4];
#pragma unroll
        for (int q = 0; q < 4; ++q) {
            const size_t tg = (size_t)tile * 16 + t4 + q;
            cs[q] = *(const f32x4*)(ct + tg * 32 + i0); sn[q] = *(const f32x4*)(st + tg * 32 + i0);
            const bf16_t* src = proj + tg * INP + C_Q + head * 64 + i0; qa[q] = *(const u32x2*)src; qb[q] = *(const u32x2*)(src + 32);
            const bf16_t* ksrc = proj + tg * INP + (arr ? C_KW : C_KS) + kvh * 64 + i0; ka[q] = *(const u32x2*)ksrc; kb[q] = *(const u32x2*)(ksrc + 32);
        }
#pragma unroll
        for (int q = 0; q < 4; ++q) {
            const int tg = tile * 16 + t4 + q; const int b = tg / SEQ, t = tg % SEQ;
            {
                const f32x4 x1 = (f32x4){bflo(qa[q].x), bfhi(qa[q].x), bflo(qa[q].y), bfhi(qa[q].y)}, x2 = (f32x4){bflo(qb[q].x), bfhi(qb[q].x), bflo(qb[q].y), bfhi(qb[q].y)};
                const f32x4 o1 = (x1 * cs[q] - x2 * sn[q]) * QSCALE, o2 = (x2 * cs[q] + x1 * sn[q]) * QSCALE;
                bf16_t* dst = Qr + (size_t)tg * 512 + head * 64 + i0;
                u32x2 w; w.x = cvt_pk_bf16(o1.x, o1.y); w.y = cvt_pk_bf16(o1.z, o1.w); *(u32x2*)dst = w;
                w.x = cvt_pk_bf16(o2.x, o2.y); w.y = cvt_pk_bf16(o2.z, o2.w); *(u32x2*)(dst + 32) = w;
            }
            if (lane < 32) {
                const f32x4 x1 = (f32x4){bflo(ka[q].x), bfhi(ka[q].x), bflo(ka[q].y), bfhi(ka[q].y)}, x2 = (f32x4){bflo(kb[q].x), bfhi(kb[q].x), bflo(kb[q].y), bfhi(kb[q].y)};
                const f32x4 o1 = x1 * cs[q] - x2 * sn[q], o2 = x2 * cs[q] + x1 * sn[q];
                bf16_t* dst = (bf16_t*)(c.ws + (arr ? WS_KW : WS_KS)) + ((size_t)(b * 2 + kvh) * SEQ + t) * 64 + i0;
                u32x2 w; w.x = cvt_pk_bf16(o1.x, o1.y); w.y = cvt_pk_bf16(o1.z, o1.w); *(u32x2*)dst = w;
                w.x = cvt_pk_bf16(o2.x, o2.y); w.y = cvt_pk_bf16(o2.z, o2.w); *(u32x2*)(dst + 32) = w;
            }
        }
    }
}
__device__ __forceinline__ void vt_unit(const Ctx& c, int u) {
    const int tile = u & 255, bk = (u >> 8) & 3, arr = u >> 10; const int b = bk >> 1, kvh = bk & 1, t0 = tile * 64;
    const bf16_t* src = (const bf16_t*)(c.ws + WS_HID) + (size_t)(b * SEQ + t0) * INP + (arr ? C_VW : C_VS) + kvh * 64 + c.lane;
    bf16_t* dst = (bf16_t*)(c.ws + (arr ? WS_VWT : WS_VST)) + (((size_t)bk * 256 + tile) * 64 + c.lane) * 64;
#pragma unroll
    for (int q = 0; q < 8; ++q) {
        unsigned w[4];
#pragma unroll
        for (int e = 0; e < 4; ++e) { const unsigned lo = src[(size_t)(q * 8 + 2 * e) * INP], hi = src[(size_t)(q * 8 + 2 * e + 1) * INP]; w[e] = lo | (hi << 16); }
        *(u32x4*)(dst + q * 8) = (u32x4){w[0], w[1], w[2], w[3]};
    }
}
template <int W>
__device__ __forceinline__ void pool_unit_w(const Ctx& c, int tile, int gp, int layer, const float* pool_scale) {
    const int lane = c.lane, r16 = lane & 15, g = lane >> 4;
    const int tg = tile * 16 + r16, b = tg / SEQ, t = tg % SEQ;
    const bf16_t* proj = (const bf16_t*)(c.ws + WS_HID);
    const bf16_t* WpT = (const bf16_t*)(c.ws + WS_WPOOL) + (size_t)(layer * 4 + gp) * 4096;
    bf16x8 Df[2];
    const int cnt = (t + 1 < W) ? t + 1 : W; const float icnt = 1.0f / (float)cnt;
#pragma unroll
    for (int ks = 0; ks < 2; ++ks) {
        const bf16_t* p = proj + (size_t)(b * SEQ + t) * INP + C_XP + gp * 64 + ks * 32 + g * 8;
        bf16x8 rows[W];
#pragma unroll
        for (int s_ = 0; s_ < W; ++s_) { const int ss = s_ <= t ? s_ : 0; rows[s_] = *(const bf16x8*)(p - (size_t)ss * INP); }
        float sum[8], x0[8];
        unpack8(rows[0], x0);
#pragma unroll
        for (int e = 0; e < 8; ++e) sum[e] = x0[e];
#pragma unroll
        for (int s_ = 1; s_ < W; ++s_) { float xv[8]; unpack8(rows[s_], xv); const float wv = s_ <= t ? 1.0f : 0.0f;
#pragma unroll
            for (int e = 0; e < 8; ++e) sum[e] += wv * xv[e]; }
        float d[8];
#pragma unroll
        for (int e = 0; e < 8; ++e) d[e] = sum[e] * icnt - x0[e];
        Df[ks] = pack8(d);
    }
    bf16_t* out = (bf16_t*)(c.ws + WS_A) + (size_t)tg * DM + gp * 64;
#pragma unroll
    for (int jt = 0; jt < 4; ++jt) {
        f32x4 acc = (f32x4){0.f, 0.f, 0.f, 0.f};
#pragma unroll
        for (int ks = 0; ks < 2; ++ks) { const bf16x8 wf = *(const bf16x8*)(WpT + (size_t)(16 * jt + r16) * 64 + ks * 32 + g * 8); acc = MFMA16(wf, Df[ks], acc); }
        const f32x4 sc = *(const f32x4*)(pool_scale + gp * 64 + 16 * jt + 4 * g);
        u32x2 o; o.x = cvt_pk_bf16(acc[0] * sc[0], acc[1] * sc[1]); o.y = cvt_pk_bf16(acc[2] * sc[2], acc[3] * sc[3]);
        *(u32x2*)(out + 16 * jt + 4 * g) = o;
    }
}
__device__ __forceinline__ void pool_unit(const Ctx& c, int u, int layer, const float* pool_scale) {
    const int gp = u & 3, tile = u >> 2;
    if (gp == 0) pool_unit_w<2>(c, tile, 0, layer, pool_scale);
    else if (gp == 1) pool_unit_w<4>(c, tile, 1, layer, pool_scale);
    else if (gp == 2) pool_unit_w<8>(c, tile, 2, layer, pool_scale);
    else pool_unit_w<16>(c, tile, 3, layer, pool_scale);
}
__device__ __forceinline__ void lru_unit(const Ctx& c, int u, int layer, const float* conv_w, const float* conv_b, const float* b_r, const float* b_i, const float* lam) {
    const int hh = u & 3, ch = (u >> 2) % LRU_NCH, b = (u >> 2) / LRU_NCH;
    const int lane = c.lane, r16 = lane & 15, g = lane >> 4;
    const bf16_t* proj = (const bf16_t*)(c.ws + WS_HID);
    const bf16_t* WrT = (const bf16_t*)(c.ws + WS_WLRU) + (size_t)((layer * 2 + 0) * 4 + hh) * 4096;
    const bf16_t* WiT = (const bf16_t*)(c.ws + WS_WLRU) + (size_t)((layer * 2 + 1) * 4 + hh) * 4096;
    float* HL = (float*)(c.ws + WS_F); float* CA = HL + (size_t)M * 256;
    float n8sp[4][4], hcar[4][4], acar[4][4];
#pragma unroll
    for (int jt = 0; jt < 4; ++jt)
#pragma unroll
        for (int jj = 0; jj < 4; ++jj) { const float L = lam[hh * 64 + 16 * jt + 4 * g + jj]; n8sp[jt][jj] = -8.0f * log1pf(__expf(-L)); hcar[jt][jj] = 0.f; acar[jt][jj] = 1.f; }
    for (int tile = 0; tile < LRU_CHUNK / 16; ++tile) {
        const int t = ch * LRU_CHUNK + tile * 16 + r16; const size_t tg = (size_t)b * SEQ + t;
        bf16x8 Xf[2];
#pragma unroll
        for (int ks = 0; ks < 2; ++ks) {
            const int c0 = hh * 64 + ks * 32 + g * 8; float acc8[8];
            { const f32x4 b0 = *(const f32x4*)(conv_b + c0), b1 = *(const f32x4*)(conv_b + c0 + 4); acc8[0] = b0[0]; acc8[1] = b0[1]; acc8[2] = b0[2]; acc8[3] = b0[3]; acc8[4] = b1[0]; acc8[5] = b1[1]; acc8[6] = b1[2]; acc8[7] = b1[3]; }
#pragma unroll
            for (int k = 0; k < 4; ++k) { const int tt = t - 3 + k;
                if (tt >= 0) { float xv[8]; unpack8(*(const bf16x8*)(proj + ((size_t)b * SEQ + tt) * INP + C_XL + c0), xv);
                    const f32x4 w0 = *(const f32x4*)(conv_w + k * 256 + c0), w1 = *(const f32x4*)(conv_w + k * 256 + c0 + 4);
                    acc8[0] += w0[0] * xv[0]; acc8[1] += w0[1] * xv[1]; acc8[2] += w0[2] * xv[2]; acc8[3] += w0[3] * xv[3];
                    acc8[4] += w1[0] * xv[4]; acc8[5] += w1[1] * xv[5]; acc8[6] += w1[2] * xv[6]; acc8[7] += w1[3] * xv[7]; } }
            Xf[ks] = pack8(acc8);
        }
#pragma unroll
        for (int jt = 0; jt < 4; ++jt) {
            f32x4 aR = (f32x4){0.f, 0.f, 0.f, 0.f}, aI = (f32x4){0.f, 0.f, 0.f, 0.f};
#pragma unroll
            for (int ks = 0; ks < 2; ++ks) { const size_t wo = (size_t)(16 * jt + r16) * 64 + ks * 32 + g * 8;
                aR = MFMA16(*(const bf16x8*)(WrT + wo), Xf[ks], aR); aI = MFMA16(*(const bf16x8*)(WiT + wo), Xf[ks], aI); }
            const int c4 = hh * 64 + 16 * jt + 4 * g;
            f32x4 xc = *(const f32x4*)(conv_b + c4);
#pragma unroll
            for (int k = 0; k < 4; ++k) { const int tt = t - 3 + k;
                if (tt >= 0) { const u32x2 xw = *(const u32x2*)(proj + ((size_t)b * SEQ + tt) * INP + C_XL + c4); const f32x4 w4 = *(const f32x4*)(conv_w + k * 256 + c4);
                    xc[0] += w4[0] * bflo(xw.x); xc[1] += w4[1] * bfhi(xw.x); xc[2] += w4[2] * bflo(xw.y); xc[3] += w4[3] * bfhi(xw.y); } }
            const f32x4 br4 = *(const f32x4*)(b_r + c4), bi4 = *(const f32x4*)(b_i + c4);
            f32x4 hv, cv;
#pragma unroll
            for (int jj = 0; jj < 4; ++jj) {
                const float r = sigmoidf_(aR[jj] + br4[jj]), ii = sigmoidf_(aI[jj] + bi4[jj]);
                const float la = n8sp[jt][jj] * r; float av = __expf(la); float bv = sqrtf(fmaxf(-expm1f(2.0f * la), 0.f)) * (ii * xc[jj]);
#pragma unroll
                for (int d = 1; d < 16; d <<= 1) { const float ap = __shfl_up(av, d, 16), bp = __shfl_up(bv, d, 16); if (r16 >= d) { bv = av * bp + bv; av = av * ap; } }
                const float h = av * hcar[jt][jj] + bv, ca = av * acar[jt][jj];
                hv[jj] = h; cv[jj] = ca;
                hcar[jt][jj] = __shfl(h, 15, 16); acar[jt][jj] = __shfl(ca, 15, 16);
            }
            *(f32x4*)(HL + tg * 256 + c4) = hv; *(f32x4*)(CA + tg * 256 + c4) = cv;
        }
    }
    if (r16 == 15) {
        float* carA = (float*)(c.ws + WS_CARA) + (size_t)(b * LRU_NCH + ch) * 256; float* carH = (float*)(c.ws + WS_CARH) + (size_t)(b * LRU_NCH + ch) * 256;
#pragma unroll
        for (int jt = 0; jt < 4; ++jt) { const int c4 = hh * 64 + 16 * jt + 4 * g;
            *(f32x4*)(carA + c4) = (f32x4){acar[jt][0], acar[jt][1], acar[jt][2], acar[jt][3]}; *(f32x4*)(carH + c4) = (f32x4){hcar[jt][0], hcar[jt][1], hcar[jt][2], hcar[jt][3]}; }
    }
}
__device__ __forceinline__ void cmp_unit(const Ctx& c, int u, int layer, const float* pe) {
    const int nt_ = u & 63, bk = (u >> 6) & 3, kv = u >> 8; const int b = bk >> 1, kvh = bk & 1;
    const int lane = c.lane, r16 = lane & 15, g = lane >> 4;
    const bf16_t* proj = (const bf16_t*)(c.ws + WS_HID);
    const bf16_t* WT = (const bf16_t*)(c.ws + WS_WCMP) + (size_t)(layer * 2 + kv) * 64 * 2048;
    const float* ct = (const float*)(c.ws + WS_COS); const float* st = (const float*)(c.ws + WS_SIN);
    const int n = nt_ * 16 + r16; const int colb = (kv ? C_VC : C_KC) + kvh * 64;
    f32x4 acc[4];
#pragma unroll
    for (int e = 0; e < 4; ++e) acc[e] = (f32x4){0.f, 0.f, 0.f, 0.f};
#pragma unroll 2
    for (int l = 0; l < 32; ++l) {
        int t = 16 * n + l; if (t > SEQ - 1) t = SEQ - 1;
        const size_t tg = (size_t)b * SEQ + t;
        float x1[8], x2[8];
        unpack8(*(const bf16x8*)(proj + tg * INP + colb + g * 8), x1); unpack8(*(const bf16x8*)(proj + tg * INP + colb + 32 + g * 8), x2);
        float o1[8], o2[8];
        if (kv == 0) {
            const f32x4 c0 = *(const f32x4*)(ct + tg * 32 + g * 8), c1 = *(const f32x4*)(ct + tg * 32 + g * 8 + 4), s0 = *(const f32x4*)(st + tg * 32 + g * 8), s1 = *(const f32x4*)(st + tg * 32 + g * 8 + 4);
#pragma unroll
            for (int e = 0; e < 8; ++e) { const float cc = e < 4 ? c0[e & 3] : c1[e & 3], ss = e < 4 ? s0[e & 3] : s1[e & 3]; o1[e] = x1[e] * cc - x2[e] * ss; o2[e] = x2[e] * cc + x1[e] * ss; }
        } else {
#pragma unroll
            for (int e = 0; e < 8; ++e) { o1[e] = x1[e]; o2[e] = x2[e]; }
        }
        { const f32x4 p0 = *(const f32x4*)(pe + l * 64 + g * 8), p1 = *(const f32x4*)(pe + l * 64 + g * 8 + 4), p2 = *(const f32x4*)(pe + l * 64 + 32 + g * 8), p3 = *(const f32x4*)(pe + l * 64 + 32 + g * 8 + 4);
#pragma unroll
            for (int e = 0; e < 4; ++e) { o1[e] += p0[e]; o1[4 + e] += p1[e]; o2[e] += p2[e]; o2[4 + e] += p3[e]; } }
        const bf16x8 X0 = pack8(o1), X1 = pack8(o2);
#pragma unroll
        for (int et = 0; et < 4; ++et) {
            const bf16_t* wp = WT + (size_t)(16 * et + r16) * 2048 + l * 64 + g * 8;
            const bf16x8 W0 = *(const bf16x8*)wp, W1 = *(const bf16x8*)(wp + 32);
            if (kv == 0) { acc[et] = MFMA16(W0, X0, acc[et]); acc[et] = MFMA16(W1, X1, acc[et]); }
            else         { acc[et] = MFMA16(X0, W0, acc[et]); acc[et] = MFMA16(X1, W1, acc[et]); }
        }
    }
    if (kv == 0) {
        bf16_t* dst = (bf16_t*)(c.ws + WS_KCMP) + ((size_t)bk * 1024 + n) * 64;
        const bool z = (n >= 1023);
#pragma unroll
        for (int et = 0; et < 4; ++et) { u32x2 o; o.x = cvt_pk_bf16(acc[et][0], acc[et][1]); o.y = cvt_pk_bf16(acc[et][2], acc[et][3]); if (z) { o.x = 0u; o.y = 0u; } *(u32x2*)(dst + 16 * et + 4 * g) = o; }
    } else {
        bf16_t* dst = (bf16_t*)(c.ws + WS_VCMPT) + (size_t)bk * 64 * 1024;
        const int nb = nt_ * 16 + 4 * g;
#pragma unroll
        for (int et = 0; et < 4; ++et) { float v3 = acc[et][3]; if (nb + 3 >= 1023) v3 = 0.f; u32x2 o; o.x = cvt_pk_bf16(acc[et][0], acc[et][1]); o.y = cvt_pk_bf16(acc[et][2], v3); *(u32x2*)(dst + ((size_t)(nb >> 6) * 64 + 16 * et + r16) * 64 + (nb & 63)) = o; }
    }
}

constexpr int NU_LRU = BATCH * LRU_NCH * 4, NU_CMP = 512, NU_POOL = (M / 16) * 4, NU_ROPE = M / 16, NU_VT = 2048;
__device__ __forceinline__ void phase_prep(const Ctx& c, int layer) {
    const float* pool_scale = INP_F(12) + layer * 256;
    const float* conv_w = INP_F(13) + layer * 1024; const float* conv_b = INP_F(14) + layer * 256;
    const float* b_r = INP_F(16) + layer * 256; const float* b_i = INP_F(18) + layer * 256; const float* lam = INP_F(19) + layer * 256;
    const float* pe = INP_F(22) + layer * 2048;
    for (int u = c.gw; u < NU_LRU; u += c.ngw) lru_unit(c, u, layer, conv_w, conv_b, b_r, b_i, lam);
    { const int gw2 = c.ngw > NU_LRU ? (c.gw + c.ngw - NU_LRU) % c.ngw : c.gw;
      for (int u = gw2; u < NU_CMP; u += c.ngw) cmp_unit(c, u, layer, pe); }
    for (int u = c.gw; u < NU_VT; u += c.ngw) vt_unit(c, u);
    for (int u = c.gw; u < NU_ROPE; u += c.ngw) rope_unit(c, u);
    for (int u = c.gw; u < NU_POOL; u += c.ngw) pool_unit(c, u, layer, pool_scale);
}

constexpr int NCG = 2, QPW = 4 * NCG;
struct AttnRegs { f32x4 O[4][NCG]; float m[NCG], l[NCG]; };

__device__ __forceinline__ void attn_reset(AttnRegs& R) {
#pragma unroll
    for (int md = 0; md < 4; ++md)
#pragma unroll
        for (int cg_ = 0; cg_ < NCG; ++cg_) R.O[md][cg_] = (f32x4){0.f, 0.f, 0.f, 0.f};
#pragma unroll
    for (int cg_ = 0; cg_ < NCG; ++cg_) { R.m[cg_] = -1e30f; R.l[cg_] = 0.f; }
}

constexpr int ATT_SLOT = 32768, ATT_WBASE = 2 * ATT_SLOT, ATT_WLDS = 9216;
#define ATT_BAR() do { asm volatile("s_waitcnt lgkmcnt(0)" ::: "memory"); __builtin_amdgcn_s_barrier(); asm volatile("" ::: "memory"); } while (0)

template <int CTRL> __device__ __forceinline__ int dpp_i(int v) { return __builtin_amdgcn_update_dpp(v, v, CTRL, 0xF, 0xF, false); }
template <int CTRL> __device__ __forceinline__ float dpp_f(float v) { return __int_as_float(dpp_i<CTRL>(__float_as_int(v))); }
__device__ __forceinline__ int row16_sum(int v) { v += dpp_i<0xB1>(v); v += dpp_i<0x4E>(v); v += dpp_i<0x141>(v); v += dpp_i<0x140>(v); return v; }
__device__ __forceinline__ float rowmax4(float x) {
    auto r = __builtin_amdgcn_permlane16_swap(__float_as_uint(x), __float_as_uint(x), false, false);
    const float a = fmaxf(__uint_as_float(r[0]), __uint_as_float(r[1]));
    auto q = __builtin_amdgcn_permlane32_swap(__float_as_uint(a), __float_as_uint(a), false, false);
    return fmaxf(__uint_as_float(q[0]), __uint_as_float(q[1]));
}
__device__ __forceinline__ float rowsum4(float x) {
    auto r = __builtin_amdgcn_permlane16_swap(__float_as_uint(x), __float_as_uint(x), false, false);
    const float a = __uint_as_float(r[0]) + __uint_as_float(r[1]);
    auto q = __builtin_amdgcn_permlane32_swap(__float_as_uint(a), __float_as_uint(a), false, false);
    return __uint_as_float(q[0]) + __uint_as_float(q[1]);
}

template <int MODE, bool MASKED>
__device__ __forceinline__ void attn_tile64(AttnRegs& R, const bf16x8 (&Qf)[NCG][2], LAS unsigned char* slot, int kb0, unsigned act, int tq_base, const unsigned (&selw)[NCG], int bit,
                                            int lane, LAS float* imp, int qi, int hg, bool mk) {
    const int r16 = lane & 15, g = lane >> 4;
    const int fK = (r16 >> 2) | (((r16 >> 1) & 1) << 2), fV = (r16 >> 1) & 7;
    const int krow = 8 * (r16 >> 2) + (r16 & 3);
    LAS unsigned char* kp0 = slot + krow * 128 + ((g ^ fK) << 4);
    LAS unsigned char* kp1 = slot + krow * 128 + (((4 + g) ^ fK) << 4);
    LAS unsigned char* vp0 = slot + 8192 + r16 * 128 + ((g ^ fV) << 4);
    LAS unsigned char* vp1 = slot + 8192 + r16 * 128 + (((4 + g) ^ fV) << 4);
#pragma unroll
    for (int cg_ = 0; cg_ < NCG; ++cg_) {
        if (!(act & (1u << cg_))) continue;
        float s[16];
#pragma unroll
        for (int half = 0; half < 2; ++half) {
            const bf16x8 k00 = *(const LAS bf16x8*)(kp0 + half * 4096), k01 = *(const LAS bf16x8*)(kp1 + half * 4096);
            const bf16x8 k10 = *(const LAS bf16x8*)(kp0 + half * 4096 + 512), k11 = *(const LAS bf16x8*)(kp1 + half * 4096 + 512);
            f32x4 s0 = (f32x4){0.f, 0.f, 0.f, 0.f}, s1 = (f32x4){0.f, 0.f, 0.f, 0.f};
            s0 = MFMA16(k00, Qf[cg_][0], s0); s1 = MFMA16(k10, Qf[cg_][0], s1);
            s0 = MFMA16(k01, Qf[cg_][1], s0); s1 = MFMA16(k11, Qf[cg_][1], s1);
#pragma unroll
            for (int j = 0; j < 4; ++j) { s[half * 8 + j] = s0[j]; s[half * 8 + 4 + j] = s1[j]; }
        }
        const int tq = tq_base + 4 * cg_;
        if (MASKED && mk) {
#pragma unroll
            for (int i = 0; i < 16; ++i) { const int key = kb0 + 32 * (i >> 3) + 8 * g + (i & 7); bool ok;
                if (MODE == 0) ok = (key <= tq) && (tq - key < 512);
                else if (MODE == 1) ok = (key <= tq);
                else ok = (16 * key + 31 <= tq);
                s[i] = ok ? s[i] : -INFINITY; }
        }
        const bool lane_on = (MODE == 1) ? (((selw[cg_] >> bit) & 1u) != 0u) : true;
        float p[16];
        if (MODE == 2) {
            const float mm = R.m[cg_], il = R.l[cg_];
#pragma unroll
            for (int i = 0; i < 16; ++i) p[i] = fexp2(s[i] - mm) * il;
#pragma unroll
            for (int half = 0; half < 2; ++half) {
                float ps[8];
#pragma unroll
                for (int i = 0; i < 8; ++i) { float v = p[half * 8 + i]; v += dpp_f<0xB1>(v); v += dpp_f<0x4E>(v); ps[i] = v; }
                if (hg == 0) {
                    const int jb = (kb0 + 32 * half + 8 * g) >> 2; LAS float* ip = imp + (4 * cg_ + qi) * 256 + jb;
                    __hip_atomic_fetch_add(ip, (ps[0] + ps[1]) + (ps[2] + ps[3]), __ATOMIC_RELAXED, __HIP_MEMORY_SCOPE_WORKGROUP);
                    if (jb + 1 < 256) __hip_atomic_fetch_add(ip + 1, ps[3] + (ps[4] + ps[5]) + (ps[6] + ps[7]), __ATOMIC_RELAXED, __HIP_MEMORY_SCOPE_WORKGROUP);
                    if (jb + 2 < 256) __hip_atomic_fetch_add(ip + 2, ps[7], __ATOMIC_RELAXED, __HIP_MEMORY_SCOPE_WORKGROUP);
                }
            }
        } else {
            float mx = fmaxf(fmaxf(fmaxf(s[0], s[1]), s[2]), fmaxf(fmaxf(s[3], s[4]), s[5])); mx = fmaxf(fmaxf(mx, s[6]), s[7]);
            float my = fmaxf(fmaxf(fmaxf(s[8], s[9]), s[10]), fmaxf(fmaxf(s[11], s[12]), s[13])); my = fmaxf(fmaxf(my, s[14]), s[15]);
            mx = fmaxf(mx, my);
            if (MODE == 1) mx = lane_on ? mx : -INFINITY;
            mx = rowmax4(mx);
            const float mold = R.m[cg_], mnew = fmaxf(mold, mx);
            if (__builtin_amdgcn_ballot_w64(mnew > mold) != 0ull) {
                const float alpha = fexp2(mold - mnew); R.m[cg_] = mnew; R.l[cg_] *= alpha;
                if (MODE != 3) {
#pragma unroll
                    for (int md = 0; md < 4; ++md) R.O[md][cg_] = R.O[md][cg_] * alpha;
                }
            }
            const float msub = ((MODE == 1) && !lane_on) ? INFINITY : mnew;
            float sum0 = 0.f, sum1 = 0.f;
#pragma unroll
            for (int i = 0; i < 8; ++i) { p[i] = fexp2(s[i] - msub); sum0 += p[i]; p[8 + i] = fexp2(s[8 + i] - msub); sum1 += p[8 + i]; }
            R.l[cg_] += sum0 + sum1;
        }
        if (MODE != 3) {
            const bf16x8 P0 = pack8(p), P1 = pack8(p + 8);
#pragma unroll
            for (int md = 0; md < 4; ++md) { const bf16x8 v0 = *(const LAS bf16x8*)(vp0 + md * 2048), v1 = *(const LAS bf16x8*)(vp1 + md * 2048);
                R.O[md][cg_] = MFMA16(v0, P0, R.O[md][cg_]); R.O[md][cg_] = MFMA16(v1, P1, R.O[md][cg_]); }
        }
    }
}

template <int MODE>
__device__ __forceinline__ void attn_stream(AttnRegs& R, const bf16x8 (&Qf)[NCG][2], LAS unsigned char* ring, const bf16_t* Kg, const bf16_t* Vg, int ldv, int t0, int nt, int tq_base,
                                            LAS unsigned* msk, LAS unsigned* uni, LAS float* imp, int tid, int lane, int qi, int hg) {
    constexpr bool HASV = (MODE != 3);
    const int tq_min_ = __builtin_amdgcn_readfirstlane(tq_base - qi), qb_ = tq_min_ >> 6;
    const int row = tid >> 3, cpos = tid & 7;
    const int cK = cpos ^ (((row >> 3) & 3) | (((row >> 1) & 1) << 2)), cV = cpos ^ ((row >> 1) & 7);
    const unsigned offk = (unsigned)(row * 64 + cK * 8) * 2u, offv = (unsigned)(row * 64 + cV * 8) * 2u;
    typedef const __attribute__((address_space(1))) char gcchar;
    gcchar* gk = (gcchar*)Kg + (size_t)t0 * 8192; gcchar* gv = (gcchar*)Vg + (size_t)t0 * 8192;
    const u32x4 z4 = (u32x4){0u, 0u, 0u, 0u};
    u32x4 ka0 = z4, va0 = z4, ka1 = z4, va1 = z4, kb0 = z4, vb0 = z4, kb1 = z4, vb1 = z4;
    const int ng = (nt + 1) >> 1;
#define ATT_LOADG(G, K0, V0, K1, V1) do { int T0_ = 2 * (G), T1_ = T0_ + 1; T0_ = T0_ < nt ? T0_ : nt - 1; T1_ = T1_ < nt ? T1_ : nt - 1;     \
        K0 = *(const __attribute__((address_space(1))) u32x4*)(gk + (size_t)T0_ * 8192 + offk); if (HASV) V0 = *(const __attribute__((address_space(1))) u32x4*)(gv + (size_t)T0_ * 8192 + offv); \
        K1 = *(const __attribute__((address_space(1))) u32x4*)(gk + (size_t)T1_ * 8192 + offk); if (HASV) V1 = *(const __attribute__((address_space(1))) u32x4*)(gv + (size_t)T1_ * 8192 + offv); } while (0)
#define ATT_STOREG(G, K0, V0, K1, V1) do { LAS unsigned char* ns_ = ring + ((G) & 1) * ATT_SLOT + tid * 16; \
        *(LAS u32x4*)ns_ = K0; if (HASV) *(LAS u32x4*)(ns_ + 8192) = V0; \
        *(LAS u32x4*)(ns_ + 16384) = K1; if (HASV) *(LAS u32x4*)(ns_ + 24576) = V1; } while (0)
    ATT_LOADG(0, ka0, va0, ka1, va1);
    ATT_STOREG(0, ka0, va0, ka1, va1);
    ATT_LOADG(1, ka0, va0, ka1, va1);
    ATT_BAR();
    unsigned selw[NCG];
#pragma unroll
    for (int cg_ = 0; cg_ < NCG; ++cg_) selw[cg_] = 0u;
#define ATT_STEP(I, PK0, PV0, PK1, PV1, WK0, WV0, WK1, WV1) do { \
        ATT_LOADG((I) + 2, PK0, PV0, PK1, PV1); \
        _Pragma("unroll 1") for (int sub_ = 0; sub_ < 2; ++sub_) { \
            if (2 * (I) + sub_ >= nt) break; \
            LAS unsigned char* slot = ring + ((I) & 1) * ATT_SLOT + sub_ * 16384; \
            const int tile = t0 + 2 * (I) + sub_; \
            unsigned act = (1u << NCG) - 1u; int bit = 0; \
            if (MODE == 1) { const int w = tile >> 5; bit = tile & 31; act = 0u; \
                _Pragma("unroll") for (int cg_ = 0; cg_ < NCG; ++cg_) { act |= ((__builtin_amdgcn_readfirstlane(uni[8 + cg_ * 8 + w]) >> bit) & 1u) << cg_; selw[cg_] = msk[(4 * cg_ + qi) * 8 + w]; } } \
            bool masked_; \
            if (MODE == 0) masked_ = (tile == qb_) || (tile == qb_ - 8); \
            else if (MODE == 1) masked_ = (tile == qb_); \
            else masked_ = (16 * (64 * tile + 63) + 31 > tq_min_); \
            attn_tile64<MODE, true>(R, Qf, slot, tile * 64, act, tq_base, selw, bit, lane, imp, qi, hg, masked_); \
        } \
        ATT_STOREG((I) + 1, WK0, WV0, WK1, WV1); \
        ATT_BAR(); } while (0)
    for (int i = 0; i < ng; i += 2) {
        ATT_STEP(i, kb0, vb0, kb1, vb1, ka0, va0, ka1, va1);
        if (i + 1 >= ng) break;
        ATT_STEP(i + 1, ka0, va0, ka1, va1, kb0, vb0, kb1, vb1);
    }
#undef ATT_STEP
#undef ATT_LOADG
#undef ATT_STOREG
}

template <int MODE, bool NORM>
__device__ __forceinline__ void attn_flush(AttnRegs& R, LAS float* ofin, const bf16_t* gp  , bf16_t* outp, int lane) {
#pragma unroll
    for (int cg_ = 0; cg_ < NCG; ++cg_) {
        float sc = sigmoidf_(bf1(gp[(size_t)(4 * cg_) * INP]));
        if (NORM) { const float L = rowsum4(R.l[cg_]); sc = L > 0.f ? sc / L : 0.f; }
#pragma unroll
        for (int md = 0; md < 4; ++md) {
            f32x4 v = R.O[md][cg_] * sc;
            LAS f32x4* slot = (LAS f32x4*)ofin + (md * NCG + cg_) * 64 + lane;
            if (MODE != 0) v = v + *slot;
            if (MODE != 2) *slot = v;
            else { u32x2 o; o.x = cvt_pk_bf16(v[0], v[1]); o.y = cvt_pk_bf16(v[2], v[3]); *(u32x2*)(outp + (size_t)(4 * cg_) * DM + 16 * md) = o; }
        }
    }
}

__device__ __forceinline__ void attn_unit(const Ctx& c, int bk, int qb) {
    int lane_ = c.lane, tid_ = c.tid; asm volatile("" : "+v"(lane_), "+v"(tid_));
    const int lane = lane_, r16 = lane & 15, g = lane >> 4, qi = r16 >> 2, hg = r16 & 3;
    const int b = bk >> 1, kvh = bk & 1;
    const int tq0 = qb * 64 + c.wave * QPW, cur = qb, head = kvh * 4 + hg;
    LAS unsigned char* ring = c.lds;
    LAS unsigned char* wl = c.lds + ATT_WBASE + c.wave * ATT_WLDS;
    unsigned long long wsi_ = (unsigned long long)c.ws; asm volatile("" : "+s"(wsi_)); unsigned char* wsu = (unsigned char*)(__attribute__((address_space(1))) unsigned char*)wsi_;
    LAS float* imp = (LAS float*)wl;
    LAS unsigned* msk = (LAS unsigned*)(wl + 8192);
    LAS unsigned* uni = (LAS unsigned*)(wl + 8192 + 256);
    const bf16_t* proj = (const bf16_t*)(wsu + WS_HID);
    const bf16_t* Qr = (const bf16_t*)(wsu + WS_QR);
    bf16x8 Qf[NCG][2];
#pragma unroll
    for (int cg_ = 0; cg_ < NCG; ++cg_) { const size_t tg = (size_t)b * SEQ + tq0 + 4 * cg_ + qi; const bf16_t* qp = Qr + tg * 512 + head * 64 + g * 8; Qf[cg_][0] = *(const bf16x8*)qp; Qf[cg_][1] = *(const bf16x8*)(qp + 32); }
    const bf16_t* gp = proj + ((size_t)b * SEQ + tq0 + qi) * INP + C_G + head * 3;
    bf16_t* outp = (bf16_t*)(wsu + WS_A) + ((size_t)b * SEQ + tq0 + qi) * DM + 512 + head * 64 + 4 * g;
    AttnRegs R;
    {
#pragma unroll
    for (int i = 0; i < QPW; ++i) ((LAS f32x4*)imp)[i * 64 + lane] = (f32x4){0.f, 0.f, 0.f, 0.f};
    CFENCE();
    {
        const bf16_t* Kc = (const bf16_t*)(wsu + WS_KCMP) + (size_t)bk * 1024 * 64; const bf16_t* Vc = (const bf16_t*)(wsu + WS_VCMPT) + (size_t)bk * 64 * 1024;
        const int ncount = 4 * qb + 3; const int nt = (ncount + 63) >> 6;
        attn_reset(R);
        attn_stream<3>(R, Qf, ring, Kc, Vc, 1024, 0, nt, tq0 + qi, msk, uni, imp, tid_, lane, qi, hg);
#pragma unroll
        for (int cg_ = 0; cg_ < NCG; ++cg_) { const float L = rowsum4(R.l[cg_]); R.l[cg_] = L > 0.f ? 1.0f / L : 0.f; }
        attn_stream<2>(R, Qf, ring, Kc, Vc, 1024, 0, nt, tq0 + qi, msk, uni, imp, tid_, lane, qi, hg);
    }
    LDS_WAIT(); CFENCE();
    }
    {
    if (cur < 16) {
        if (lane < QPW) {
#pragma unroll
            for (int w = 0; w < 8; ++w) { const int lo = 32 * w; unsigned v = 0u; if (cur >= lo) { const int nb = cur - lo + 1; v = nb >= 32 ? 0xFFFFFFFFu : ((1u << nb) - 1u); } msk[lane * 8 + w] = v; }
        }
    } else {
        LAS unsigned short* m16 = (LAS unsigned short*)msk;
        for (int rr = 0; rr < NCG; ++rr) {
            const int qq = 4 * rr + g; int v[16];
#pragma unroll
            for (int i = 0; i < 16; ++i) { const int j = i * 16 + r16; const bool cand = (j <= cur) && (j != 0) && (j != cur) && (j != cur - 1); v[i] = cand ? (int)__float_as_uint(imp[qq * 256 + j]) : -1; }
            int T = 0;
            for (int bitp = 30; bitp >= 0; --bitp) { const int cd = T | (1 << bitp); int cnt = 0;
#pragma unroll
                for (int i = 0; i < 16; ++i) cnt += (v[i] >= cd) ? 1 : 0;
                cnt = row16_sum(cnt);
                if (cnt >= 13) T = cd; }
            int gt = 0;
#pragma unroll
            for (int i = 0; i < 16; ++i) gt += (v[i] > T) ? 1 : 0;
            gt = row16_sum(gt);
            const int need = 13 - gt; int running = 0;
#pragma unroll
            for (int i = 0; i < 16; ++i) { const int j = i * 16 + r16; const bool eq = (v[i] == T);
                const unsigned long long bal = __ballot(eq); const unsigned be = (unsigned)(bal >> (16 * g)) & 0xFFFFu;
                const int rank = running + __popc(be & ((1u << r16) - 1u)); running += __popc(be);
                const bool forced = (j <= cur) && ((j == 0) || (j == cur) || (j == cur - 1));
                const bool sel = (v[i] > T) || (eq && rank < need) || forced;
                const unsigned long long bs = __ballot(sel);
                if (r16 == 0) m16[qq * 16 + i] = (unsigned short)((bs >> (16 * g)) & 0xFFFFu); }
        }
    }
    LDS_WAIT(); CFENCE();
    }
    if (lane < 8) { unsigned u = 0u;
#pragma unroll
        for (int q = 0; q < QPW; ++q) u |= msk[q * 8 + lane];
        uni[lane] = u; }
    if (lane < 8 * NCG) { const int cg_ = lane >> 3, w = lane & 7; unsigned u = 0u;
#pragma unroll
        for (int q = 0; q < 4; ++q) u |= msk[(4 * cg_ + q) * 8 + w];
        uni[8 + lane] = u; }
    LDS_WAIT(); CFENCE();
    attn_flush<0, false>(R, imp, gp + 0, outp, lane);
    {
        const bf16_t* Ks = (const bf16_t*)(wsu + WS_KS) + (size_t)bk * SEQ * 64; const bf16_t* Vs = (const bf16_t*)(wsu + WS_VST) + (size_t)bk * 64 * SEQ;
        {
        attn_reset(R);
        attn_stream<1>(R, Qf, ring, Ks, Vs, SEQ, 0, cur + 1, tq0 + qi, msk, uni, imp, tid_, lane, qi, hg);
        }
        attn_flush<1, true>(R, imp, gp + 1, outp, lane);
    }
    {
        const bf16_t* Kw = (const bf16_t*)(wsu + WS_KW) + (size_t)bk * SEQ * 64; const bf16_t* Vw = (const bf16_t*)(wsu + WS_VWT) + (size_t)bk * 64 * SEQ;
        int t0 = qb - 8; if (t0 < 0) t0 = 0;
        {
        attn_reset(R);
        attn_stream<0>(R, Qf, ring, Kw, Vw, SEQ, t0, qb - t0 + 1, tq0 + qi, msk, uni, imp, tid_, lane, qi, hg);
        }
        attn_flush<2, true>(R, imp, gp + 2, outp, lane);
    }
    LDS_WAIT(); CFENCE();
}

__device__ __forceinline__ void lru_fin_unit(const Ctx& c, int u) {
    const int hh = u & 3, ch = (u >> 2) % LRU_NCH, b = (u >> 2) / LRU_NCH; const int chn = hh * 64 + c.lane;
    const float* carA = (const float*)(c.ws + WS_CARA) + (size_t)b * LRU_NCH * 256 + chn; const float* carH = (const float*)(c.ws + WS_CARH) + (size_t)b * LRU_NCH * 256 + chn;
    float h = 0.f;
#pragma unroll 8
    for (int k = 0; k < ch; ++k) h = carA[k * 256] * h + carH[k * 256];
    const float* HL = (const float*)(c.ws + WS_F); const float* CA = HL + (size_t)M * 256;
    const bf16_t* proj = (const bf16_t*)(c.ws + WS_HID); bf16_t* out = (bf16_t*)(c.ws + WS_A);
    const size_t tg0 = (size_t)b * SEQ + ch * LRU_CHUNK;
#pragma unroll 8
    for (int t = 0; t < LRU_CHUNK; ++t) { const size_t tg = tg0 + t;
        const float hv = HL[tg * 256 + chn] + CA[tg * 256 + chn] * h; const float x = bf1(proj[tg * INP + C_GL + chn]);
        const float u3 = 0.7978845608028654f * (x + 0.044715f * x * x * x); const float th = 1.0f - 2.0f / (1.0f + __expf(2.0f * u3));
        const float y = hv * (0.5f * x * (1.0f + th));
        out[tg * DM + 256 + chn] = (bf16_t)(cvt_pk_bf16(y, 0.f) & 0xffffu); }
}

constexpr int NU_ATT = (SEQ / QPW) * 4;
__device__ __forceinline__ void phase_attn_units(const Ctx& c) {
    for (int p2 = (c.gw / NWAVES) * 2; p2 < 1024; p2 += c.G * 2) { const int p = p2 >> 1;
        for (int r = 0; r < 2; ++r) { const int bk = p & 3, ql = p >> 2; attn_unit(c, bk, r ? 255 - ql : ql); } }
    __syncthreads();
}
__device__ __forceinline__ void phase_attn_fin(const Ctx& c) {
    for (int u = c.gw; u < NU_LRU; u += c.ngw) lru_fin_unit(c, u);
}
__device__ __forceinline__ void phase_attn(const Ctx& c) {
    phase_attn_units(c);
    phase_attn_fin(c);
}

constexpr int N_PHASES = 1 + 11 * DEPTH;
__global__ void __launch_bounds__(NTHREADS, 2) fwd_kernel(Args args) {
    extern __shared__ __attribute__((aligned(16))) unsigned char lds_raw[];
    {
        LAS unsigned long long* tab = (LAS unsigned long long*)((LAS unsigned char*)lds_raw + PTAB_OFF);
        if (threadIdx.x < 28) tab[threadIdx.x] = (unsigned long long)args.in[threadIdx.x];
        if (threadIdx.x == 28) tab[28] = (unsigned long long)args.out;
        if (threadIdx.x == 29) tab[29] = (unsigned long long)args.ws;

        if (threadIdx.x == 0) (void)xb_add((unsigned*)(args.ws + WS_CTL) + XB_XCNT(xb_xcc_id()), 1u);
        if (threadIdx.x == 30) tab[30] = (unsigned long long)(unsigned)args.rep_attn | ((unsigned long long)(unsigned)args.rep_fin << 32);
        if (threadIdx.x == 31) tab[31] = 0ull;
        __syncthreads();
    }
    const int ph_lo = args.ph_lo, ph_hi = args.ph_hi;
    const int wave_s = __builtin_amdgcn_readfirstlane(threadIdx.x >> 6);
    using namespace pg8;
    for (int ph = ph_lo; ph < ph_hi; ++ph) {
        Ctx c;
        int tid = threadIdx.x; asm volatile("" : "+v"(tid));
        int bid = blockIdx.x; asm volatile("" : "+s"(bid));
        unsigned ldsb = (unsigned)(size_t)(LAS unsigned char*)lds_raw; asm volatile("" : "+s"(ldsb));
        c.lds = (LAS unsigned char*)(size_t)ldsb; c.tid = tid; c.lane = tid & 63; c.wave = __builtin_amdgcn_readfirstlane(tid >> 6);
        c.G = gridDim.x; c.gw = bid * NWAVES + c.wave; c.ngw = c.G * NWAVES;
        c.wlds = c.lds + c.wave * WAVE_LDS;
        unsigned char* ws = (unsigned char*)ldptr(c.lds, 29); c.ws = ws;
        float* outp = (float*)ldptr(c.lds, 28);
        if (ph == 0) {
#ifndef NO_P0
            p0_prologue(c);
#endif
        } else {
            const int l = (ph - 1) / 11, s = (ph - 1) % 11;
            if (s == 0 || s == 8) {
                const int which = s == 8; Gemm g{(const bf16_t*)(ws + WS_A), (const bf16_t*)(ws + WS_WGU + (size_t)(l * 2 + which) * SZ_WGU), M, NGU, DM};
                StaticOrder S; S.init(M, NGU, c.G, bid); EpiSwiGLU E{(bf16_t*)(ws + WS_HID)};
                gemm_phase<EpiSwiGLU, StaticOrder, true, true>(c.lds, g, S, E, tid);
            } else if (s == 1 || s == 9 || s == 3 || s == 6) {
                const bf16_t* A; const bf16_t* Bt; bf16_t* O; int N, K;
                if (s == 3) { A = (const bf16_t*)(ws + WS_A); Bt = (const bf16_t*)(ws + WS_WIN + (size_t)l * SZ_WIN); O = (bf16_t*)(ws + WS_HID); N = INP; K = DM; }
                else if (s == 6) { A = (const bf16_t*)(ws + WS_A); Bt = (const bf16_t*)(ws + WS_WOUT + (size_t)l * SZ_WOUT); O = (bf16_t*)(ws + WS_F); N = DM; K = DM; }
                else { A = (const bf16_t*)(ws + WS_HID); Bt = (const bf16_t*)(ws + WS_WDN + (size_t)(l * 2 + (s == 9)) * SZ_WDN); O = (bf16_t*)(ws + WS_F); N = DM; K = FF; }
                Gemm g{A, Bt, M, N, K};
                StaticOrder S; S.init(M, N, c.G, bid); EpiStore E{O, N};
                gemm_phase<EpiStore, StaticOrder, true, true>(c.lds, g, S, E, tid);
            } else if (s == 4) {
#ifndef NO_PREP
                phase_prep(c, l);
#endif
            } else if (s == 5) {
#ifndef NO_ATTN
                phase_attn(c);
#endif
            } else {
                const float* hin = (s == 2 && l == 0) ? INP_F(0) : outp;
                const float* gpost = INP_F(s == 2 ? 3 : (s == 7 ? 8 : 24)) + l * DM;
                const float* gnext = s == 2 ? INP_F(7) + l * DM : (s == 7 ? INP_F(23) + l * DM : ((l + 1 < DEPTH) ? INP_F(2) + (l + 1) * DM : nullptr));
                rowpass(c, hin, outp, (const bf16_t*)(ws + WS_F), gpost, s == 7 ? 1.0f : 0.5f, gnext, (bf16_t*)(ws + WS_A));
            }
        }
        if (ph + 1 < ph_hi) {
            if (ph == ph_lo) cg::this_grid().sync();
            else xcd_barrier((unsigned*)(ws + WS_CTL), xb_xcc_id(), (volatile LAS unsigned*)(c.lds + PTAB_OFF + 248));
        }
    }
}

extern "C" void kernel_launch(void* const* d_in, const int* in_sizes, int n_in, void* d_out, int out_size, void* d_ws, size_t ws_size, hipStream_t stream) {
    static int grid = 0;
    if (grid == 0) {
        if (n_in != 28 || out_size != M * DM || ws_size < WS_END) { fprintf(stderr, "kernel_launch: unexpected shapes (n_in %d out %d ws %zu need %zu)\n", n_in, out_size, ws_size, (size_t)WS_END); grid = -1; return; }
        int dev = 0, cus = 0, per_cu = 0;
        hipGetDevice(&dev); hipDeviceGetAttribute(&cus, hipDeviceAttributeMultiprocessorCount, dev);
        if (hipFuncSetAttribute((const void*)fwd_kernel, hipFuncAttributeMaxDynamicSharedMemorySize, LDS_BYTES) != hipSuccess) { fprintf(stderr, "kernel_launch: hipFuncSetAttribute failed\n"); grid = -1; return; }
        if (hipOccupancyMaxActiveBlocksPerMultiprocessor(&per_cu, (const void*)fwd_kernel, NTHREADS, LDS_BYTES) != hipSuccess || per_cu < 1) { fprintf(stderr, "kernel_launch: occupancy query says %d\n", per_cu); per_cu = 1; }
        (void)hipGetLastError();
        grid = cus * per_cu;
        fprintf(stderr, "kernel_launch: grid %d (cus %d x %d)\n", grid, cus, per_cu);
    }
    if (grid < 0) return;
    if (hipMemsetAsync((char*)d_ws + WS_CTL, 0, CTL_BYTES, stream) != hipSuccess) { fprintf(stderr, "kernel_launch: memset failed\n"); return; }
    Args a{};
    for (int i = 0; i < 28; ++i) a.in[i] = d_in[i];
    a.out = (float*)d_out; a.ws = (unsigned char*)d_ws;
#ifndef REP_ATTN
#define REP_ATTN 1
#endif
#ifndef REP_FIN
#define REP_FIN 1
#endif
#ifndef REP_PREP
#define REP_PREP 0
#endif
    a.rep_attn = REP_ATTN; a.rep_fin = REP_FIN; a.rep_prep = REP_PREP; a.rep_pad = 0;
#if N_LAUNCH_MODE == 1
    a.ph_lo = 0; a.ph_hi = N_PHASES;
    void* kargs[] = {&a};
    hipError_t e = hipLaunchCooperativeKernel((const void*)fwd_kernel, dim3(grid), dim3(NTHREADS), kargs, LDS_BYTES, stream);
    if (e != hipSuccess) fprintf(stderr, "cooperative launch failed: %s (grid %d)\n", hipGetErrorString(e), grid);
#else
    for (int ph = 0; ph < N_PHASES; ++ph) {
        a.ph_lo = ph; a.ph_hi = ph + 1;
        hipLaunchKernelGGL(fwd_kernel, dim3(grid), dim3(NTHREADS), LDS_BYTES, stream, a);
    }
#endif
}
```
